# Optimizing an MI355X kernel written in HIP

```python
import math
import jax, jax.numpy as jnp
from jax import lax
import numpy as np

D_MODEL = 1024
BATCH = 8
SEQ = 4096
DEPTH = 2

GRID_W = 64
CTX_LEN = 256
N_MIXERS = 2
N_HEADS = 16
N_KV_HEADS = 4
HEAD_DIM = D_MODEL // N_HEADS
GQA_GROUP = N_HEADS // N_KV_HEADS
Q_DIM = N_HEADS * HEAD_DIM
KV_DIM = N_KV_HEADS * HEAD_DIM
ROPE_AXIS_DIM = HEAD_DIM // 2
ROPE_THETA = 10000.0
ATTN_SCALE = HEAD_DIM ** -0.5
Q_BLOCK = 128
FOURIER_GROUPS = 4
N_GROUPS = 4
EXPERTS_PER_GROUP = 8
N_EXPERTS = N_GROUPS * EXPERTS_PER_GROUP
TOP_K_IN_GROUP = 2
D_EXPERT = D_MODEL // 2
MOE_BLOCK = 128
N_ATTN_LAYERS = (DEPTH + N_MIXERS - 1) // N_MIXERS
N_FOURIER_LAYERS = DEPTH // N_MIXERS
EPS = 1e-6

kernel_name = 'hybrid_attn_fourier_hmoe_dit'


def _rms_norm(x, gain):
    xf = x.astype(jnp.float32)
    y = xf * lax.rsqrt(jnp.mean(xf * xf, axis=-1, keepdims=True) + EPS)
    return y.astype(x.dtype) * gain


def _ada_params(silu_cond, w_mod, b_mod):
    return jnp.split(silu_cond @ w_mod + b_mod, 6, axis=-1)


def _modulate(x, gain, shift, scale):
    return _rms_norm(x, gain) * (1 + scale) + shift


def _axial_rope_tables(rows, dtype):
    half = ROPE_AXIS_DIM // 2
    inv = ROPE_THETA ** (-jnp.arange(half, dtype=jnp.float32) / half)
    ang_r = jnp.arange(rows, dtype=jnp.float32)[:, None] * inv
    ang_c = jnp.arange(GRID_W, dtype=jnp.float32)[:, None] * inv
    ang_r = jnp.broadcast_to(ang_r[:, None, :], (rows, GRID_W, half)).reshape(-1, half)
    ang_c = jnp.broadcast_to(ang_c[None, :, :], (rows, GRID_W, half)).reshape(-1, half)
    return (jnp.cos(ang_r).astype(dtype), jnp.sin(ang_r).astype(dtype),
            jnp.cos(ang_c).astype(dtype), jnp.sin(ang_c).astype(dtype))


def _rotate_half(x, cos, sin):
    shp = (cos.shape[0],) + (1,) * (x.ndim - 3) + (cos.shape[-1],)
    cos, sin = cos.reshape(shp), sin.reshape(shp)
    x1, x2 = jnp.split(x, 2, axis=-1)
    return jnp.concatenate([x1 * cos - x2 * sin, x2 * cos + x1 * sin], axis=-1)


def _apply_axial_rope(x, tables):
    cos_r, sin_r, cos_c, sin_c = tables
    return jnp.concatenate([_rotate_half(x[..., :ROPE_AXIS_DIM], cos_r, sin_r),
                            _rotate_half(x[..., ROPE_AXIS_DIM:], cos_c, sin_c)], axis=-1)


def _project_qkv(h, w_qkv, q_gain, k_gain, with_q):
    b, l, _ = h.shape
    if with_q:
        qkv = h @ w_qkv
        q = _rms_norm(qkv[..., :Q_DIM].reshape(b, l, N_KV_HEADS, GQA_GROUP, HEAD_DIM), q_gain)
        kv = qkv[..., Q_DIM:]
    else:
        q = None
        kv = h @ w_qkv[:, Q_DIM:]
    k = _rms_norm(kv[..., :KV_DIM].reshape(b, l, N_KV_HEADS, HEAD_DIM), k_gain)
    v = kv[..., KV_DIM:].reshape(b, l, N_KV_HEADS, HEAD_DIM)
    return q, k, v


def _attend(q, k, v):
    s = jnp.einsum('bqkgd,bskd->bkgqs', q, k).astype(jnp.float32) * ATTN_SCALE
    p = jax.nn.softmax(s, axis=-1).astype(v.dtype)
    return jnp.einsum('bkgqs,bskd->bqkgd', p, v)


def _gqa_attention(h_lat, h_ctx, w_qkv, q_gain, k_gain, w_o, rope, need_ctx_out):
    b, n, _ = h_lat.shape
    q_l, k_l, v_l = _project_qkv(h_lat, w_qkv, q_gain, k_gain, True)
    q_c, k_c, v_c = _project_qkv(h_ctx, w_qkv, q_gain, k_gain, need_ctx_out)
    q_l = _apply_axial_rope(q_l, rope)
    k_l = _apply_axial_rope(k_l, rope)
    k_all = jnp.concatenate([k_l, k_c], axis=1)
    v_all = jnp.concatenate([v_l, v_c], axis=1)
    n_blk = n // Q_BLOCK
    q_blocks = jnp.moveaxis(q_l.reshape(b, n_blk, Q_BLOCK, N_KV_HEADS, GQA_GROUP, HEAD_DIM), 1, 0)
    o = lax.map(lambda qb: _attend(qb, k_all, v_all), q_blocks)
    y_lat = jnp.moveaxis(o, 0, 1).reshape(b, n, Q_DIM) @ w_o
    y_ctx = None
    if need_ctx_out:
        y_ctx = _attend(q_c, k_c, v_c).reshape(b, h_ctx.shape[1], Q_DIM) @ w_o
    return y_lat, y_ctx


def _fourier_mix(h, w_o):
    b, n, d = h.shape
    hg = h.astype(jnp.float32).reshape(b, n, FOURIER_GROUPS, d // FOURIER_GROUPS)
    f = jnp.fft.fft2(hg, axes=(1, 3), norm='ortho').real
    return f.reshape(b, n, d).astype(h.dtype) @ w_o


def _hier_moe(h, w_rg, b_rg, w_re, b_re, w1, w3, w2):
    b, n, d = h.shape
    xt = h.reshape(-1, d)
    t = xt.shape[0]
    lg = (xt @ w_rg + b_rg).astype(jnp.float32)
    g_sel = jnp.argmax(lg, axis=-1)
    p_grp = jnp.max(jax.nn.softmax(lg, axis=-1), axis=-1)
    le = (xt @ w_re + b_re).astype(jnp.float32).reshape(t, N_GROUPS, EXPERTS_PER_GROUP)
    le_sel = jnp.take_along_axis(le, g_sel[:, None, None], axis=1)[:, 0]
    top_l, top_i = lax.top_k(le_sel, TOP_K_IN_GROUP)
    gate = p_grp[:, None] * jax.nn.softmax(top_l, axis=-1)
    eid = (g_sel[:, None] * EXPERTS_PER_GROUP + top_i).astype(jnp.int32)
    a = t * TOP_K_IN_GROUP
    flat_e = eid.reshape(-1)
    flat_t = jnp.arange(a, dtype=jnp.int32) // TOP_K_IN_GROUP
    flat_w = gate.reshape(-1).astype(h.dtype)
    order = jnp.argsort(flat_e)
    se = flat_e[order]
    counts = jnp.bincount(flat_e, length=N_EXPERTS)
    pcounts = (counts + MOE_BLOCK - 1) // MOE_BLOCK * MOE_BLOCK
    pend = jnp.cumsum(pcounts)
    pstart = pend - pcounts
    start = jnp.cumsum(counts) - counts
    dest = pstart[se] + jnp.arange(a, dtype=jnp.int32) - start[se]
    n_blk = (a + N_EXPERTS * (MOE_BLOCK - 1) + MOE_BLOCK - 1) // MOE_BLOCK
    p_rows = n_blk * MOE_BLOCK
    row_t = jnp.full((p_rows,), t, jnp.int32).at[dest].set(flat_t[order])
    row_w = jnp.zeros((p_rows,), h.dtype).at[dest].set(flat_w[order])
    blk_e = jnp.minimum(jnp.searchsorted(pend, jnp.arange(n_blk) * MOE_BLOCK, side='right'),
                        N_EXPERTS - 1).astype(jnp.int32)
    x_pad = jnp.concatenate([xt, jnp.zeros((1, d), xt.dtype)], axis=0)
    xb = x_pad[row_t].reshape(n_blk, MOE_BLOCK, d)

    def expert_block(args):
        xblk, e = args
        return (jax.nn.silu(xblk @ w1[e]) * (xblk @ w3[e])) @ w2[e]

    yb = lax.map(expert_block, (xb, blk_e)).reshape(p_rows, d)
    y = jax.ops.segment_sum(yb * row_w[:, None], row_t, num_segments=t + 1)[:t]
    return y.reshape(b, n, d)


def _context_needed_after(i):
    return any(j % N_MIXERS == 0 for j in range(i + 1, DEPTH))


def setup_inputs(seed: int = 0) -> dict:
    key = jax.random.key(seed)
    ks = jax.random.split(key, 21)
    nrm = lambda k, shape, s: jax.random.normal(k, shape, jnp.float32) * s
    return {
        'x': nrm(ks[0], (BATCH, SEQ, D_MODEL), 1.0),
        'c': nrm(ks[1], (BATCH, D_MODEL), 1.0),
        'ctx': nrm(ks[2], (BATCH, CTX_LEN, D_MODEL), 1.0),
        'c_ctx': nrm(ks[3], (D_MODEL,), 1.0),
        'w_mod': nrm(ks[4], (DEPTH, D_MODEL, 6 * D_MODEL), 0.5 * D_MODEL ** -0.5),
        'b_mod': nrm(ks[5], (DEPTH, 6 * D_MODEL), 0.02),
        'norm_mix': 1.0 + nrm(ks[6], (DEPTH, D_MODEL), 0.02),
        'norm_ffn': 1.0 + nrm(ks[7], (DEPTH, D_MODEL), 0.02),
        'attn_w_qkv': nrm(ks[8], (N_ATTN_LAYERS, D_MODEL, Q_DIM + 2 * KV_DIM), D_MODEL ** -0.5),
        'attn_q_norm': 1.0 + nrm(ks[9], (N_ATTN_LAYERS, HEAD_DIM), 0.02),
        'attn_k_norm': 1.0 + nrm(ks[10], (N_ATTN_LAYERS, HEAD_DIM), 0.02),
        'attn_w_o': nrm(ks[11], (N_ATTN_LAYERS, Q_DIM, D_MODEL), Q_DIM ** -0.5),
        'fourier_w_o': nrm(ks[12], (N_FOURIER_LAYERS, D_MODEL, D_MODEL), D_MODEL ** -0.5),
        'moe_w_rg': nrm(ks[13], (DEPTH, D_MODEL, N_GROUPS), D_MODEL ** -0.5),
        'moe_b_rg': nrm(ks[14], (DEPTH, N_GROUPS), 0.01),
        'moe_w_re': nrm(ks[15], (DEPTH, D_MODEL, N_EXPERTS), D_MODEL ** -0.5),
        'moe_b_re': nrm(ks[16], (DEPTH, N_EXPERTS), 0.01),
        'moe_w1': nrm(ks[17], (DEPTH, N_EXPERTS, D_MODEL, D_EXPERT), D_MODEL ** -0.5),
        'moe_w3': nrm(ks[18], (DEPTH, N_EXPERTS, D_MODEL, D_EXPERT), D_MODEL ** -0.5),
        'moe_w2': nrm(ks[19], (DEPTH, N_EXPERTS, D_EXPERT, D_MODEL), D_EXPERT ** -0.5),
        'final_norm': 1.0 + nrm(ks[20], (D_MODEL,), 0.02),
    }


def reference(x, c, ctx, c_ctx, w_mod, b_mod, norm_mix, norm_ffn, attn_w_qkv, attn_q_norm, attn_k_norm,
              attn_w_o, fourier_w_o, moe_w_rg, moe_b_rg, moe_w_re, moe_b_re, moe_w1, moe_w3, moe_w2,
              final_norm):
    n_tok = x.shape[1]
    rows = n_tok // GRID_W
    rope = _axial_rope_tables(rows, x.dtype)
    silu_c = jax.nn.silu(c)[:, None, :]
    silu_cc = jax.nn.silu(c_ctx)[None, None, :]
    s_ctx = ctx
    for i in range(DEPTH):
        kind = i % N_MIXERS
        j = i // N_MIXERS
        ctx_next = _context_needed_after(i)
        moe_p = (moe_w_rg[i], moe_b_rg[i], moe_w_re[i], moe_b_re[i], moe_w1[i], moe_w3[i], moe_w2[i])
        sh1, sc1, g1, sh2, sc2, g2 = _ada_params(silu_c, w_mod[i], b_mod[i])
        h = _modulate(x, norm_mix[i], sh1, sc1)
        if kind == 0 or ctx_next:
            csh1, csc1, cg1, csh2, csc2, cg2 = _ada_params(silu_cc, w_mod[i], b_mod[i])
            h_c = _modulate(s_ctx, norm_mix[i], csh1, csc1)
        if kind == 0:
            y, y_c = _gqa_attention(h, h_c, attn_w_qkv[j], attn_q_norm[j], attn_k_norm[j], attn_w_o[j],
                                    rope, ctx_next)
        else:
            y = _fourier_mix(h, fourier_w_o[j])
            y_c = _fourier_mix(h_c, fourier_w_o[j]) if ctx_next else None
        x = x + g1 * y
        x = x + g2 * _hier_moe(_modulate(x, norm_ffn[i], sh2, sc2), *moe_p)
        if ctx_next:
            s_ctx = s_ctx + cg1 * y_c
            s_ctx = s_ctx + cg2 * _hier_moe(_modulate(s_ctx, norm_ffn[i], csh2, csc2), *moe_p)
    return _rms_norm(x, final_norm)
```

```cpp
#include <hip/hip_runtime.h>
#include <hip/hip_bf16.h>
#include <cstdio>
#include <cstdint>
#include <cmath>

#ifndef PHMASK
#define PHMASK 0xFFFF
#endif
#define PH_EN(k) (((PHMASK) >> (k)) & 1)
#ifndef MK_N_LAUNCHES
#define MK_N_LAUNCHES 1
#endif

constexpr int NB = 8, SEQ = 4096, DM = 1024, NT_TOK = NB * SEQ, CTXL = 256, NCTX = NB * CTXL, LK = SEQ + CTXL;
constexpr int NHEAD = 16, NKVH = 4, HD = 64, QKVN = 1536, KVP = 256;
constexpr int NEXP = 32, DEXP = 512, NGRP = 4, EPG = 8;
constexpr float EPS = 1e-6f;

namespace pg8 {
#define PG8_LAS __attribute__((address_space(3)))
typedef unsigned short bf16_t;
typedef short bf16x8 __attribute__((ext_vector_type(8)));
typedef float f32x4 __attribute__((ext_vector_type(4)));
typedef unsigned u32x4 __attribute__((ext_vector_type(4)));
typedef unsigned u32x2 __attribute__((ext_vector_type(2)));
constexpr int BM = 256, BK = 64, HALF = 128, HTB = HALF * BK * 2, STAGE_BYTES = 8 * HTB, NXCD = 8, WGM = 8;

__host__ __device__ __forceinline__ int lds_byte(int r, int c) { const int st = (r >> 4) * 2 + (c >> 5), rr = r & 15, cc = c & 31, ob = rr * 64 + cc * 2; return st * 1024 + (ob ^ (((ob >> 9) & 1) << 5)); }
__host__ __device__ __forceinline__ void stage_rc(int b, int& R, int& C) { const int st = b / 1024, sb = b % 1024, swz = sb ^ (((sb >> 9) & 1) << 5); R = (st >> 1) * 16 + swz / 64; C = (st & 1) * 32 + (swz % 64) / 2; }
__host__ __device__ __forceinline__ int perm32(int rho) { const int n = rho >> 4, i = rho & 15; return 8 * (i >> 2) + 4 * n + (i & 3); }

struct Unit { int pm, pn, e, r0, cnt, rb, ui; };

__device__ __forceinline__ int xcd_remap(int wgid, int nwg) { const int q = nwg / NXCD, r = nwg % NXCD, xcd = wgid % NXCD, off = wgid / NXCD; return (xcd < r ? xcd * (q + 1) : r * (q + 1) + (xcd - r) * q) + off; }

struct StaticOrder {
    int nM, nN, nwg, G, c;
    __device__ void init(int nM_, int nN_, int G_, int c_) { nM = nM_; nN = nN_; nwg = nM * nN; G = G_; c = c_; }
    __device__ bool next(int i, Unit& u) const {
        const long L = (long)i * G + c; if (L >= nwg) return false;
        const int wgid = xcd_remap((int)L, nwg);
        const int nig = WGM * nN, gid = wgid / nig, fm = gid * WGM, gsz = (nM - fm) < WGM ? (nM - fm) : WGM;
        u.pm = fm + ((wgid % nig) % gsz); u.pn = (wgid % nig) / gsz; u.e = 0; u.r0 = 0; u.cnt = 0; u.rb = 0; u.ui = i; return true;
    }
};

__device__ __forceinline__ unsigned cvt_pk_bf16(float lo, float hi) { unsigned r; asm volatile("v_cvt_pk_bf16_f32 %0, %1, %2" : "=v"(r) : "v"(lo), "v"(hi)); return r; }

template <class Prob, class Epi, class Sched, bool ALIGN_EPI>
__device__ __forceinline__ void gemm_phase(PG8_LAS unsigned char* lds, const Prob& P, const Sched& S, const Epi& E) {
    const int tid = threadIdx.x, wid = __builtin_amdgcn_readfirstlane(tid >> 6), lane = tid & 63, wr = wid >> 2, wc = wid & 3, fr = lane & 15, fq = lane >> 4;
    const int nt = P.nt;
    int Rr[2], Cc[2];
    unsigned voffA[2], voffB[2];
#pragma unroll
    for (int i = 0; i < 2; ++i) { stage_rc(tid * 16 + i * 8192, Rr[i], Cc[i]); voffA[i] = P.a_voff(Rr[i], Cc[i]); voffB[i] = P.b_voff(Rr[i], Cc[i]); }
    const size_t hstepA = P.a_hstep(), hstepB = P.b_hstep();
    const unsigned ldsw = (unsigned)wid * 1024u;
    const int aoff = lds_byte(wr * 64 + fr, fq * 8), boff = lds_byte(wc * 32 + fr, fq * 8);
    unsigned cva0[2] = {0, 0}, cva1[2] = {0, 0}, nva0[2] = {0, 0}, nva1[2] = {0, 0};
    const PG8_LAS unsigned* tab = (const PG8_LAS unsigned*)(lds + Prob::tab_off);
#define PG8_SA(b, h) (((b) * 2 + (h)) * HTB)
#define PG8_SB(b, h) ((4 + (b) * 2 + (h)) * HTB)
#define PG8_STAGE(bufoff, gbase, voff) do { _Pragma("unroll") for (int _i = 0; _i < 2; ++_i) \
        __builtin_amdgcn_global_load_lds((const unsigned*)((const char*)(gbase) + (voff)[_i]), (PG8_LAS unsigned*)(lds + (bufoff) + ldsw + _i * 8192), 16, 0, 0); } while (0)
#define PG8_LDA(dst, b, h) do { _Pragma("unroll") for (int m = 0; m < 4; ++m) _Pragma("unroll") for (int k = 0; k < 2; ++k) dst[m][k] = *(const PG8_LAS bf16x8*)(lds + PG8_SA(b, h) + aoff + m * 2048 + k * 1024); } while (0)
#define PG8_LDB(dst, b, h) do { _Pragma("unroll") for (int n = 0; n < 2; ++n) _Pragma("unroll") for (int k = 0; k < 2; ++k) dst[n][k] = *(const PG8_LAS bf16x8*)(lds + PG8_SB(b, h) + boff + n * 2048 + k * 1024); } while (0)
#define PG8_MMA(ai, bj, At, Bt) do { __builtin_amdgcn_s_setprio(1); _Pragma("unroll") for (int m = 0; m < 4; ++m) _Pragma("unroll") for (int n = 0; n < 2; ++n) _Pragma("unroll") for (int k = 0; k < 2; ++k) \
        acc[ai][bj][m][n] = __builtin_amdgcn_mfma_f32_16x16x32_bf16(Bt[n][k], At[m][k], acc[ai][bj][m][n], 0, 0, 0); __builtin_amdgcn_s_setprio(0); } while (0)
#define PG8_WAIT_V(n) asm volatile("s_waitcnt vmcnt(" #n ")" ::: "memory")
#define PG8_WAIT_L(n) asm volatile("s_waitcnt lgkmcnt(" #n ")" ::: "memory")
#define PG8_BAR __builtin_amdgcn_s_barrier()
#define PG8_SCHED __builtin_amdgcn_sched_barrier(0)
#define PG8_STAGE_A(bufoff, gb, h, VO0, VO1) do { if constexpr (Prob::GATHER) { if ((h) == 0) PG8_STAGE(bufoff, gb, VO0); else PG8_STAGE(bufoff, gb, VO1); } else { PG8_STAGE(bufoff, (gb) + (h) * hstepA, voffA); } } while (0)
    Unit cur, nxt; int ui = 0;
    if (!S.next(0, cur)) return;
    f32x4 acc[2][2][4][2];
#pragma unroll
    for (int a = 0; a < 2; ++a)
#pragma unroll
        for (int b = 0; b < 2; ++b)
#pragma unroll
            for (int m = 0; m < 4; ++m)
#pragma unroll
                for (int n = 0; n < 2; ++n) acc[a][b][m][n] = (f32x4){0.f, 0.f, 0.f, 0.f};
    bf16x8 At[4][2], B0[2][2], B1[2][2];
    const char* cA = P.a_unit(cur); const char* cB = P.b_unit(cur);
    if constexpr (Prob::GATHER) {
#pragma unroll
        for (int i = 0; i < 2; ++i) { cva0[i] = tab[cur.ui * 256 + Rr[i]] + (unsigned)Cc[i] * 2u; cva1[i] = tab[cur.ui * 256 + 128 + Rr[i]] + (unsigned)Cc[i] * 2u; }
    }
    PG8_STAGE(PG8_SB(0, 0), cB + P.b_kt(0), voffB); PG8_STAGE(PG8_SB(0, 1), cB + P.b_kt(0) + hstepB, voffB); PG8_STAGE_A(PG8_SA(0, 0), cA + P.a_kt(0), 0, cva0, cva1); PG8_STAGE_A(PG8_SA(0, 1), cA + P.a_kt(0), 1, cva0, cva1);
    if (wr == 1) PG8_BAR;
    PG8_WAIT_V(2); PG8_BAR;
    PG8_STAGE(PG8_SB(1, 0), cB + P.b_kt(1), voffB); PG8_STAGE_A(PG8_SA(1, 0), cA + P.a_kt(1), 0, cva0, cva1); PG8_STAGE(PG8_SB(1, 1), cB + P.b_kt(1) + hstepB, voffB);
    PG8_WAIT_V(6); PG8_BAR;
    for (;;) {
        const bool has_next = S.next(ui + 1, nxt);
        const char* nA = has_next ? P.a_unit(nxt) : cA; const char* nB = has_next ? P.b_unit(nxt) : cB;
        if constexpr (Prob::GATHER) {
            const int nu = has_next ? nxt.ui : cur.ui;
#pragma unroll
            for (int i = 0; i < 2; ++i) { nva0[i] = tab[nu * 256 + Rr[i]] + (unsigned)Cc[i] * 2u; nva1[i] = tab[nu * 256 + 128 + Rr[i]] + (unsigned)Cc[i] * 2u; }
        }
        for (int t = 0; t < nt; t += 2) {
            const bool last = (t == nt - 2);
            const char* a1 = cA + P.a_kt(t + 1);
            const char* a2 = last ? nA + P.a_kt(0) : cA + P.a_kt(t + 2); const char* b2 = last ? nB + P.b_kt(0) : cB + P.b_kt(t + 2);
            const char* a3 = last ? nA + P.a_kt(1) : cA + P.a_kt(t + 3); const char* b3 = last ? nB + P.b_kt(1) : cB + P.b_kt(t + 3);
            unsigned sv0[2] = {0, 0}, sv1[2] = {0, 0};
            if constexpr (Prob::GATHER) {
#pragma unroll
                for (int i = 0; i < 2; ++i) { sv0[i] = last ? nva0[i] : cva0[i]; sv1[i] = last ? nva1[i] : cva1[i]; }
            }
            PG8_LDB(B0, 0, 0); PG8_LDB(B1, 0, 1); PG8_SCHED; PG8_LDA(At, 0, 0); PG8_STAGE_A(PG8_SA(1, 1), a1, 1, cva0, cva1);
            PG8_WAIT_V(8); PG8_WAIT_L(0); PG8_BAR; PG8_MMA(0, 0, At, B0); PG8_MMA(0, 1, At, B1); PG8_BAR; PG8_SCHED;
            PG8_LDA(At, 0, 1); PG8_STAGE(PG8_SB(0, 0), b2, voffB); PG8_STAGE(PG8_SB(0, 1), b2 + hstepB, voffB); PG8_STAGE_A(PG8_SA(0, 0), a2, 0, sv0, sv1);
            PG8_WAIT_V(8); PG8_WAIT_L(0); PG8_BAR; PG8_MMA(1, 0, At, B0); PG8_MMA(1, 1, At, B1); PG8_BAR; PG8_SCHED;
            PG8_LDB(B0, 1, 0); PG8_LDB(B1, 1, 1); PG8_SCHED; PG8_LDA(At, 1, 0); PG8_STAGE_A(PG8_SA(0, 1), a2, 1, sv0, sv1);
            PG8_WAIT_V(8); PG8_WAIT_L(0); PG8_BAR; PG8_MMA(0, 0, At, B0); PG8_MMA(0, 1, At, B1); PG8_BAR; PG8_SCHED;
            PG8_LDA(At, 1, 1); PG8_STAGE(PG8_SB(1, 0), b3, voffB); PG8_STAGE(PG8_SB(1, 1), b3 + hstepB, voffB); PG8_STAGE_A(PG8_SA(1, 0), a3, 0, sv0, sv1);
            PG8_WAIT_V(8); PG8_WAIT_L(0); PG8_BAR; PG8_MMA(1, 0, At, B0); PG8_MMA(1, 1, At, B1); PG8_BAR; PG8_SCHED;
        }
        if constexpr (ALIGN_EPI) { if (wr == 0) PG8_BAR; }
        E(acc, cur, wr, wc, fr, fq);
        if (!has_next) break;
#pragma unroll
        for (int a = 0; a < 2; ++a)
#pragma unroll
            for (int b = 0; b < 2; ++b)
#pragma unroll
                for (int m = 0; m < 4; ++m)
#pragma unroll
                    for (int n = 0; n < 2; ++n) acc[a][b][m][n] = (f32x4){0.f, 0.f, 0.f, 0.f};
        cur = nxt; cA = nA; cB = nB; ++ui;
        if constexpr (Prob::GATHER) {
#pragma unroll
            for (int i = 0; i < 2; ++i) { cva0[i] = nva0[i]; cva1[i] = nva1[i]; }
        }
        if constexpr (ALIGN_EPI) { if (wr == 1) PG8_BAR; }
    }
    PG8_WAIT_V(0);
    if constexpr (!ALIGN_EPI) { if (wr == 0) PG8_BAR; }
    PG8_BAR;
#undef PG8_SA
#undef PG8_SB
#undef PG8_STAGE
#undef PG8_STAGE_A
#undef PG8_LDA
#undef PG8_LDB
#undef PG8_MMA
#undef PG8_WAIT_V
#undef PG8_WAIT_L
#undef PG8_BAR
#undef PG8_SCHED
}
}

namespace attn_body {
using bf16=__hip_bfloat16;
using bf16x8=__attribute__((ext_vector_type(8)))short;
using s16x4=__attribute__((ext_vector_type(4)))short;
using f32x16=__attribute__((ext_vector_type(16)))float;
using u32x4=__attribute__((ext_vector_type(4)))unsigned;
constexpr int D=64,QP=1024,KP=256;
constexpr int NW=8,QBLK=32,QB=QBLK*NW,KVBLK=64;
__device__ __forceinline__ int crow(int r,int hi){return (r&3)+8*(r>>2)+4*hi;}
#define SBAR() __builtin_amdgcn_sched_barrier(0)
constexpr int NSLOT=3, SLOTB=8192;
constexpr int LDS_K=0, LDS_V=NSLOT*SLOTB, LDS_WS=2*NSLOT*SLOTB, LDS_OST=LDS_WS+NW*64*4, LDS_BYTES=LDS_OST+NW*4096;
constexpr float C2=0.125f*1.4426950408889634f;
__device__ __forceinline__ void glds16(const void*gsrc,unsigned lds_dst){unsigned keep;
  asm volatile("s_mov_b32 %0, m0\n\ts_mov_b32 m0, %2\n\ts_nop 0\n\tglobal_load_lds_dwordx4 %1, off\n\ts_mov_b32 m0, %0":"=&s"(keep):"v"(gsrc),"s"(lds_dst):"memory");}
__device__ __forceinline__ float max3f(float a,float b,float c){float r;asm("v_max3_f32 %0, %1, %2, %3":"=v"(r):"v"(a),"v"(b),"v"(c));return r;}
__device__ __forceinline__ float max2f(float a,float b){float r;asm("v_max_f32_e32 %0, %1, %2":"=v"(r):"v"(a),"v"(b));return r;}
__device__ __forceinline__ float fadd_s(float a,float b){float r;asm("v_add_f32_e32 %0, %1, %2":"=v"(r):"v"(a),"v"(b));return r;}
__device__ __forceinline__ float fsub_s(float a,float b){float r;asm("v_sub_f32_e32 %0, %1, %2":"=v"(r):"v"(a),"v"(b));return r;}
typedef float f32x2_t __attribute__((ext_vector_type(2))); typedef __bf16 bf16x2_t __attribute__((ext_vector_type(2)));
__device__ __forceinline__ unsigned cvtpk_s(float lo,float hi){f32x2_t v={lo,hi};bf16x2_t b=__builtin_convertvector(v,bf16x2_t);return __builtin_bit_cast(unsigned,b);}
#define WAIT_BAR(N) asm volatile("s_waitcnt vmcnt(" #N ") lgkmcnt(0)\n\ts_barrier":::"memory")

__device__ __forceinline__ void qkt(f32x16&p0,f32x16&p1,const char*Kslot,const bf16x8*qr,const f32x16&negm,int r32,int hi){
  const char*kb=Kslot+hi*1024+r32*16;
  #pragma unroll
  for(int d0=0;d0<4;++d0){
    const bf16x8 b0=*reinterpret_cast<const bf16x8*>(kb+d0*2048);
    const bf16x8 b1=*reinterpret_cast<const bf16x8*>(kb+d0*2048+512);
    if(d0==0){p0=__builtin_amdgcn_mfma_f32_32x32x16_bf16(b0,qr[0],negm,0,0,0);p1=__builtin_amdgcn_mfma_f32_32x32x16_bf16(b1,qr[0],negm,0,0,0);}
    else{p0=__builtin_amdgcn_mfma_f32_32x32x16_bf16(b0,qr[d0],p0,0,0,0);p1=__builtin_amdgcn_mfma_f32_32x32x16_bf16(b1,qr[d0],p1,0,0,0);}}
}
typedef __attribute__((address_space(3))) const char* lds_cptr;
typedef short v4i16_t __attribute__((ext_vector_type(4)));
__device__ __forceinline__ void kload8(bf16x8*kf,lds_cptr kp){
  kf[0]=*(const __attribute__((address_space(3))) bf16x8*)(kp);      kf[1]=*(const __attribute__((address_space(3))) bf16x8*)(kp+512);
  kf[2]=*(const __attribute__((address_space(3))) bf16x8*)(kp+2048); kf[3]=*(const __attribute__((address_space(3))) bf16x8*)(kp+2560);
  kf[4]=*(const __attribute__((address_space(3))) bf16x8*)(kp+4096); kf[5]=*(const __attribute__((address_space(3))) bf16x8*)(kp+4608);
  kf[6]=*(const __attribute__((address_space(3))) bf16x8*)(kp+6144); kf[7]=*(const __attribute__((address_space(3))) bf16x8*)(kp+6656);
}
__device__ __forceinline__ void kload2(bf16x8*kf,lds_cptr kp,int j){ kf[2*j]=*(const __attribute__((address_space(3))) bf16x8*)(kp+j*2048); kf[2*j+1]=*(const __attribute__((address_space(3))) bf16x8*)(kp+j*2048+512); }
__device__ __forceinline__ s16x4 vtr(lds_cptr p){ return __builtin_bit_cast(s16x4,__builtin_amdgcn_ds_read_tr16_b64_v4i16((__attribute__((address_space(3))) v4i16_t*)p)); }
__device__ __forceinline__ float rowmax(const f32x16&p0,const f32x16&p1){
  float a=max3f(p0[0],p0[1],p1[0]),b=max3f(p0[2],p0[3],p1[1]);a=max3f(a,p1[2],p1[3]);
  #pragma unroll
  for(int r=4;r<16;r+=4){a=max3f(a,p0[r],p0[r+1]);b=max3f(b,p0[r+2],p0[r+3]);a=max3f(a,p1[r],p1[r+1]);b=max3f(b,p1[r+2],p1[r+3]);}
  const float m=max2f(a,b);
  auto rr=__builtin_amdgcn_permlane32_swap(__float_as_uint(m),__float_as_uint(m),false,false);
  return max2f(__uint_as_float(rr[0]),__uint_as_float(rr[1]));
}
__device__ __forceinline__ void pv(f32x16*o,int vb,bf16x8 pa0,bf16x8 pa1,bf16x8 pa2,bf16x8 pa3){
  #pragma unroll
  for(int d0=0;d0<2;++d0){s16x4 lo[4],hi[4];
    #pragma unroll
    for(int ks=0;ks<4;++ks){
      asm volatile("ds_read_b64_tr_b16 %0,%1 offset:%c2":"=&v"(lo[ks]):"v"(vb),"i"(d0*4096+ks*1024):"memory");
      asm volatile("ds_read_b64_tr_b16 %0,%1 offset:%c2":"=&v"(hi[ks]):"v"(vb),"i"(d0*4096+ks*1024+512):"memory");}
    asm volatile("s_waitcnt lgkmcnt(0)":::"memory");SBAR();
    #define PK(k) (bf16x8){lo[k][0],lo[k][1],lo[k][2],lo[k][3],hi[k][0],hi[k][1],hi[k][2],hi[k][3]}
    o[d0]=__builtin_amdgcn_mfma_f32_32x32x16_bf16(pa0,PK(0),o[d0],0,0,0);
    o[d0]=__builtin_amdgcn_mfma_f32_32x32x16_bf16(pa1,PK(1),o[d0],0,0,0);
    o[d0]=__builtin_amdgcn_mfma_f32_32x32x16_bf16(pa2,PK(2),o[d0],0,0,0);
    o[d0]=__builtin_amdgcn_mfma_f32_32x32x16_bf16(pa3,PK(3),o[d0],0,0,0);
    #undef PK
  }
}
#define ATTN_STORE16(p,v) (*(u32x4*)(p)=(v))
template<int THRL,int NT> __device__ __forceinline__ void attn_unit(const bf16*Qu,const bf16*__restrict__ Kh,const bf16*__restrict__ Vh,bf16*Ou,char*shm){
  const int tid=threadIdx.x,lane=tid&63,r32=lane&31,hi=lane>>5; const int wid=__builtin_amdgcn_readfirstlane(tid>>6);
  const bf16*Qw=Qu+(long)(wid*QBLK)*QP;
  const unsigned lds0=(unsigned)(uintptr_t)shm;
  float*wsf=(float*)(shm+LDS_WS)+wid*64;
  const bf16*ksrc=Kh+(long)lane*KP+wid*8;
  const bf16*vsrc=Vh+(long)(16*(wid&3)+(lane>>2))*KP+(wid>>2)*32+(lane&3)*8;
  const unsigned kdst=lds0+LDS_K+wid*1024, vdst=lds0+LDS_V+wid*1024;
  #define DMA_K(t,slot) glds16(ksrc+(long)(t)*KVBLK*KP,(unsigned)__builtin_amdgcn_readfirstlane(kdst+(slot)))
  #define DMA_V(t,slot) glds16(vsrc+(long)(t)*KVBLK*KP,(unsigned)__builtin_amdgcn_readfirstlane(vdst+(slot)))
  const int vb0=(int)(lds0+LDS_V)+((lane>>4)&1)*32+(lane&3)*8+(4*hi+((lane&15)>>2))*64;
  const char*Kbase=shm+LDS_K; bf16x8 kf[8];
  const lds_cptr shm3=(lds_cptr)shm; const lds_cptr kp0=shm3+LDS_K+hi*1024+r32*16; const lds_cptr vp0=shm3+LDS_V+((lane>>4)&1)*32+(lane&3)*8+(4*hi+((lane&15)>>2))*64;
  DMA_K(0,0);DMA_V(0,0);DMA_K(1,SLOTB);
  bf16x8 qr[4];
  #pragma unroll
  for(int d0=0;d0<4;++d0)qr[d0]=*reinterpret_cast<const bf16x8*>(&Qw[(long)r32*QP+d0*16+hi*8]);
  float mhat=0.f,l_reg=0.f;f32x16 o[2];o[0]=f32x16{};o[1]=f32x16{};f32x16 negm=f32x16{};asm volatile("":"+v"(negm));
  bool resc=false;
  #define START(P0,P1) do{ const float rm=rowmax(P0,P1); resc=false; \
    { const float dl=rm; mhat=fadd_s(mhat,dl); \
      _Pragma("unroll") for(int r=0;r<16;++r){P0[r]=fsub_s(P0[r],dl);P1[r]=fsub_s(P1[r],dl);} \
      _Pragma("unroll") for(int r=0;r<16;++r)negm[r]=-mhat; asm volatile("":"+v"(negm)); } \
    _Pragma("unroll") for(int r=0;r<16;++r)P0[r]=__builtin_amdgcn_exp2f(P0[r]); }while(0)
  #define RESC() do{ if(resc){ asm volatile("s_waitcnt lgkmcnt(0)":::"memory"); \
      _Pragma("unroll") for(int d_=0;d_<2;++d_) _Pragma("unroll") for(int r=0;r<16;++r)o[d_][r]*=wsf[crow(r,hi)]; } }while(0)
  f32x16 pA0,pA1,pB0,pB1;
  int sl_prev=0,sl_cur=0,sl_next=SLOTB;
  #define ROT() do{sl_prev=sl_cur;sl_cur=sl_next;sl_next=(sl_next==(NSLOT-1)*SLOTB)?0:sl_next+SLOTB;}while(0)
  DMA_K(2,2*SLOTB);
  WAIT_BAR(3);
  qkt(pA0,pA1,Kbase,qr,negm,r32,hi);asm volatile("s_nop 15\n\ts_nop 7":"+v"(pA0),"+v"(pA1));
  START(pA0,pA1);
  _Pragma("unroll") for(int r=0;r<16;++r)pA1[r]=__builtin_amdgcn_exp2f(pA1[r]);
  WAIT_BAR(0);
  DMA_K(3,0);DMA_V(1,SLOTB);
  ROT();
  kload8(kf,kp0+sl_cur);
  WAIT_BAR(2);
  s16x4 vlo[8],vhi[8]; u32x4 pw0,pw1,pw2,pw3;
  #define PKW(P,B) cvtpk_s(P[B],P[B+1])
  #define PAF(k) __builtin_bit_cast(bf16x8,pw##k)
  #define VFR(i) (bf16x8){vlo[i][0],vlo[i][1],vlo[i][2],vlo[i][3],vhi[i][0],vhi[i][1],vhi[i][2],vhi[i][3]}
  #define PIN(x) asm volatile("":"+v"(x))
  #define MX3(a,b,c) __builtin_fmaxf(__builtin_fmaxf((a),(b)),(c))
  #define GAPA(MF,A0,A1,A2,A3,W0,W1,PW) do{ MF; sacc+=A0; sacc+=A1; sacc+=A2; sacc+=A3; PIN(sacc); W0; W1; PIN(PW); SBAR(); }while(0)
  #define EX(v) __builtin_amdgcn_exp2f(v)
  #define GAPB(MF,X,B) do{ MF; X[B]=EX(X[B]); X[B+1]=EX(X[B+1]); X[B+2]=EX(X[B+2]); X[B+3]=EX(X[B+3]); PIN(X); SBAR(); }while(0)
  #define VRD(i) do{ vlo[i]=vtr(vp_+(((i)>>2)*4096+((i)&3)*1024)); vhi[i]=vtr(vp_+(((i)>>2)*4096+((i)&3)*1024+512)); }while(0)
  #define KRD(G,j) do{ if(G){ kload2(kf,kp0+sl_next,j); SBAR(); } }while(0)
  #define STEP(C0,C1,P0,P1,t,GK,GV,GL) do{ SBAR(); \
    const lds_cptr vp_=vp0+sl_prev; \
    VRD(0); SBAR(); float sacc=(P0[0]+P0[1]); \
    GAPA(C0=__builtin_amdgcn_mfma_f32_32x32x16_bf16(kf[0],qr[0],negm,0,0,0), P0[2],P0[3],P0[4],P0[5],     pw0[0]=PKW(P0,0), pw0[1]=PKW(P0,2), pw0); \
    VRD(4); SBAR(); GAPA(C1=__builtin_amdgcn_mfma_f32_32x32x16_bf16(kf[1],qr[0],negm,0,0,0), P0[6],P0[7],P0[8],P0[9],     pw0[2]=PKW(P0,4), pw0[3]=PKW(P0,6), pw0); \
    VRD(1); SBAR(); GAPA(C0=__builtin_amdgcn_mfma_f32_32x32x16_bf16(kf[2],qr[1],C0,0,0,0),   P0[10],P0[11],P0[12],P0[13], pw1[0]=PKW(P0,8), pw1[1]=PKW(P0,10), pw1); \
    VRD(5); SBAR(); GAPA(C1=__builtin_amdgcn_mfma_f32_32x32x16_bf16(kf[3],qr[1],C1,0,0,0),   P0[14],P0[15],P1[0],P1[1],   pw1[2]=PKW(P0,12),pw1[3]=PKW(P0,14), pw1); \
    VRD(2); SBAR(); GAPA(C0=__builtin_amdgcn_mfma_f32_32x32x16_bf16(kf[4],qr[2],C0,0,0,0),   P1[2],P1[3],P1[4],P1[5],     pw2[0]=PKW(P1,0), pw2[1]=PKW(P1,2), pw2); \
    VRD(6); SBAR(); GAPA(C1=__builtin_amdgcn_mfma_f32_32x32x16_bf16(kf[5],qr[2],C1,0,0,0),   P1[6],P1[7],P1[8],P1[9],     pw2[2]=PKW(P1,4), pw2[3]=PKW(P1,6), pw2); \
    VRD(3); SBAR(); GAPA(C0=__builtin_amdgcn_mfma_f32_32x32x16_bf16(kf[6],qr[3],C0,0,0,0),   P1[10],P1[11],P1[12],P1[13], pw3[0]=PKW(P1,8), pw3[1]=PKW(P1,10), pw3); \
    VRD(7); SBAR(); GAPA(C1=__builtin_amdgcn_mfma_f32_32x32x16_bf16(kf[7],qr[3],C1,0,0,0),   P1[14],P1[15],0.f,0.f,       pw3[2]=PKW(P1,12),pw3[3]=PKW(P1,14), pw3); \
    l_reg+=sacc; \
    if(GK){DMA_K((t)+3,sl_cur);} if(GV){DMA_V((t)+1,sl_next);} \
    { float a=MX3(C0[0],C0[1],C1[0]),b=MX3(C0[2],C0[3],C1[1]); a=MX3(a,C1[2],C1[3]); \
      _Pragma("unroll") for(int r=4;r<16;r+=4){a=MX3(a,C0[r],C0[r+1]);b=MX3(b,C0[r+2],C0[r+3]);a=MX3(a,C1[r],C1[r+1]);b=MX3(b,C1[r+2],C1[r+3]);} \
      float rm=__builtin_fmaxf(a,b); { auto rr=__builtin_amdgcn_permlane32_swap(__float_as_uint(rm),__float_as_uint(rm),false,false); rm=__builtin_fmaxf(__uint_as_float(rr[0]),__uint_as_float(rr[1])); } \
      resc=false; \
      if(__builtin_expect(__any(rm>(float)THRL),0)){ const float dl=__builtin_fmaxf(rm,0.f); mhat+=dl; \
        _Pragma("unroll") for(int r=0;r<16;++r){C0[r]-=dl;C1[r]-=dl;} \
        _Pragma("unroll") for(int r=0;r<16;++r)negm[r]=-mhat; asm volatile("":"+v"(negm)); \
        const float f=__builtin_amdgcn_exp2f(-dl); l_reg*=f; if(hi==0)wsf[r32]=f; resc=true; } } \
    SBAR(); \
    GAPB(o[0]=__builtin_amdgcn_mfma_f32_32x32x16_bf16(PAF(0),VFR(0),o[0],0,0,0), C0,0); \
    GAPB(o[1]=__builtin_amdgcn_mfma_f32_32x32x16_bf16(PAF(0),VFR(4),o[1],0,0,0), C0,4); \
    KRD(GL,0); GAPB(o[0]=__builtin_amdgcn_mfma_f32_32x32x16_bf16(PAF(1),VFR(1),o[0],0,0,0), C0,8); \
    KRD(GL,1); GAPB(o[1]=__builtin_amdgcn_mfma_f32_32x32x16_bf16(PAF(1),VFR(5),o[1],0,0,0), C0,12); \
    KRD(GL,2); GAPB(o[0]=__builtin_amdgcn_mfma_f32_32x32x16_bf16(PAF(2),VFR(2),o[0],0,0,0), C1,0); \
    KRD(GL,3); GAPB(o[1]=__builtin_amdgcn_mfma_f32_32x32x16_bf16(PAF(2),VFR(6),o[1],0,0,0), C1,4); \
    GAPB(o[0]=__builtin_amdgcn_mfma_f32_32x32x16_bf16(PAF(3),VFR(3),o[0],0,0,0), C1,8); \
    GAPB(o[1]=__builtin_amdgcn_mfma_f32_32x32x16_bf16(PAF(3),VFR(7),o[1],0,0,0), C1,12); \
    }while(0)
  int t=1;
  for(;t+5<NT;t+=2){
    STEP(pB0,pB1,pA0,pA1,t,true,true,true);     WAIT_BAR(2); RESC(); ROT();
    STEP(pA0,pA1,pB0,pB1,t+1,true,true,true);   WAIT_BAR(2); RESC(); ROT();
  }
  #define ENDW(tt) do{ if((tt)+3<NT){WAIT_BAR(2);} else if((tt)+2<NT){WAIT_BAR(1);} else {WAIT_BAR(0);} }while(0)
  for(;t+1<NT;t+=2){
    STEP(pB0,pB1,pA0,pA1,t,(t+3<NT),(t+1<NT),(t+1<NT));       ENDW(t);   RESC(); ROT();
    STEP(pA0,pA1,pB0,pB1,t+1,(t+4<NT),(t+2<NT),(t+2<NT));     ENDW(t+1); RESC(); ROT();
  }
  STEP(pB0,pB1,pA0,pA1,NT-1,false,false,false); RESC();
  { float sacc=pB0[0]+pB0[1]; _Pragma("unroll") for(int r=2;r<16;++r)sacc+=pB0[r]; _Pragma("unroll") for(int r=0;r<16;++r)sacc+=pB1[r]; l_reg+=sacc;
    pw0=(u32x4){PKW(pB0,0),PKW(pB0,2),PKW(pB0,4),PKW(pB0,6)};pw1=(u32x4){PKW(pB0,8),PKW(pB0,10),PKW(pB0,12),PKW(pB0,14)};pw2=(u32x4){PKW(pB1,0),PKW(pB1,2),PKW(pB1,4),PKW(pB1,6)};pw3=(u32x4){PKW(pB1,8),PKW(pB1,10),PKW(pB1,12),PKW(pB1,14)};
    SBAR(); pv(o,vb0+sl_cur,PAF(0),PAF(1),PAF(2),PAF(3)); }
  #undef PKW
  #undef PAF
  #undef VFR
  #undef PIN
  #undef MX3
  #undef GAPA
  #undef GAPB
  #undef EX
  #undef VRD
  #undef KRD
  #undef STEP
  #undef ENDW
  {auto rr=__builtin_amdgcn_permlane32_swap(__float_as_uint(l_reg),__float_as_uint(l_reg),false,false);l_reg=__uint_as_float(rr[0])+__uint_as_float(rr[1]);}
  if(hi==0)wsf[32+r32]=l_reg;asm volatile("s_waitcnt lgkmcnt(0)":::"memory");
  float rli[16];
  #pragma unroll
  for(int r=0;r<16;++r)rli[r]=__builtin_amdgcn_rcpf(wsf[32+crow(r,hi)]);
  bf16*Ow=Ou+(long)(wid*QBLK)*QP;
  { bf16*stg=(bf16*)(shm+LDS_OST)+wid*2048;
    #pragma unroll
    for(int r=0;r<16;++r){const int orow=crow(r,hi);
      #pragma unroll
      for(int d0=0;d0<2;++d0)stg[orow*64+d0*32+r32]=__float2bfloat16(o[d0][r]*rli[r]);}
    asm volatile("s_waitcnt lgkmcnt(0)":::"memory");
    #pragma unroll
    for(int i=0;i<4;++i){const int row=i*8+(lane>>3),ch=lane&7; const u32x4 v=*(const u32x4*)(stg+row*64+ch*8); ATTN_STORE16(Ow+(long)row*QP+ch*8,v);} }
  asm volatile("s_waitcnt lgkmcnt(0)\n\ts_barrier":::"memory");
  #undef DMA_K
  #undef DMA_V
  #undef START
  #undef RESC
  #undef ROT
}
#undef SBAR
#undef WAIT_BAR
}

constexpr int NWAVES = 8;
constexpr int N_LAUNCHES = MK_N_LAUNCHES;
constexpr int N_PHASES = 16;

constexpr size_t MiB = 1u << 20;
constexpr size_t WS_CTL = 0, CTL_ZERO_BYTES = 1 * MiB;
constexpr size_t WS_MOD = 1 * MiB;
constexpr size_t WS_ROPE = 1 * MiB + 512 * 1024;
constexpr size_t WS_RBIAS = WS_ROPE + 16 * 1024;
constexpr size_t WS_DFTC = 1 * MiB + 768 * 1024;
constexpr size_t WS_RW = 2 * MiB;
constexpr size_t WS_WQKV = 6 * MiB, WS_WO = 9 * MiB, WS_WF = 11 * MiB;
constexpr size_t WS_LIST = 13 * MiB;
constexpr size_t WS_GATE = 17 * MiB;
constexpr size_t WS_W13 = 18 * MiB;
constexpr size_t WS_W2 = 146 * MiB;
constexpr size_t WS_DFTS = 210 * MiB;
constexpr size_t WS_XN = 274 * MiB;
constexpr size_t WS_XNC = 338 * MiB;
constexpr size_t WS_QO = 342 * MiB;
constexpr size_t WS_K = 406 * MiB, WS_V = 423 * MiB;
constexpr size_t WS_H1 = 342 * MiB;
constexpr size_t WS_Y = 440 * MiB;
constexpr size_t WS_END = 568 * MiB;
constexpr int CW_TMO = 0, CW_CODE = 1, CW_BAR = 4096, CW_CNT = 16384;

constexpr int RING_OFF = 0, RING_BYTES = 131072;
constexpr int LDSCTL_OFF = RING_BYTES, MISC_OFF = LDSCTL_OFF + 320;
constexpr int TS_OFF = LDSCTL_OFF + 512;
constexpr int HIST_OFF = LDSCTL_OFF + 1024;
constexpr int GTAB_OFF = LDSCTL_OFF + 2048;
constexpr int LDS_BYTES = 147456;

#define GAS __attribute__((address_space(1)))
#define LAS __attribute__((address_space(3)))
typedef unsigned short bf16;
typedef unsigned v4u __attribute__((ext_vector_type(4)));
typedef unsigned v2u __attribute__((ext_vector_type(2)));
typedef float f32x4 __attribute__((ext_vector_type(4)));
typedef short bf16x8 __attribute__((ext_vector_type(8)));
typedef GAS unsigned gu32;
#define RLX_AGENT __ATOMIC_RELAXED, __HIP_MEMORY_SCOPE_AGENT
#define LDS_WAIT() asm volatile("s_waitcnt lgkmcnt(0)" ::: "memory")
#define VM_WAIT() asm volatile("s_waitcnt vmcnt(0)" ::: "memory")
__device__ __forceinline__ unsigned f2bf(float f) { unsigned u = __builtin_bit_cast(unsigned, f); return (u + 0x7fffu + ((u >> 16) & 1u)) >> 16; }
__device__ __forceinline__ unsigned pk2(float lo, float hi) { return f2bf(lo) | (f2bf(hi) << 16); }
__device__ __forceinline__ float bf2f(unsigned h) { return __builtin_bit_cast(float, h << 16); }

#define XB_TMO      128
#define XB_XCNT(j)  (256  + 64 * (j))
#define XB_XSUB(j)  (1280 + 64 * (j))
#define XB_XGEN(j)  (2304 + 64 * (j))
#define XB_TOP      3328
#define XB_TOPGEN   3392
#define XCD_BAR_WORDS 3456
#define XB_SPIN_CAP (1u << 18)
__device__ __forceinline__ unsigned xb_ld(unsigned* p)              { return __hip_atomic_load(p, __ATOMIC_RELAXED, __HIP_MEMORY_SCOPE_AGENT); }
__device__ __forceinline__ unsigned xb_add(unsigned* p, unsigned v) { return __hip_atomic_fetch_add(p, v, __ATOMIC_RELAXED, __HIP_MEMORY_SCOPE_AGENT); }
__device__ __forceinline__ unsigned xb_xcc_id() { return (unsigned)__builtin_amdgcn_s_getreg((3 << 11) | 20) & 0xFu; }
#define XB_SPIN(cond, bar) do { unsigned _sp = 0; while (cond) { __builtin_amdgcn_s_sleep(1); \
    if ((++_sp & 255u) == 0u) { if (xb_ld(&(bar)[XB_TMO])) break; if (_sp > XB_SPIN_CAP) { atomicAdd(&(bar)[XB_TMO], 1u); break; } } } } while (0)
struct XcdBarrier { unsigned* bar; unsigned x; volatile LAS unsigned* st; };
__device__ __forceinline__ XcdBarrier xcd_barrier_post(unsigned* bar, volatile LAS unsigned* st) {
    XcdBarrier b; b.bar = bar; b.x = xb_xcc_id(); b.st = st;
    if (threadIdx.x == 0) (void)xb_add(&bar[XB_XCNT(b.x)], 1u);
    return b;
}
__device__ __forceinline__ void xcd_barrier_complete(unsigned* bar, unsigned x, unsigned& nloc, unsigned& nx) {
    const unsigned G = gridDim.x * gridDim.y * gridDim.z;
    unsigned sum, cnt, mine, sp = 0u;
    for (;;) {
        sum = 0u; cnt = 0u; mine = 0u;
#pragma unroll
        for (unsigned j = 0; j < 16; ++j) { const unsigned c = xb_ld(&bar[XB_XCNT(j)]); sum += c; cnt += (c > 0u) ? 1u : 0u; mine = (j == x) ? c : mine; }
        if (sum == G) break;
        __builtin_amdgcn_s_sleep(1);
        if ((++sp & 255u) == 0u) { if (xb_ld(&bar[XB_TMO])) break; if (sp > XB_SPIN_CAP) { atomicAdd(&bar[XB_TMO], 1u); break; } }
    }
    nloc = mine > 0u ? mine : 1u; nx = cnt > 0u ? cnt : 1u;
}
__device__ __forceinline__ void xcd_barrier(const XcdBarrier& b) {
    asm volatile("s_waitcnt vmcnt(0)" ::: "memory");
    __syncthreads();
    if (threadIdx.x == 0) {
        unsigned* bar = b.bar;
        __builtin_amdgcn_s_waitcnt(0);
        unsigned nloc = b.st[0], nx = b.st[1];
        if (nloc == 0u) { xcd_barrier_complete(bar, b.x, nloc, nx); b.st[0] = nloc; b.st[1] = nx; }
        const unsigned old = xb_add(&bar[XB_XSUB(b.x)], 1u);
        const unsigned gen = old / nloc;
        if (old + 1u == (gen + 1u) * nloc) {
            __builtin_amdgcn_fence(__ATOMIC_RELEASE, "agent");
            asm volatile("s_waitcnt vmcnt(0)" ::: "memory");
            const unsigned og = xb_add(&bar[XB_TOP], 1u);
            const unsigned tg = og / nx;
            if (og + 1u == (tg + 1u) * nx) xb_add(&bar[XB_TOPGEN], 1u);
            else XB_SPIN(xb_ld(&bar[XB_TOPGEN]) == tg, bar);
            __builtin_amdgcn_fence(__ATOMIC_ACQUIRE, "agent");
            xb_add(&bar[XB_XGEN(b.x)], 1u);
            asm volatile("s_waitcnt vmcnt(0)" ::: "memory");
        } else {
            XB_SPIN(xb_ld(&bar[XB_XGEN(b.x)]) == gen, bar);
            __builtin_amdgcn_fence(__ATOMIC_ACQUIRE, "agent");
            asm volatile("s_waitcnt vmcnt(0)" ::: "memory");
        }
    }
    __syncthreads();
}

struct Args { const float* in[21]; float* out; unsigned char* ws; int ph_lo, ph_hi; };
struct Frame {
    LAS unsigned char* lds;
    volatile LAS unsigned* MISC;
    gu32* ctl;
    int tid, lane, wave;
    int vcu, G;
    unsigned char* ws;
    float* out;
};
enum { I_X = 0, I_C, I_CTX, I_CCTX, I_WMOD, I_BMOD, I_NMIX, I_NFFN, I_WQKV, I_QN, I_KN, I_WO, I_WF, I_WRG, I_BRG, I_WRE, I_BRE, I_W1, I_W3, I_W2, I_FN };

__device__ __forceinline__ float wave_sum(float v) {
#pragma unroll
    for (int o = 1; o < 64; o <<= 1) v += __shfl_xor(v, o);
    return v;
}

__device__ __forceinline__ void p0_transpose_item(const float* W, int N, bf16* WT, int ldk, int row_off, LAS float* scr, int kb, int nb, int lane) {
    const int k0 = 64 * kb, n0 = 32 * nb;
    f32x4 v[8];
#pragma unroll
    for (int i = 0; i < 8; ++i) v[i] = *(const GAS f32x4*)(W + (size_t)(k0 + (lane >> 3) + 8 * i) * N + n0 + 4 * (lane & 7));
#pragma unroll
    for (int i = 0; i < 8; ++i) { LAS float* d = scr + ((lane >> 3) + 8 * i) * 33 + 4 * (lane & 7); d[0] = v[i].x; d[1] = v[i].y; d[2] = v[i].z; d[3] = v[i].w; }
    LDS_WAIT(); asm volatile("" ::: "memory");
    const int c = lane & 7;
#pragma unroll
    for (int j = 0; j < 4; ++j) { const int n = (lane >> 3) + 8 * j; const LAS float* s = scr + (8 * c) * 33 + n;
        v4u o; o.x = pk2(s[0 * 33], s[1 * 33]); o.y = pk2(s[2 * 33], s[3 * 33]); o.z = pk2(s[4 * 33], s[5 * 33]); o.w = pk2(s[6 * 33], s[7 * 33]);
        *(GAS v4u*)(WT + (size_t)(row_off + n0 + n) * ldk + k0 + 8 * c) = o; }
    LDS_WAIT(); asm volatile("" ::: "memory");
}

__device__ __forceinline__ void p0_prologue(const Args& A, Frame& F) {
    LAS float* L = (LAS float*)(F.lds);
    if (F.vcu < 192) {
        const int l = F.vcu / 96, cg = F.vcu % 96;
        LAS float* sc = L;
        LAS float* part = L + 10240;
        for (int i = F.tid; i < 9 * 1024; i += NWAVES * 64) { const int r = i >> 10, k = i & 1023; const float c = (r < 8) ? A.in[I_C][r * 1024 + k] : A.in[I_CCTX][k]; sc[i] = c / (1.f + __expf(-c)); }
        __syncthreads();
        float acc[9];
#pragma unroll
        for (int r = 0; r < 9; ++r) acc[r] = 0.f;
        const float* wp = A.in[I_WMOD] + (size_t)l * 1024 * 6144 + cg * 64 + F.lane;
        const int kb = F.wave * 128;
#pragma unroll 4
        for (int k = 0; k < 128; ++k) { const float w = wp[(size_t)(kb + k) * 6144];
#pragma unroll
            for (int r = 0; r < 9; ++r) acc[r] += sc[r * 1024 + kb + k] * w; }
#pragma unroll
        for (int r = 0; r < 9; ++r) part[(F.wave * 9 + r) * 64 + F.lane] = acc[r];
        __syncthreads();
        for (int i = F.tid; i < 9 * 64; i += NWAVES * 64) { const int r = i >> 6, c = i & 63; float s = 0.f;
#pragma unroll
            for (int w = 0; w < 8; ++w) s += part[(w * 9 + r) * 64 + c];
            ((float*)(F.ws + WS_MOD))[(l * 9 + r) * 6144 + cg * 64 + c] = s + A.in[I_BMOD][l * 6144 + cg * 64 + c]; }
        __syncthreads();
    }
    LAS float* tab = L + 16384;
    for (int i = F.tid; i < 4096; i += NWAVES * 64) tab[i] = cospif((float)i * (1.0f / 2048.0f));
    __syncthreads();
    const int gw = F.vcu * NWAVES + F.wave, NGW = F.G * NWAVES;
    { bf16* DS = (bf16*)(F.ws + WS_DFTS);
      for (int row = gw; row < 8192; row += NGW) { const int k = row & 4095; const int sh = (row >= 4096) ? 1024 : 0;
#pragma unroll 2
          for (int j = 0; j < 8; ++j) { const int n0 = 512 * j + 8 * F.lane; float v[8];
#pragma unroll
              for (int i = 0; i < 8; ++i) v[i] = tab[((k * (n0 + i)) - sh) & 4095] * (1.0f / 64.0f);
              v4u o; o.x = pk2(v[0], v[1]); o.y = pk2(v[2], v[3]); o.z = pk2(v[4], v[5]); o.w = pk2(v[6], v[7]);
              *(GAS v4u*)(DS + (size_t)row * 4096 + n0) = o; } }
      bf16* DC = (bf16*)(F.ws + WS_DFTC);
      for (int m = gw; m < 256; m += NGW) { const int c0 = 8 * F.lane; float v[8];
#pragma unroll
          for (int i = 0; i < 8; ++i) { const int c = c0 + i; const int cc = c & 255; const int idx = (m * cc * 16) & 4095; v[i] = (c < 256) ? tab[idx] * (1.0f / 16.0f) : -tab[(idx - 1024) & 4095] * (1.0f / 16.0f); }
          v4u o; o.x = pk2(v[0], v[1]); o.y = pk2(v[2], v[3]); o.z = pk2(v[4], v[5]); o.w = pk2(v[6], v[7]);
          *(GAS v4u*)(DC + (size_t)m * 512 + c0) = o; }
      if (F.vcu == F.G - 1) { float* R = (float*)(F.ws + WS_ROPE);
          for (int i = F.tid; i < 1024; i += NWAVES * 64) { const int pos = i >> 4, j = i & 15; const float inv = powf(10000.0f, -(float)j / 16.0f); const float ang = (float)pos * inv; R[i] = cosf(ang); R[1024 + i] = sinf(ang); } }
    }
    __syncthreads();
    LAS float* scr = (LAS float*)(F.lds + F.wave * 16384);
    constexpr int I_QKV = 16 * 48, I_SQ = 16 * 32, I_MOE = 768 * 64;
    constexpr int NITEMS = I_QKV + 2 * I_SQ + I_MOE;
    for (int it = gw; it < NITEMS; it += NGW) {
        int r = it;
        if (r < I_QKV) { p0_transpose_item(A.in[I_WQKV], QKVN, (bf16*)(F.ws + WS_WQKV), 1024, 0, scr, r / 48, r % 48, F.lane); continue; } r -= I_QKV;
        if (r < I_SQ) { p0_transpose_item(A.in[I_WO], 1024, (bf16*)(F.ws + WS_WO), 1024, 0, scr, r / 32, r % 32, F.lane); continue; } r -= I_SQ;
        if (r < I_SQ) { p0_transpose_item(A.in[I_WF], 1024, (bf16*)(F.ws + WS_WF), 1024, 0, scr, r / 32, r % 32, F.lane); continue; } r -= I_SQ;
        const int le = r / 768, q = r % 768;
        if (q < 256) p0_transpose_item(A.in[I_W1] + (size_t)le * 1024 * 512, 512, (bf16*)(F.ws + WS_W13) + (size_t)le * 1024 * 1024, 1024, 0, scr, q / 16, q % 16, F.lane);
        else if (q < 512) p0_transpose_item(A.in[I_W3] + (size_t)le * 1024 * 512, 512, (bf16*)(F.ws + WS_W13) + (size_t)le * 1024 * 1024, 1024, 512, scr, (q - 256) / 16, (q - 256) % 16, F.lane);
        else p0_transpose_item(A.in[I_W2] + (size_t)le * 512 * 1024, 1024, (bf16*)(F.ws + WS_W2) + (size_t)le * 1024 * 512, 512, 0, scr, (q - 512) / 32, (q - 512) % 32, F.lane);
    }
}

struct RowVec { f32x4 v[4]; };
__device__ __forceinline__ RowVec ld_row(const float* p, int lane) { RowVec r; const GAS f32x4* q = (const GAS f32x4*)p + lane;
#pragma unroll
    for (int j = 0; j < 4; ++j) r.v[j] = q[64 * j]; return r; }
__device__ __forceinline__ void st_row(float* p, int lane, const RowVec& r) { GAS f32x4* q = (GAS f32x4*)p + lane;
#pragma unroll
    for (int j = 0; j < 4; ++j) q[64 * j] = r.v[j]; }
__device__ __forceinline__ RowVec ld_row_bf16(const bf16* p, int lane) { RowVec r; const GAS v2u* q = (const GAS v2u*)p + lane;
#pragma unroll
    for (int j = 0; j < 4; ++j) { const v2u w = q[64 * j]; r.v[j] = (f32x4){bf2f(w.x & 0xffffu), bf2f(w.x >> 16), bf2f(w.y & 0xffffu), bf2f(w.y >> 16)}; } return r; }
__device__ __forceinline__ void st_row_bf16(bf16* p, int lane, const RowVec& r) { GAS v2u* q = (GAS v2u*)p + lane;
#pragma unroll
    for (int j = 0; j < 4; ++j) { v2u w; w.x = pk2(r.v[j].x, r.v[j].y); w.y = pk2(r.v[j].z, r.v[j].w); q[64 * j] = w; } }
__device__ __forceinline__ float row_ss(const RowVec& r) { float s = 0.f;
#pragma unroll
    for (int j = 0; j < 4; ++j) s += (r.v[j].x * r.v[j].x + r.v[j].y * r.v[j].y) + (r.v[j].z * r.v[j].z + r.v[j].w * r.v[j].w);
    return wave_sum(s); }
__device__ __forceinline__ void ld_mod(const float* gain, const float* scale, const float* shift, int lane, RowVec& gm, RowVec& sh) {
    const RowVec g = ld_row(gain, lane), s = ld_row(scale, lane); sh = ld_row(shift, lane);
#pragma unroll
    for (int j = 0; j < 4; ++j) gm.v[j] = g.v[j] * (s.v[j] + 1.0f);
}
__device__ __forceinline__ const float* modp(Frame& F, int l, int r, int chunk) { return (const float*)(F.ws + WS_MOD) + (size_t)(l * 9 + r) * 6144 + chunk * 1024; }

__device__ __forceinline__ void p1_phase(const Args& A, Frame& F) {
    const int gw = F.vcu * NWAVES + F.wave, NGW = F.G * NWAVES;
    for (int it = gw; it < NT_TOK / 16; it += NGW) { const int t0 = it * 16, b = t0 / SEQ; RowVec gm, sh; ld_mod(A.in[I_NMIX], modp(F, 0, b, 1), modp(F, 0, b, 0), F.lane, gm, sh);
        for (int r = 0; r < 16; ++r) { RowVec x = ld_row(A.in[I_X] + (size_t)(t0 + r) * DM, F.lane); const float rstd = rsqrtf(row_ss(x) * (1.0f / DM) + EPS);
#pragma unroll
            for (int j = 0; j < 4; ++j) x.v[j] = x.v[j] * rstd * gm.v[j] + sh.v[j];
            st_row_bf16((bf16*)(F.ws + WS_XN) + (size_t)(t0 + r) * DM, F.lane, x); } }
    for (int it = gw; it < NCTX / 16; it += NGW) { const int t0 = it * 16; RowVec gm, sh; ld_mod(A.in[I_NMIX], modp(F, 0, 8, 1), modp(F, 0, 8, 0), F.lane, gm, sh);
        for (int r = 0; r < 16; ++r) { RowVec x = ld_row(A.in[I_CTX] + (size_t)(t0 + r) * DM, F.lane); const float rstd = rsqrtf(row_ss(x) * (1.0f / DM) + EPS);
#pragma unroll
            for (int j = 0; j < 4; ++j) x.v[j] = x.v[j] * rstd * gm.v[j] + sh.v[j];
            st_row_bf16((bf16*)(F.ws + WS_XNC) + (size_t)(t0 + r) * DM, F.lane, x); } }
    for (int it = gw; it < 2 * 8 * 48; it += NGW) { const int l = it / 384, b = (it / 48) % 8, c = it % 48;
        bf16* hi = (bf16*)(F.ws + WS_RW) + ((size_t)((l * 8 + b) * 2 + 0) * 48 + c) * 1024; bf16* lo = hi + 48 * 1024;
        const float* gain = A.in[I_NFFN] + l * 1024; const float* sc2 = modp(F, l, b, 4); const float* sh2 = modp(F, l, b, 3);
        float bs = 0.f;
        for (int j = 0; j < 16; ++j) { const int k = F.lane + 64 * j; float w = 0.f;
            if (c < 4) w = A.in[I_WRG][(size_t)l * 1024 * 4 + k * 4 + c]; else if (c < 36) w = A.in[I_WRE][(size_t)l * 1024 * 32 + k * 32 + (c - 4)];
            const float wp = gain[k] * (1.0f + sc2[k]) * w; const unsigned h = f2bf(wp); hi[k] = (bf16)h; lo[k] = (bf16)f2bf(wp - bf2f(h)); bs += sh2[k] * w; }
        bs = wave_sum(bs);
        if (F.lane == 0) { float br = 0.f; if (c < 4) br = A.in[I_BRG][l * 4 + c]; else if (c < 36) br = A.in[I_BRE][l * 32 + (c - 4)]; ((float*)(F.ws + WS_RBIAS))[(l * 8 + b) * 48 + c] = bs + br; } }
}

using pg8::Unit; using pg8::perm32;
template <bool PERM> struct ProbStd {
    static constexpr bool GATHER = false; static constexpr int tab_off = 0;
    int nt; const char* A; const char* B; int lda2, ldb2;
    __device__ __forceinline__ const char* a_unit(const Unit& u) const { return A + (size_t)u.pm * 256 * lda2; }
    __device__ __forceinline__ size_t a_hstep() const { return (size_t)128 * lda2; }
    __device__ __forceinline__ size_t a_kt(int t) const { return (size_t)t * 128; }
    __device__ __forceinline__ unsigned a_voff(int R, int C) const { return (unsigned)(R * lda2 + C * 2); }
    __device__ __forceinline__ const char* b_unit(const Unit& u) const { return B + (size_t)u.pn * 256 * ldb2; }
    __device__ __forceinline__ size_t b_hstep() const { return (size_t)128 * ldb2; }
    __device__ __forceinline__ size_t b_kt(int t) const { return (size_t)t * 128; }
    __device__ __forceinline__ unsigned b_voff(int R, int C) const { const int Rb = PERM ? ((R & ~31) + perm32(R & 31)) : R; return (unsigned)(Rb * ldb2 + C * 2); }
};
struct ProbQKV {
    static constexpr bool GATHER = false; static constexpr int tab_off = 0;
    int nt; const char* XN; const char* XNC; const char* W;
    __device__ __forceinline__ const char* a_unit(const Unit& u) const { return XN + (size_t)u.e * (size_t)(WS_XNC - WS_XN) + (size_t)u.pm * 256 * 2048; }
    __device__ __forceinline__ size_t a_hstep() const { return (size_t)128 * 2048; }
    __device__ __forceinline__ size_t a_kt(int t) const { return (size_t)t * 128; }
    __device__ __forceinline__ unsigned a_voff(int R, int C) const { return (unsigned)(R * 2048 + C * 2); }
    __device__ __forceinline__ const char* b_unit(const Unit& u) const { return W + (size_t)u.pn * 256 * 2048; }
    __device__ __forceinline__ size_t b_hstep() const { return (size_t)32 * 2048; }
    __device__ __forceinline__ size_t b_kt(int t) const { return (size_t)t * 128; }
    __device__ __forceinline__ unsigned b_voff(int R, int C) const { return (unsigned)((64 * (R >> 5) + (R & 31)) * 2048 + C * 2); }
};
struct ProbUp {
    static constexpr bool GATHER = true; static constexpr int tab_off = GTAB_OFF;
    int nt; const char* XN; const char* W;
    __device__ __forceinline__ const char* a_unit(const Unit&) const { return XN; }
    __device__ __forceinline__ size_t a_hstep() const { return 0; }
    __device__ __forceinline__ size_t a_kt(int t) const { return (size_t)t * 128; }
    __device__ __forceinline__ unsigned a_voff(int, int) const { return 0u; }
    __device__ __forceinline__ const char* b_unit(const Unit& u) const { return W + ((size_t)u.e * 1024 + 128 * u.pn) * 2048; }
    __device__ __forceinline__ size_t b_hstep() const { return (size_t)512 * 2048; }
    __device__ __forceinline__ size_t b_kt(int t) const { return (size_t)t * 128; }
    __device__ __forceinline__ unsigned b_voff(int R, int C) const { const int Rb = (R & ~31) + perm32(R & 31); return (unsigned)(Rb * 2048 + C * 2); }
};
struct ProbDown {
    static constexpr bool GATHER = false; static constexpr int tab_off = 0;
    int nt; const char* H1; const char* W;
    __device__ __forceinline__ const char* a_unit(const Unit& u) const { return H1 + (size_t)u.rb * 1024; }
    __device__ __forceinline__ size_t a_hstep() const { return (size_t)128 * 1024; }
    __device__ __forceinline__ size_t a_kt(int t) const { return (size_t)t * 128; }
    __device__ __forceinline__ unsigned a_voff(int R, int C) const { return (unsigned)(R * 1024 + C * 2); }
    __device__ __forceinline__ const char* b_unit(const Unit& u) const { return W + ((size_t)u.e * 1024 + 256 * u.pn) * 1024; }
    __device__ __forceinline__ size_t b_hstep() const { return (size_t)128 * 1024; }
    __device__ __forceinline__ size_t b_kt(int t) const { return (size_t)t * 128; }
    __device__ __forceinline__ unsigned b_voff(int R, int C) const { const int Rb = (R & ~31) + perm32(R & 31); return (unsigned)(Rb * 1024 + C * 2); }
};
struct ProbC {
    static constexpr bool GATHER = false; static constexpr int tab_off = 0;
    int nt; const char* ZT; const char* DC;
    __device__ __forceinline__ const char* a_unit(const Unit& u) const { return ZT + (((size_t)(u.pm >> 4) * 8192 + (u.pm & 15) * 256) * 1024 + 256 * u.pn) * 2; }
    __device__ __forceinline__ size_t a_hstep() const { return (size_t)128 * 2048; }
    __device__ __forceinline__ size_t a_kt(int t) const { return (size_t)(t & 3) * 128 + (size_t)(t >> 2) * ((size_t)4096 * 2048); }
    __device__ __forceinline__ unsigned a_voff(int R, int C) const { return (unsigned)(R * 2048 + C * 2); }
    __device__ __forceinline__ const char* b_unit(const Unit&) const { return DC; }
    __device__ __forceinline__ size_t b_hstep() const { return (size_t)128 * 1024; }
    __device__ __forceinline__ size_t b_kt(int t) const { return (size_t)t * 128; }
    __device__ __forceinline__ unsigned b_voff(int R, int C) const { const int Rb = (R & ~31) + perm32(R & 31); return (unsigned)(Rb * 1024 + C * 2); }
};

struct SchedQKV {
    pg8::StaticOrder base;
    __device__ __forceinline__ bool next(int i, Unit& u) const {
        if (base.next(i, u)) return true;
        const int L = i * base.G + base.c - base.nwg; if (L < 0 || L >= 16) return false;
        u.pm = L >> 1; u.pn = 4 + (L & 1); u.e = 1; u.r0 = 0; u.cnt = 0; u.rb = 0; u.ui = i; return true;
    }
};
struct GroupedOrder {
    const LAS int* ts; int G, c, layer;
    __device__ __forceinline__ bool next(int i, Unit& u) const {
        const int nrt = ts[32], nwg = nrt * 4; const int L = i * G + c; if (L >= nwg) return false;
        const int wgid = pg8::xcd_remap(L, nwg); const int rt = wgid >> 2;
        int e = 0;
#pragma unroll 1
        for (int j = 1; j < 32; ++j) if (ts[j] <= rt) e = j;
        e = __builtin_amdgcn_readfirstlane(e);
        u.pm = __builtin_amdgcn_readfirstlane(rt); u.pn = __builtin_amdgcn_readfirstlane(wgid & 3); u.e = layer * 32 + e;
        u.r0 = __builtin_amdgcn_readfirstlane((rt - ts[e]) * 256); u.cnt = __builtin_amdgcn_readfirstlane(ts[33 + e]); u.rb = u.pm * 256; u.ui = i; return true;
    }
};

typedef pg8::f32x4 (AccT)[2][2][4][2];
struct EpiQKV {
    bf16* Q; bf16* K; bf16* V; const float* qn; const float* kn; const float* rope;
    __device__ __forceinline__ void operator()(const AccT& acc, const Unit& u, int wr, int wc, int fr, int fq) const {
        const int pn = u.pn; const bool ctx = u.e != 0;
        f32x4 gv[2][2];
        if (pn != 5) { const float* g = (pn == 4) ? kn : qn;
#pragma unroll
            for (int bj = 0; bj < 2; ++bj)
#pragma unroll
                for (int n = 0; n < 2; ++n) gv[bj][n] = *(const f32x4*)(g + 32 * bj + 16 * n + 4 * fq); }
#pragma unroll
        for (int ai = 0; ai < 2; ++ai)
#pragma unroll
            for (int m = 0; m < 4; ++m) {
                const int row = 128 * ai + 64 * wr + 16 * m + fr; const int tok = u.pm * 256 + row; const int pos = tok & (SEQ - 1);
                const size_t krow = ctx ? ((size_t)u.pm * LK + SEQ + row) : ((size_t)(tok >> 12) * LK + pos);
                f32x4 y[2][2];
#pragma unroll
                for (int bj = 0; bj < 2; ++bj)
#pragma unroll
                    for (int n = 0; n < 2; ++n) y[bj][n] = acc[ai][bj][m][n];
                if (pn != 5) {
                    float ss = 0.f;
#pragma unroll
                    for (int bj = 0; bj < 2; ++bj)
#pragma unroll
                        for (int n = 0; n < 2; ++n) ss += (y[bj][n].x * y[bj][n].x + y[bj][n].y * y[bj][n].y) + (y[bj][n].z * y[bj][n].z + y[bj][n].w * y[bj][n].w);
                    ss += __shfl_xor(ss, 16); ss += __shfl_xor(ss, 32);
                    const float rstd = rsqrtf(ss * (1.0f / 64.0f) + EPS);
#pragma unroll
                    for (int bj = 0; bj < 2; ++bj)
#pragma unroll
                        for (int n = 0; n < 2; ++n) y[bj][n] = y[bj][n] * rstd * gv[bj][n];
                    if (!ctx) {
                        const int pr[2] = {pos >> 6, pos & 63};
#pragma unroll
                        for (int bj = 0; bj < 2; ++bj) { const f32x4 cs = *(const f32x4*)(rope + pr[bj] * 16 + 4 * fq), sn = *(const f32x4*)(rope + 1024 + pr[bj] * 16 + 4 * fq);
                            const f32x4 a = y[bj][0], b2 = y[bj][1]; y[bj][0] = a * cs - b2 * sn; y[bj][1] = b2 * cs + a * sn; }
                    }
                }
                bf16* dst;
                if (pn < 4) { dst = Q + (size_t)tok * 1024 + (4 * pn + wc) * 64;
#pragma unroll
                    for (int bj = 0; bj < 2; ++bj)
#pragma unroll
                        for (int n = 0; n < 2; ++n) y[bj][n] = y[bj][n] * attn_body::C2; }
                else dst = ((pn == 4) ? K : V) + krow * KVP + wc * 64;
#pragma unroll
                for (int bj = 0; bj < 2; ++bj)
#pragma unroll
                    for (int n = 0; n < 2; ++n) { v2u w; w.x = pg8::cvt_pk_bf16(y[bj][n].x, y[bj][n].y); w.y = pg8::cvt_pk_bf16(y[bj][n].z, y[bj][n].w); *(v2u*)(dst + 32 * bj + 16 * n + 4 * fq) = w; }
                asm volatile("" ::: "memory");
            }
    }
};
struct EpiResid {
    const float* base; float* out; const float* gate;
    __device__ __forceinline__ void operator()(const AccT& acc, const Unit& u, int wr, int wc, int fr, int fq) const {
        const int b = (u.pm * 256) >> 12; const int col0 = u.pn * 256 + wc * 32 + 4 * fq; const float* g = gate + b * 6144 + col0;
        f32x4 gv[2][2];
#pragma unroll
        for (int bj = 0; bj < 2; ++bj)
#pragma unroll
            for (int n = 0; n < 2; ++n) gv[bj][n] = *(const f32x4*)(g + bj * 128 + n * 16);
#pragma unroll
        for (int ai = 0; ai < 2; ++ai)
#pragma unroll
            for (int m = 0; m < 4; ++m) { const size_t off = (size_t)(u.pm * 256 + ai * 128 + wr * 64 + m * 16 + fr) * 1024 + col0;
#pragma unroll
                for (int bj = 0; bj < 2; ++bj)
#pragma unroll
                    for (int n = 0; n < 2; ++n) { const f32x4 bs = *(const f32x4*)(base + off + bj * 128 + n * 16); *(f32x4*)(out + off + bj * 128 + n * 16) = bs + gv[bj][n] * acc[ai][bj][m][n]; } }
    }
};
__device__ __forceinline__ v4u pack8(const f32x4& a, const f32x4& b) { v4u w; w.x = pg8::cvt_pk_bf16(a.x, a.y); w.y = pg8::cvt_pk_bf16(a.z, a.w); w.z = pg8::cvt_pk_bf16(b.x, b.y); w.w = pg8::cvt_pk_bf16(b.z, b.w); return w; }
struct EpiUp {
    bf16* H1;
    __device__ __forceinline__ void operator()(const AccT& acc, const Unit& u, int wr, int wc, int fr, int fq) const {
#pragma unroll
        for (int ai = 0; ai < 2; ++ai)
#pragma unroll
            for (int m = 0; m < 4; ++m) { f32x4 h[2];
#pragma unroll
                for (int n = 0; n < 2; ++n) { const f32x4 a = acc[ai][0][m][n], b = acc[ai][1][m][n];
#pragma unroll
                    for (int i = 0; i < 4; ++i) h[n][i] = a[i] * __builtin_amdgcn_rcpf(1.0f + __builtin_amdgcn_exp2f(-1.4426950408889634f * a[i])) * b[i]; }
                *(v4u*)(H1 + (size_t)(u.rb + 128 * ai + 64 * wr + 16 * m + fr) * 512 + 128 * u.pn + 32 * wc + 8 * fq) = pack8(h[0], h[1]); }
    }
};
struct EpiDown {
    bf16* Y; const int* list; const float* gate;
    __device__ __forceinline__ void operator()(const AccT& acc, const Unit& u, int wr, int wc, int fr, int fq) const {
        const int* le = list + (size_t)(u.e & 31) * NT_TOK;
#pragma unroll
        for (int ai = 0; ai < 2; ++ai)
#pragma unroll
            for (int m = 0; m < 4; ++m) { const int ridx = u.r0 + 128 * ai + 64 * wr + 16 * m + fr;
                if (ridx < u.cnt) { const int a = le[ridx]; const float g = gate[a]; bf16* dst = Y + (size_t)a * 1024 + 256 * u.pn + 32 * wc + 8 * fq;
#pragma unroll
                    for (int bj = 0; bj < 2; ++bj) *(v4u*)(dst + 128 * bj) = pack8(acc[ai][bj][m][0] * g, acc[ai][bj][m][1] * g); } }
    }
};
struct EpiS {
    bf16* ZT;
    __device__ __forceinline__ void operator()(const AccT& acc, const Unit& u, int wr, int wc, int fr, int fq) const {
#pragma unroll
        for (int ai = 0; ai < 2; ++ai)
#pragma unroll
            for (int m = 0; m < 4; ++m) { const int kp = u.pm * 256 + 128 * ai + 64 * wr + 16 * m + fr;
#pragma unroll
                for (int bj = 0; bj < 2; ++bj) { const int col = u.pn * 256 + 128 * bj + 32 * wc + 8 * fq; const int b = col >> 10, c = col & 1023;
                    *(v4u*)(ZT + ((size_t)b * 8192 + kp) * 1024 + c) = pack8(acc[ai][bj][m][0], acc[ai][bj][m][1]); } }
    }
};
struct EpiC {
    bf16* Fm;
    __device__ __forceinline__ void operator()(const AccT& acc, const Unit& u, int wr, int wc, int fr, int fq) const {
#pragma unroll
        for (int ai = 0; ai < 2; ++ai)
#pragma unroll
            for (int m = 0; m < 4; ++m) { bf16* dst = Fm + (size_t)(u.pm * 256 + 128 * ai + 64 * wr + 16 * m + fr) * 1024 + u.pn * 256 + 32 * wc + 8 * fq;
#pragma unroll
                for (int bj = 0; bj < 2; ++bj) *(v4u*)(dst + 128 * bj) = pack8(acc[ai][bj][m][0], acc[ai][bj][m][1]); }
    }
};

__device__ __forceinline__ void moe_in_phase(const Args& A, Frame& F, int l) {
    const float* X = F.out;
    LAS unsigned* hist = (LAS unsigned*)(F.lds + HIST_OFF); LAS unsigned* hbase = hist + 32;
    unsigned* cnt = (unsigned*)(F.ctl + CW_CNT) + l * 32;
    int* list = (int*)(F.ws + WS_LIST); float* gate = (float*)(F.ws + WS_GATE);
    for (int blk = F.vcu; blk < NT_TOK / 128; blk += F.G) {
        const int tokb = blk * 128, tok0 = tokb + F.wave * 16, b = tokb / SEQ;
        if (F.tid < 32) hist[F.tid] = 0u;
        __syncthreads();
        const int ti = F.lane & 15, kq = F.lane >> 4;
        const float* xr = X + (size_t)(tok0 + ti) * DM + 8 * kq;
        const bf16* wh = (const bf16*)(F.ws + WS_RW) + (size_t)((l * 8 + b) * 2) * 48 * 1024 + (size_t)ti * 1024 + 8 * kq;
        const bf16* wl = wh + 48 * 1024;
        f32x4 acc[3]; acc[0] = (f32x4){0.f, 0.f, 0.f, 0.f}; acc[1] = acc[0]; acc[2] = acc[0];
        float ss = 0.f;
#pragma unroll 2
        for (int s = 0; s < 32; ++s) {
            const f32x4 x0 = *(const GAS f32x4*)(xr + 32 * s), x1 = *(const GAS f32x4*)(xr + 32 * s + 4);
            ss += (x0.x * x0.x + x0.y * x0.y) + (x0.z * x0.z + x0.w * x0.w) + (x1.x * x1.x + x1.y * x1.y) + (x1.z * x1.z + x1.w * x1.w);
            v4u h, lo;
            h.x = pg8::cvt_pk_bf16(x0.x, x0.y); h.y = pg8::cvt_pk_bf16(x0.z, x0.w); h.z = pg8::cvt_pk_bf16(x1.x, x1.y); h.w = pg8::cvt_pk_bf16(x1.z, x1.w);
            lo.x = pg8::cvt_pk_bf16(x0.x - bf2f(h.x & 0xffffu), x0.y - bf2f(h.x >> 16)); lo.y = pg8::cvt_pk_bf16(x0.z - bf2f(h.y & 0xffffu), x0.w - bf2f(h.y >> 16));
            lo.z = pg8::cvt_pk_bf16(x1.x - bf2f(h.z & 0xffffu), x1.y - bf2f(h.z >> 16)); lo.w = pg8::cvt_pk_bf16(x1.z - bf2f(h.w & 0xffffu), x1.w - bf2f(h.w >> 16));
            const bf16x8 ah = __builtin_bit_cast(bf16x8, h), al = __builtin_bit_cast(bf16x8, lo);
#pragma unroll
            for (int cb = 0; cb < 3; ++cb) { const bf16x8 bh = *(const GAS bf16x8*)(wh + cb * 16 * 1024 + 32 * s), bl = *(const GAS bf16x8*)(wl + cb * 16 * 1024 + 32 * s);
                acc[cb] = __builtin_amdgcn_mfma_f32_16x16x32_bf16(ah, bh, acc[cb], 0, 0, 0);
                acc[cb] = __builtin_amdgcn_mfma_f32_16x16x32_bf16(al, bh, acc[cb], 0, 0, 0);
                acc[cb] = __builtin_amdgcn_mfma_f32_16x16x32_bf16(ah, bl, acc[cb], 0, 0, 0); }
        }
        ss += __shfl_xor(ss, 16); ss += __shfl_xor(ss, 32);
        LAS float* scr = (LAS float*)(F.lds + F.wave * 16384);
#pragma unroll
        for (int cb = 0; cb < 3; ++cb)
#pragma unroll
            for (int r = 0; r < 4; ++r) scr[(4 * kq + r) * 49 + 16 * cb + ti] = acc[cb][r];
        if (kq == 0) scr[16 * 49 + ti] = rsqrtf(ss * (1.0f / DM) + EPS);
        LDS_WAIT(); asm volatile("" ::: "memory");
        int e0 = 0, e1 = 0; unsigned rk0 = 0, rk1 = 0; float w0 = 0.f, w1 = 0.f;
        if (F.lane < 16) {
            const float rstd = scr[16 * 49 + F.lane]; const float* bias = (const float*)(F.ws + WS_RBIAS) + (l * 8 + b) * 48; const LAS float* raw = scr + F.lane * 49;
            float lg[4];
#pragma unroll
            for (int g = 0; g < 4; ++g) lg[g] = rstd * raw[g] + bias[g];
            int gs = 0; float mx = lg[0];
#pragma unroll
            for (int g = 1; g < 4; ++g) if (lg[g] > mx) { mx = lg[g]; gs = g; }
            float den = 0.f;
#pragma unroll
            for (int g = 0; g < 4; ++g) den += __expf(lg[g] - mx);
            const float pgrp = 1.0f / den;
            float le[8];
#pragma unroll
            for (int j = 0; j < 8; ++j) le[j] = rstd * raw[4 + gs * 8 + j] + bias[4 + gs * 8 + j];
            int i0 = 0; float m0 = le[0];
#pragma unroll
            for (int j = 1; j < 8; ++j) if (le[j] > m0) { m0 = le[j]; i0 = j; }
            int i1 = -1; float m1 = -INFINITY;
#pragma unroll
            for (int j = 0; j < 8; ++j) if (j != i0 && le[j] > m1) { m1 = le[j]; i1 = j; }
            const float d = __expf(m1 - m0); w0 = pgrp / (1.0f + d); w1 = pgrp * d / (1.0f + d);
            e0 = gs * 8 + i0; e1 = gs * 8 + i1;
            rk0 = __hip_atomic_fetch_add(hist + e0, 1u, __ATOMIC_RELAXED, __HIP_MEMORY_SCOPE_WORKGROUP);
            rk1 = __hip_atomic_fetch_add(hist + e1, 1u, __ATOMIC_RELAXED, __HIP_MEMORY_SCOPE_WORKGROUP);
        }
        __syncthreads();
        if (F.tid < 32) hbase[F.tid] = __hip_atomic_fetch_add(cnt + F.tid, hist[F.tid], __ATOMIC_RELAXED, __HIP_MEMORY_SCOPE_AGENT);
        __syncthreads();
        if (F.lane < 16) { const int t = tok0 + F.lane;
            list[(size_t)e0 * NT_TOK + hbase[e0] + rk0] = 2 * t; list[(size_t)e1 * NT_TOK + hbase[e1] + rk1] = 2 * t + 1;
            gate[2 * t] = w0; gate[2 * t + 1] = w1; }
        RowVec gm, sh; ld_mod(A.in[I_NFFN] + l * 1024, modp(F, l, b, 4), modp(F, l, b, 3), F.lane, gm, sh);
        for (int r = 0; r < 16; ++r) { RowVec x = ld_row(X + (size_t)(tok0 + r) * DM, F.lane); const float rstd = scr[16 * 49 + r];
#pragma unroll
            for (int j = 0; j < 4; ++j) x.v[j] = x.v[j] * rstd * gm.v[j] + sh.v[j];
            st_row_bf16((bf16*)(F.ws + WS_XN) + (size_t)(tok0 + r) * DM, F.lane, x); }
        __syncthreads();
    }
}

__device__ __forceinline__ void grouped_setup(Frame& F, int l, bool with_tab) {
    LAS int* ts = (LAS int*)(F.lds + TS_OFF);
    const unsigned* cnt = (const unsigned*)(F.ctl + CW_CNT) + l * 32;
    if (F.tid < 32) ts[33 + F.tid] = (int)__hip_atomic_load(cnt + F.tid, __ATOMIC_RELAXED, __HIP_MEMORY_SCOPE_AGENT);
    __syncthreads();
    if (F.tid == 0) { int s = 0; for (int e = 0; e < 32; ++e) { ts[e] = s; s += (ts[33 + e] + 255) >> 8; } ts[32] = s; }
    __syncthreads();
    if (with_tab) {
        GroupedOrder S{(const LAS int*)ts, F.G, (int)blockIdx.x, l}; Unit u;
        LAS unsigned* tab = (LAS unsigned*)(F.lds + GTAB_OFF);
        const int* list = (const int*)(F.ws + WS_LIST);
        for (int i = 0; i < 5; ++i) { if (!S.next(i, u)) break;
            if (F.tid < 256) { const int ridx = u.r0 + F.tid; int tok = 0; if (ridx < u.cnt) tok = list[(size_t)(u.e & 31) * NT_TOK + ridx] >> 1; tab[i * 256 + F.tid] = (unsigned)tok * 2048u; } }
        __syncthreads();
    }
}

__device__ __forceinline__ void p8_phase(const Args& A, Frame& F) {
    LAS unsigned char* tile = F.lds;
    const bf16* Y = (const bf16*)(F.ws + WS_Y); bf16* hT = (bf16*)(F.ws + WS_XN);
    for (int it = F.vcu; it < NT_TOK / 32; it += F.G) {
        const int t0 = it * 32, b = t0 / SEQ, n0 = t0 & (SEQ - 1);
        const RowVec g2 = ld_row(modp(F, 0, b, 5), F.lane); RowVec gm, sh; ld_mod(A.in[I_NMIX] + 1024, modp(F, 1, b, 1), modp(F, 1, b, 0), F.lane, gm, sh);
        for (int q = 0; q < 4; ++q) { const int r = F.wave * 4 + q; const size_t t = (size_t)t0 + r;
            RowVec x = ld_row(F.out + t * DM, F.lane); const RowVec y0 = ld_row_bf16(Y + (2 * t) * DM, F.lane), y1 = ld_row_bf16(Y + (2 * t + 1) * DM, F.lane);
#pragma unroll
            for (int j = 0; j < 4; ++j) x.v[j] = x.v[j] + g2.v[j] * (y0.v[j] + y1.v[j]);
            st_row(F.out + t * DM, F.lane, x);
            const float rstd = rsqrtf(row_ss(x) * (1.0f / DM) + EPS);
#pragma unroll
            for (int j = 0; j < 4; ++j) { const f32x4 h = x.v[j] * rstd * gm.v[j] + sh.v[j]; v2u w; w.x = pk2(h.x, h.y); w.y = pk2(h.z, h.w); *(LAS v2u*)(tile + r * 2056 + 8 * F.lane + 512 * j) = w; } }
        __syncthreads();
        const int tg = F.lane & 3;
        for (int ic = 0; ic < 8; ++ic) { const int c = 128 * F.wave + 16 * ic + (F.lane >> 2); unsigned e[8];
#pragma unroll
            for (int i = 0; i < 8; ++i) e[i] = *(const LAS unsigned short*)(tile + (8 * tg + i) * 2056 + 2 * c);
            v4u o; o.x = e[0] | (e[1] << 16); o.y = e[2] | (e[3] << 16); o.z = e[4] | (e[5] << 16); o.w = e[6] | (e[7] << 16);
            *(GAS v4u*)(hT + ((size_t)(b * 1024 + c) * 4096 + n0 + 8 * tg)) = o; }
        __syncthreads();
    }
}

__device__ __forceinline__ void final_phase(const Args& A, Frame& F) {
    const int gw = F.vcu * NWAVES + F.wave, NGW = F.G * NWAVES; const bf16* Y = (const bf16*)(F.ws + WS_Y);
    const RowVec fn = ld_row(A.in[I_FN], F.lane);
    for (int it = gw; it < NT_TOK / 16; it += NGW) { const int t0 = it * 16, b = t0 / SEQ; const RowVec g2 = ld_row(modp(F, 1, b, 5), F.lane);
        for (int r = 0; r < 16; ++r) { const size_t t = (size_t)t0 + r; RowVec x = ld_row(F.out + t * DM, F.lane); const RowVec y0 = ld_row_bf16(Y + (2 * t) * DM, F.lane), y1 = ld_row_bf16(Y + (2 * t + 1) * DM, F.lane);
#pragma unroll
            for (int j = 0; j < 4; ++j) x.v[j] = x.v[j] + g2.v[j] * (y0.v[j] + y1.v[j]);
            const float rstd = rsqrtf(row_ss(x) * (1.0f / DM) + EPS);
#pragma unroll
            for (int j = 0; j < 4; ++j) x.v[j] = x.v[j] * rstd * fn.v[j];
            st_row(F.out + t * DM, F.lane, x); } }
}

__global__ void __launch_bounds__(NWAVES * 64, 2) fwd_megakernel(Args args) {
    extern __shared__ __attribute__((aligned(16))) unsigned char lds[];
    Frame F;
    F.lds = (LAS unsigned char*)lds;
    F.MISC = (volatile LAS unsigned*)(F.lds + MISC_OFF);
    F.tid = threadIdx.x; F.lane = F.tid & 63; F.wave = __builtin_amdgcn_readfirstlane(F.tid >> 6);
    F.G = gridDim.x; { const int bx = blockIdx.x; F.vcu = (F.G % 8 == 0) ? (bx % 8) * (F.G / 8) + bx / 8 : bx; }
    F.ws = args.ws; F.out = args.out; F.ctl = (gu32*)(args.ws + WS_CTL);
    for (int u = F.tid; u < (LDS_BYTES - LDSCTL_OFF) / 4; u += NWAVES * 64) ((LAS unsigned*)(F.lds + LDSCTL_OFF))[u] = 0u;
    __syncthreads();
    XcdBarrier bar; bar.bar = (unsigned*)(F.ctl + CW_BAR); bar.x = 0; bar.st = nullptr;
    if (N_LAUNCHES == 1) bar = xcd_barrier_post((unsigned*)(F.ctl + CW_BAR), F.MISC + 8);
    unsigned char* ws = args.ws;
    const Args& A = args;
    const int lo = args.ph_lo, hi = args.ph_hi;
#define IN(k) (PH_EN(k) && lo <= (k) && (k) < hi)
#define SEAM(k) do { if (lo <= (k) && (k) + 1 < hi) xcd_barrier(bar); } while (0)
    if (IN(0)) p0_prologue(A, F);
    SEAM(0);
    if (IN(1)) p1_phase(A, F);
    SEAM(1);
    if (IN(2)) { ProbQKV P{16, (const char*)(ws + WS_XN), (const char*)(ws + WS_XNC), (const char*)(ws + WS_WQKV)};
        SchedQKV S; S.base.init(NT_TOK / 256, QKVN / 256, F.G, (int)blockIdx.x);
        EpiQKV E{(bf16*)(ws + WS_QO), (bf16*)(ws + WS_K), (bf16*)(ws + WS_V), A.in[I_QN], A.in[I_KN], (const float*)(ws + WS_ROPE)};
        pg8::gemm_phase<ProbQKV, EpiQKV, SchedQKV, true>(F.lds + RING_OFF, P, S, E); }
    SEAM(2);
    if (IN(3)) { const int x = F.vcu >> 5, j = F.vcu & 31;
        for (int i = 0; i < 8; ++i) { const int pair = 4 * x + (i >> 1), b = pair >> 2, kvh = pair & 3, un = (i & 1) * 32 + j, h = kvh * 4 + (un >> 4), qb = un & 15;
            const attn_body::bf16* Qu = (const attn_body::bf16*)(ws + WS_QO) + ((size_t)b * SEQ + qb * 256) * 1024 + h * 64;
            attn_body::attn_unit<8, LK / 64>(Qu, (const attn_body::bf16*)(ws + WS_K) + (size_t)b * LK * KVP + kvh * 64, (const attn_body::bf16*)(ws + WS_V) + (size_t)b * LK * KVP + kvh * 64,
                                              (attn_body::bf16*)(ws + WS_QO) + ((size_t)b * SEQ + qb * 256) * 1024 + h * 64, (char*)lds + RING_OFF); } }
    SEAM(3);
    if (IN(4)) { ProbStd<false> P{16, (const char*)(ws + WS_QO), (const char*)(ws + WS_WO), 2048, 2048};
        pg8::StaticOrder S; S.init(NT_TOK / 256, 4, F.G, (int)blockIdx.x);
        EpiResid E{A.in[I_X], F.out, modp(F, 0, 0, 2)};
        pg8::gemm_phase<ProbStd<false>, EpiResid, pg8::StaticOrder, true>(F.lds + RING_OFF, P, S, E); }
    SEAM(4);
#define MOE_PHASES(l, k0) \
    if (IN(k0)) moe_in_phase(A, F, l); \
    SEAM(k0); \
    if (IN((k0) + 1)) { grouped_setup(F, l, true); \
        ProbUp P{16, (const char*)(ws + WS_XN), (const char*)(ws + WS_W13)}; \
        GroupedOrder S{(const LAS int*)(F.lds + TS_OFF), F.G, (int)blockIdx.x, l}; \
        EpiUp E{(bf16*)(ws + WS_H1)}; \
        pg8::gemm_phase<ProbUp, EpiUp, GroupedOrder, true>(F.lds + RING_OFF, P, S, E); } \
    SEAM((k0) + 1); \
    if (IN((k0) + 2)) { grouped_setup(F, l, false); \
        ProbDown P{8, (const char*)(ws + WS_H1), (const char*)(ws + WS_W2)}; \
        GroupedOrder S{(const LAS int*)(F.lds + TS_OFF), F.G, (int)blockIdx.x, l}; \
        EpiDown E{(bf16*)(ws + WS_Y), (const int*)(ws + WS_LIST), (const float*)(ws + WS_GATE)}; \
        pg8::gemm_phase<ProbDown, EpiDown, GroupedOrder, true>(F.lds + RING_OFF, P, S, E); } \
    SEAM((k0) + 2);
    MOE_PHASES(0, 5)
    if (IN(8)) p8_phase(A, F);
    SEAM(8);
    if (IN(9)) { ProbStd<true> P{64, (const char*)(ws + WS_DFTS), (const char*)(ws + WS_XN), 8192, 8192};
        pg8::StaticOrder S; S.init(32, 32, F.G, (int)blockIdx.x);
        EpiS E{(bf16*)(ws + WS_Y)};
        pg8::gemm_phase<ProbStd<true>, EpiS, pg8::StaticOrder, true>(F.lds + RING_OFF, P, S, E); }
    SEAM(9);
    if (IN(10)) { ProbC P{8, (const char*)(ws + WS_Y), (const char*)(ws + WS_DFTC)};
        pg8::StaticOrder S; S.init(NT_TOK / 256, 4, F.G, (int)blockIdx.x);
        EpiC E{(bf16*)(ws + WS_QO)};
        pg8::gemm_phase<ProbC, EpiC, pg8::StaticOrder, true>(F.lds + RING_OFF, P, S, E); }
    SEAM(10);
    if (IN(11)) { ProbStd<false> P{16, (const char*)(ws + WS_QO), (const char*)(ws + WS_WF), 2048, 2048};
        pg8::StaticOrder S; S.init(NT_TOK / 256, 4, F.G, (int)blockIdx.x);
        EpiResid E{F.out, F.out, modp(F, 1, 0, 2)};
        pg8::gemm_phase<ProbStd<false>, EpiResid, pg8::StaticOrder, true>(F.lds + RING_OFF, P, S, E); }
    SEAM(11);
    MOE_PHASES(1, 12)
    if (IN(15)) final_phase(A, F);
#undef IN
#undef SEAM
}

extern "C" void kernel_launch(void* const* d_in, const int* in_sizes, int n_in, void* d_out, int out_size, void* d_ws, size_t ws_size, hipStream_t stream) {
    static int grid = 0;
    if (grid == 0) {
        if (n_in != 21 || out_size != NT_TOK * DM || ws_size < WS_END) { fprintf(stderr, "kernel_launch: unexpected problem (n_in %d, out %d, ws %zu < %zu)\n", n_in, out_size, ws_size, (size_t)WS_END); grid = -1; return; }
        int dev = 0, cus = 0;
        if (hipGetDevice(&dev) != hipSuccess || hipDeviceGetAttribute(&cus, hipDeviceAttributeMultiprocessorCount, dev) != hipSuccess) { grid = -1; return; }
        if (hipFuncSetAttribute((const void*)fwd_megakernel, hipFuncAttributeMaxDynamicSharedMemorySize, LDS_BYTES) != hipSuccess) { fprintf(stderr, "kernel_launch: hipFuncSetAttribute failed\n"); grid = -1; return; }
        int per_cu = 0;
        if (hipOccupancyMaxActiveBlocksPerMultiprocessor(&per_cu, (const void*)fwd_megakernel, NWAVES * 64, LDS_BYTES) != hipSuccess || per_cu < 1) fprintf(stderr, "kernel_launch: occupancy query says %d\n", per_cu);
        (void)hipGetLastError();
        grid = 256;
        if (cus != 256) fprintf(stderr, "kernel_launch: device has %d CUs, kernel built for 256\n", cus);
    }
    if (grid < 0) return;
    (void)hipMemsetAsync((char*)d_ws + WS_CTL, 0, CTL_ZERO_BYTES, stream);
    Args a{};
    for (int i = 0; i < 21; ++i) a.in[i] = (const float*)d_in[i];
    a.out = (float*)d_out; a.ws = (unsigned char*)d_ws;
    if (N_LAUNCHES == 1) { a.ph_lo = 0; a.ph_hi = N_PHASES; hipLaunchKernelGGL(fwd_megakernel, dim3(grid), dim3(NWAVES * 64), LDS_BYTES, stream, a); }
    else for (int p = 0; p < N_PHASES; ++p) { a.ph_lo = p; a.ph_hi = p + 1; hipLaunchKernelGGL(fwd_megakernel, dim3(grid), dim3(NWAVES * 64), LDS_BYTES, stream, a); }
}
```

```cpp
#include <hip/hip_runtime.h>
#include <hip/hip_bf16.h>
#include <cstdio>
#include <cstdint>
#include <cmath>

#ifndef PHMASK
#define PHMASK 0x1FFFF
#endif
#define PH_EN(k) (((PHMASK) >> (k)) & 1)
#ifndef MK_N_LAUNCHES
#define MK_N_LAUNCHES 1
#endif

constexpr int NB = 8, SEQ = 4096, DM = 1024, NT_TOK = NB * SEQ, CTXL = 256, NCTX = NB * CTXL, LK = SEQ + CTXL;
constexpr int NHEAD = 16, NKVH = 4, HD = 64, QKVN = 1536, KVP = 256;
constexpr int NEXP = 32, DEXP = 512, NGRP = 4, EPG = 8;
constexpr float EPS = 1e-6f;

namespace pg8 {
#define PG8_LAS __attribute__((address_space(3)))
typedef unsigned short bf16_t;
typedef short bf16x8 __attribute__((ext_vector_type(8)));
typedef float f32x4 __attribute__((ext_vector_type(4)));
typedef unsigned u32x4 __attribute__((ext_vector_type(4)));
typedef unsigned u32x2 __attribute__((ext_vector_type(2)));
constexpr int BM = 256, BK = 64, HALF = 128, HTB = HALF * BK * 2, STAGE_BYTES = 8 * HTB, NXCD = 8, WGM = 8;

__host__ __device__ __forceinline__ int lds_byte(int r, int c) { const int st = (r >> 4) * 2 + (c >> 5), rr = r & 15, cc = c & 31, ob = rr * 64 + cc * 2; return st * 1024 + (ob ^ (((ob >> 9) & 1) << 5)); }
__host__ __device__ __forceinline__ void stage_rc(int b, int& R, int& C) { const int st = b / 1024, sb = b % 1024, swz = sb ^ (((sb >> 9) & 1) << 5); R = (st >> 1) * 16 + swz / 64; C = (st & 1) * 32 + (swz % 64) / 2; }
__host__ __device__ __forceinline__ int perm32(int rho) { const int n = rho >> 4, i = rho & 15; return 8 * (i >> 2) + 4 * n + (i & 3); }

struct Unit { int pm, pn, e, r0, cnt, rb, ui; };

__device__ __forceinline__ int xcd_remap(int wgid, int nwg) { const int q = nwg / NXCD, r = nwg % NXCD, xcd = wgid % NXCD, off = wgid / NXCD; return (xcd < r ? xcd * (q + 1) : r * (q + 1) + (xcd - r) * q) + off; }

struct StaticOrder {
    int nM, nN, nwg, G, c;
    __device__ void init(int nM_, int nN_, int G_, int c_) { nM = nM_; nN = nN_; nwg = nM * nN; G = G_; c = c_; }
    __device__ bool next(int i, Unit& u) const {
        const long L = (long)i * G + c; if (L >= nwg) return false;
        const int wgid = xcd_remap((int)L, nwg);
        const int nig = WGM * nN, gid = wgid / nig, fm = gid * WGM, gsz = (nM - fm) < WGM ? (nM - fm) : WGM;
        u.pm = fm + ((wgid % nig) % gsz); u.pn = (wgid % nig) / gsz; u.e = 0; u.r0 = 0; u.cnt = 0; u.rb = 0; u.ui = i; return true;
    }
};

__device__ __forceinline__ unsigned cvt_pk_bf16(float lo, float hi) { unsigned r; asm volatile("v_cvt_pk_bf16_f32 %0, %1, %2" : "=v"(r) : "v"(lo), "v"(hi)); return r; }

template <class Prob, class Epi, class Sched, bool ALIGN_EPI>
__device__ __forceinline__ void gemm_phase(PG8_LAS unsigned char* lds, const Prob& P, const Sched& S, const Epi& E) {
    const int tid = threadIdx.x, wid = __builtin_amdgcn_readfirstlane(tid >> 6), lane = tid & 63, wr = wid >> 2, wc = wid & 3, fr = lane & 15, fq = lane >> 4;
    const int nt = P.nt;
    int Rr[2], Cc[2];
    unsigned voffA[2], voffB[2];
#pragma unroll
    for (int i = 0; i < 2; ++i) { stage_rc(tid * 16 + i * 8192, Rr[i], Cc[i]); voffA[i] = P.a_voff(Rr[i], Cc[i]); voffB[i] = P.b_voff(Rr[i], Cc[i]); }
    const size_t hstepA = P.a_hstep(), hstepB = P.b_hstep();
    const unsigned ldsw = (unsigned)wid * 1024u;
    const int aoff = lds_byte(wr * 64 + fr, fq * 8), boff = lds_byte(wc * 32 + fr, fq * 8);
    unsigned cva0[2] = {0, 0}, cva1[2] = {0, 0}, nva0[2] = {0, 0}, nva1[2] = {0, 0};
    const PG8_LAS unsigned* tab = (const PG8_LAS unsigned*)(lds + Prob::tab_off);
#define PG8_SA(b, h) (((b) * 2 + (h)) * HTB)
#define PG8_SB(b, h) ((4 + (b) * 2 + (h)) * HTB)
#define PG8_STAGE(bufoff, gbase, voff) do { _Pragma("unroll") for (int _i = 0; _i < 2; ++_i) \
        __builtin_amdgcn_global_load_lds((const unsigned*)((const char*)(gbase) + (voff)[_i]), (PG8_LAS unsigned*)(lds + (bufoff) + ldsw + _i * 8192), 16, 0, 0); } while (0)
#define PG8_LDA(dst, b, h) do { _Pragma("unroll") for (int m = 0; m < 4; ++m) _Pragma("unroll") for (int k = 0; k < 2; ++k) dst[m][k] = *(const PG8_LAS bf16x8*)(lds + PG8_SA(b, h) + aoff + m * 2048 + k * 1024); } while (0)
#define PG8_LDB(dst, b, h) do { _Pragma("unroll") for (int n = 0; n < 2; ++n) _Pragma("unroll") for (int k = 0; k < 2; ++k) dst[n][k] = *(const PG8_LAS bf16x8*)(lds + PG8_SB(b, h) + boff + n * 2048 + k * 1024); } while (0)
#define PG8_MMA(ai, bj, At, Bt) do { __builtin_amdgcn_s_setprio(1); _Pragma("unroll") for (int m = 0; m < 4; ++m) _Pragma("unroll") for (int n = 0; n < 2; ++n) _Pragma("unroll") for (int k = 0; k < 2; ++k) \
        acc[ai][bj][m][n] = __builtin_amdgcn_mfma_f32_16x16x32_bf16(Bt[n][k], At[m][k], acc[ai][bj][m][n], 0, 0, 0); __builtin_amdgcn_s_setprio(0); } while (0)
#define PG8_WAIT_V(n) asm volatile("s_waitcnt vmcnt(" #n ")" ::: "memory")
#define PG8_WAIT_L(n) asm volatile("s_waitcnt lgkmcnt(" #n ")" ::: "memory")
#define PG8_BAR __builtin_amdgcn_s_barrier()
#define PG8_SCHED __builtin_amdgcn_sched_barrier(0)
#define PG8_STAGE_A(bufoff, gb, h, VO0, VO1) do { if constexpr (Prob::GATHER) { if ((h) == 0) PG8_STAGE(bufoff, gb, VO0); else PG8_STAGE(bufoff, gb, VO1); } else { PG8_STAGE(bufoff, (gb) + (h) * hstepA, voffA); } } while (0)
    Unit cur, nxt; int ui = 0;
    if (!S.next(0, cur)) return;
    f32x4 acc[2][2][4][2];
#pragma unroll
    for (int a = 0; a < 2; ++a)
#pragma unroll
        for (int b = 0; b < 2; ++b)
#pragma unroll
            for (int m = 0; m < 4; ++m)
#pragma unroll
                for (int n = 0; n < 2; ++n) acc[a][b][m][n] = (f32x4){0.f, 0.f, 0.f, 0.f};
    bf16x8 At[4][2], B0[2][2], B1[2][2];
    const char* cA = P.a_unit(cur); const char* cB = P.b_unit(cur);
    if constexpr (Prob::GATHER) {
#pragma unroll
        for (int i = 0; i < 2; ++i) { cva0[i] = tab[cur.ui * 256 + Rr[i]] + (unsigned)Cc[i] * 2u; cva1[i] = tab[cur.ui * 256 + 128 + Rr[i]] + (unsigned)Cc[i] * 2u; }
    }
    PG8_STAGE(PG8_SB(0, 0), cB + P.b_kt(0), voffB); PG8_STAGE(PG8_SB(0, 1), cB + P.b_kt(0) + hstepB, voffB); PG8_STAGE_A(PG8_SA(0, 0), cA + P.a_kt(0), 0, cva0, cva1); PG8_STAGE_A(PG8_SA(0, 1), cA + P.a_kt(0), 1, cva0, cva1);
    if (wr == 1) PG8_BAR;
    PG8_WAIT_V(2); PG8_BAR;
    PG8_STAGE(PG8_SB(1, 0), cB + P.b_kt(1), voffB); PG8_STAGE_A(PG8_SA(1, 0), cA + P.a_kt(1), 0, cva0, cva1); PG8_STAGE(PG8_SB(1, 1), cB + P.b_kt(1) + hstepB, voffB);
    PG8_WAIT_V(6); PG8_BAR;
    for (;;) {
        const bool has_next = S.next(ui + 1, nxt);
        const char* nA = has_next ? P.a_unit(nxt) : cA; const char* nB = has_next ? P.b_unit(nxt) : cB;
        if constexpr (Prob::GATHER) {
            const int nu = has_next ? nxt.ui : cur.ui;
#pragma unroll
            for (int i = 0; i < 2; ++i) { nva0[i] = tab[nu * 256 + Rr[i]] + (unsigned)Cc[i] * 2u; nva1[i] = tab[nu * 256 + 128 + Rr[i]] + (unsigned)Cc[i] * 2u; }
        }
        for (int t = 0; t < nt; t += 2) {
            const bool last = (t == nt - 2);
            const char* a1 = cA + P.a_kt(t + 1);
            const char* a2 = last ? nA + P.a_kt(0) : cA + P.a_kt(t + 2); const char* b2 = last ? nB + P.b_kt(0) : cB + P.b_kt(t + 2);
            const char* a3 = last ? nA + P.a_kt(1) : cA + P.a_kt(t + 3); const char* b3 = last ? nB + P.b_kt(1) : cB + P.b_kt(t + 3);
            unsigned sv0[2] = {0, 0}, sv1[2] = {0, 0};
            if constexpr (Prob::GATHER) {
#pragma unroll
                for (int i = 0; i < 2; ++i) { sv0[i] = last ? nva0[i] : cva0[i]; sv1[i] = last ? nva1[i] : cva1[i]; }
            }
            PG8_LDB(B0, 0, 0); PG8_LDB(B1, 0, 1); PG8_SCHED; PG8_LDA(At, 0, 0); PG8_STAGE_A(PG8_SA(1, 1), a1, 1, cva0, cva1);
            PG8_WAIT_V(8); PG8_WAIT_L(0); PG8_BAR; PG8_MMA(0, 0, At, B0); PG8_MMA(0, 1, At, B1); PG8_BAR; PG8_SCHED;
            PG8_LDA(At, 0, 1); PG8_STAGE(PG8_SB(0, 0), b2, voffB); PG8_STAGE(PG8_SB(0, 1), b2 + hstepB, voffB); PG8_STAGE_A(PG8_SA(0, 0), a2, 0, sv0, sv1);
            PG8_WAIT_V(8); PG8_WAIT_L(0); PG8_BAR; PG8_MMA(1, 0, At, B0); PG8_MMA(1, 1, At, B1); PG8_BAR; PG8_SCHED;
            PG8_LDB(B0, 1, 0); PG8_LDB(B1, 1, 1); PG8_SCHED; PG8_LDA(At, 1, 0); PG8_STAGE_A(PG8_SA(0, 1), a2, 1, sv0, sv1);
            PG8_WAIT_V(8); PG8_WAIT_L(0); PG8_BAR; PG8_MMA(0, 0, At, B0); PG8_MMA(0, 1, At, B1); PG8_BAR; PG8_SCHED;
            PG8_LDA(At, 1, 1); PG8_STAGE(PG8_SB(1, 0), b3, voffB); PG8_STAGE(PG8_SB(1, 1), b3 + hstepB, voffB); PG8_STAGE_A(PG8_SA(1, 0), a3, 0, sv0, sv1);
            PG8_WAIT_V(8); PG8_WAIT_L(0); PG8_BAR; PG8_MMA(1, 0, At, B0); PG8_MMA(1, 1, At, B1); PG8_BAR; PG8_SCHED;
        }
        if constexpr (ALIGN_EPI) { if (wr == 0) PG8_BAR; }
        E(acc, cur, wr, wc, fr, fq);
        if (!has_next) break;
#pragma unroll
        for (int a = 0; a < 2; ++a)
#pragma unroll
            for (int b = 0; b < 2; ++b)
#pragma unroll
                for (int m = 0; m < 4; ++m)
#pragma unroll
                    for (int n = 0; n < 2; ++n) acc[a][b][m][n] = (f32x4){0.f, 0.f, 0.f, 0.f};
        cur = nxt; cA = nA; cB = nB; ++ui;
        if constexpr (Prob::GATHER) {
#pragma unroll
            for (int i = 0; i < 2; ++i) { cva0[i] = nva0[i]; cva1[i] = nva1[i]; }
        }
        if constexpr (ALIGN_EPI) { if (wr == 1) PG8_BAR; }
    }
    PG8_WAIT_V(0);
    if constexpr (!ALIGN_EPI) { if (wr == 0) PG8_BAR; }
    PG8_BAR;
#undef PG8_SA
#undef PG8_SB
#undef PG8_STAGE
#undef PG8_STAGE_A
#undef PG8_LDA
#undef PG8_LDB
#undef PG8_MMA
#undef PG8_WAIT_V
#undef PG8_WAIT_L
#undef PG8_BAR
#undef PG8_SCHED
}
}

namespace attn_body {
using bf16=__hip_bfloat16;
using bf16x8=__attribute__((ext_vector_type(8)))short;
using s16x4=__attribute__((ext_vector_type(4)))short;
using f32x16=__attribute__((ext_vector_type(16)))float;
using u32x4=__attribute__((ext_vector_type(4)))unsigned;
constexpr int D=64,QP=1024,KP=256;
constexpr int NW=8,QBLK=32,QB=QBLK*NW,KVBLK=64;
__device__ __forceinline__ int crow(int r,int hi){return (r&3)+8*(r>>2)+4*hi;}
#define SBAR() __builtin_amdgcn_sched_barrier(0)
constexpr int NSLOT=3, SLOTB=8192;
constexpr int LDS_K=0, LDS_V=NSLOT*SLOTB, LDS_WS=2*NSLOT*SLOTB, LDS_OST=LDS_WS+NW*64*4, LDS_BYTES=LDS_OST+NW*4096;
constexpr float C2=0.125f*1.4426950408889634f;
__device__ __forceinline__ void glds16(const void*gsrc,unsigned lds_dst){unsigned keep;
  asm volatile("s_mov_b32 %0, m0\n\ts_mov_b32 m0, %2\n\ts_nop 0\n\tglobal_load_lds_dwordx4 %1, off\n\ts_mov_b32 m0, %0":"=&s"(keep):"v"(gsrc),"s"(lds_dst):"memory");}
__device__ __forceinline__ float max3f(float a,float b,float c){float r;asm("v_max3_f32 %0, %1, %2, %3":"=v"(r):"v"(a),"v"(b),"v"(c));return r;}
__device__ __forceinline__ float max2f(float a,float b){float r;asm("v_max_f32_e32 %0, %1, %2":"=v"(r):"v"(a),"v"(b));return r;}
__device__ __forceinline__ float fadd_s(float a,float b){float r;asm("v_add_f32_e32 %0, %1, %2":"=v"(r):"v"(a),"v"(b));return r;}
__device__ __forceinline__ float fsub_s(float a,float b){float r;asm("v_sub_f32_e32 %0, %1, %2":"=v"(r):"v"(a),"v"(b));return r;}
typedef float f32x2_t __attribute__((ext_vector_type(2))); typedef __bf16 bf16x2_t __attribute__((ext_vector_type(2)));
__device__ __forceinline__ unsigned cvtpk_s(float lo,float hi){f32x2_t v={lo,hi};bf16x2_t b=__builtin_convertvector(v,bf16x2_t);return __builtin_bit_cast(unsigned,b);}
#define WAIT_BAR(N) asm volatile("s_waitcnt vmcnt(" #N ") lgkmcnt(0)\n\ts_barrier":::"memory")

__device__ __forceinline__ void qkt(f32x16&p0,f32x16&p1,const char*Kslot,const bf16x8*qr,const f32x16&negm,int r32,int hi){
  const char*kb=Kslot+hi*1024+r32*16;
  #pragma unroll
  for(int d0=0;d0<4;++d0){
    const bf16x8 b0=*reinterpret_cast<const bf16x8*>(kb+d0*2048);
    const bf16x8 b1=*reinterpret_cast<const bf16x8*>(kb+d0*2048+512);
    if(d0==0){p0=__builtin_amdgcn_mfma_f32_32x32x16_bf16(b0,qr[0],negm,0,0,0);p1=__builtin_amdgcn_mfma_f32_32x32x16_bf16(b1,qr[0],negm,0,0,0);}
    else{p0=__builtin_amdgcn_mfma_f32_32x32x16_bf16(b0,qr[d0],p0,0,0,0);p1=__builtin_amdgcn_mfma_f32_32x32x16_bf16(b1,qr[d0],p1,0,0,0);}}
}
typedef __attribute__((address_space(3))) const char* lds_cptr;
typedef short v4i16_t __attribute__((ext_vector_type(4)));
__device__ __forceinline__ void kload8(bf16x8*kf,lds_cptr kp){
  kf[0]=*(const __attribute__((address_space(3))) bf16x8*)(kp);      kf[1]=*(const __attribute__((address_space(3))) bf16x8*)(kp+512);
  kf[2]=*(const __attribute__((address_space(3))) bf16x8*)(kp+2048); kf[3]=*(const __attribute__((address_space(3))) bf16x8*)(kp+2560);
  kf[4]=*(const __attribute__((address_space(3))) bf16x8*)(kp+4096); kf[5]=*(const __attribute__((address_space(3))) bf16x8*)(kp+4608);
  kf[6]=*(const __attribute__((address_space(3))) bf16x8*)(kp+6144); kf[7]=*(const __attribute__((address_space(3))) bf16x8*)(kp+6656);
}
__device__ __forceinline__ void kload2(bf16x8*kf,lds_cptr kp,int j){ kf[2*j]=*(const __attribute__((address_space(3))) bf16x8*)(kp+j*2048); kf[2*j+1]=*(const __attribute__((address_space(3))) bf16x8*)(kp+j*2048+512); }
__device__ __forceinline__ s16x4 vtr(lds_cptr p){ return __builtin_bit_cast(s16x4,__builtin_amdgcn_ds_read_tr16_b64_v4i16((__attribute__((address_space(3))) v4i16_t*)p)); }
__device__ __forceinline__ float rowmax(const f32x16&p0,const f32x16&p1){
  float a=max3f(p0[0],p0[1],p1[0]),b=max3f(p0[2],p0[3],p1[1]);a=max3f(a,p1[2],p1[3]);
  #pragma unroll
  for(int r=4;r<16;r+=4){a=max3f(a,p0[r],p0[r+1]);b=max3f(b,p0[r+2],p0[r+3]);a=max3f(a,p1[r],p1[r+1]);b=max3f(b,p1[r+2],p1[r+3]);}
  const float m=max2f(a,b);
  auto rr=__builtin_amdgcn_permlane32_swap(__float_as_uint(m),__float_as_uint(m),false,false);
  return max2f(__uint_as_float(rr[0]),__uint_as_float(rr[1]));
}
__device__ __forceinline__ void pv(f32x16*o,int vb,bf16x8 pa0,bf16x8 pa1,bf16x8 pa2,bf16x8 pa3){
  #pragma unroll
  for(int d0=0;d0<2;++d0){s16x4 lo[4],hi[4];
    #pragma unroll
    for(int ks=0;ks<4;++ks){
      asm volatile("ds_read_b64_tr_b16 %0,%1 offset:%c2":"=&v"(lo[ks]):"v"(vb),"i"(d0*4096+ks*1024):"memory");
      asm volatile("ds_read_b64_tr_b16 %0,%1 offset:%c2":"=&v"(hi[ks]):"v"(vb),"i"(d0*4096+ks*1024+512):"memory");}
    asm volatile("s_waitcnt lgkmcnt(0)":::"memory");SBAR();
    #define PK(k) (bf16x8){lo[k][0],lo[k][1],lo[k][2],lo[k][3],hi[k][0],hi[k][1],hi[k][2],hi[k][3]}
    o[d0]=__builtin_amdgcn_mfma_f32_32x32x16_bf16(pa0,PK(0),o[d0],0,0,0);
    o[d0]=__builtin_amdgcn_mfma_f32_32x32x16_bf16(pa1,PK(1),o[d0],0,0,0);
    o[d0]=__builtin_amdgcn_mfma_f32_32x32x16_bf16(pa2,PK(2),o[d0],0,0,0);
    o[d0]=__builtin_amdgcn_mfma_f32_32x32x16_bf16(pa3,PK(3),o[d0],0,0,0);
    #undef PK
  }
}
#define ATTN_STORE16(p,v) (*(u32x4*)(p)=(v))
template<int THRL,int NT> __device__ __forceinline__ void attn_unit(const bf16*Qu,const bf16*__restrict__ Kh,const bf16*__restrict__ Vh,bf16*Ou,char*shm){
  const int tid=threadIdx.x,lane=tid&63,r32=lane&31,hi=lane>>5; const int wid=__builtin_amdgcn_readfirstlane(tid>>6);
  const bf16*Qw=Qu+(long)(wid*QBLK)*QP;
  const unsigned lds0=(unsigned)(uintptr_t)shm;
  float*wsf=(float*)(shm+LDS_WS)+wid*64;
  const bf16*ksrc=Kh+(long)lane*KP+wid*8;
  const bf16*vsrc=Vh+(long)(16*(wid&3)+(lane>>2))*KP+(wid>>2)*32+(lane&3)*8;
  const unsigned kdst=lds0+LDS_K+wid*1024, vdst=lds0+LDS_V+wid*1024;
  #define DMA_K(t,slot) glds16(ksrc+(long)(t)*KVBLK*KP,(unsigned)__builtin_amdgcn_readfirstlane(kdst+(slot)))
  #define DMA_V(t,slot) glds16(vsrc+(long)(t)*KVBLK*KP,(unsigned)__builtin_amdgcn_readfirstlane(vdst+(slot)))
  const int vb0=(int)(lds0+LDS_V)+((lane>>4)&1)*32+(lane&3)*8+(4*hi+((lane&15)>>2))*64;
  const char*Kbase=shm+LDS_K; bf16x8 kf[8];
  const lds_cptr shm3=(lds_cptr)shm; const lds_cptr kp0=shm3+LDS_K+hi*1024+r32*16; const lds_cptr vp0=shm3+LDS_V+((lane>>4)&1)*32+(lane&3)*8+(4*hi+((lane&15)>>2))*64;
  DMA_K(0,0);DMA_V(0,0);DMA_K(1,SLOTB);
  bf16x8 qr[4];
  #pragma unroll
  for(int d0=0;d0<4;++d0)qr[d0]=*reinterpret_cast<const bf16x8*>(&Qw[(long)r32*QP+d0*16+hi*8]);
  float mhat=0.f,l_reg=0.f;f32x16 o[2];o[0]=f32x16{};o[1]=f32x16{};f32x16 negm=f32x16{};asm volatile("":"+v"(negm));
  bool resc=false;
  #define START(P0,P1) do{ const float rm=rowmax(P0,P1); resc=false; \
    { const float dl=rm; mhat=fadd_s(mhat,dl); \
      _Pragma("unroll") for(int r=0;r<16;++r){P0[r]=fsub_s(P0[r],dl);P1[r]=fsub_s(P1[r],dl);} \
      _Pragma("unroll") for(int r=0;r<16;++r)negm[r]=-mhat; asm volatile("":"+v"(negm)); } \
    _Pragma("unroll") for(int r=0;r<16;++r)P0[r]=__builtin_amdgcn_exp2f(P0[r]); }while(0)
  #define RESC() do{ if(resc){ asm volatile("s_waitcnt lgkmcnt(0)":::"memory"); \
      _Pragma("unroll") for(int d_=0;d_<2;++d_) _Pragma("unroll") for(int r=0;r<16;++r)o[d_][r]*=wsf[crow(r,hi)]; } }while(0)
  f32x16 pA0,pA1,pB0,pB1;
  int sl_prev=0,sl_cur=0,sl_next=SLOTB;
  #define ROT() do{sl_prev=sl_cur;sl_cur=sl_next;sl_next=(sl_next==(NSLOT-1)*SLOTB)?0:sl_next+SLOTB;}while(0)
  DMA_K(2,2*SLOTB);
  WAIT_BAR(3);
  qkt(pA0,pA1,Kbase,qr,negm,r32,hi);asm volatile("s_nop 15\n\ts_nop 7":"+v"(pA0),"+v"(pA1));
  START(pA0,pA1);
  _Pragma("unroll") for(int r=0;r<16;++r)pA1[r]=__builtin_amdgcn_exp2f(pA1[r]);
  WAIT_BAR(0);
  DMA_K(3,0);DMA_V(1,SLOTB);
  ROT();
  kload8(kf,kp0+sl_cur);
  WAIT_BAR(2);
  s16x4 vlo[8],vhi[8]; u32x4 pw0,pw1,pw2,pw3;
  #define PKW(P,B) cvtpk_s(P[B],P[B+1])
  #define PAF(k) __builtin_bit_cast(bf16x8,pw##k)
  #define VFR(i) (bf16x8){vlo[i][0],vlo[i][1],vlo[i][2],vlo[i][3],vhi[i][0],vhi[i][1],vhi[i][2],vhi[i][3]}
  #define PIN(x) asm volatile("":"+v"(x))
  #define MX3(a,b,c) __builtin_fmaxf(__builtin_fmaxf((a),(b)),(c))
  #define GAPA(MF,A0,A1,A2,A3,W0,W1,PW) do{ MF; sacc+=A0; sacc+=A1; sacc+=A2; sacc+=A3; PIN(sacc); W0; W1; PIN(PW); SBAR(); }while(0)
  #define EX(v) __builtin_amdgcn_exp2f(v)
  #define GAPB(MF,X,B) do{ MF; X[B]=EX(X[B]); X[B+1]=EX(X[B+1]); X[B+2]=EX(X[B+2]); X[B+3]=EX(X[B+3]); PIN(X); SBAR(); }while(0)
  #define VRD(i) do{ vlo[i]=vtr(vp_+(((i)>>2)*4096+((i)&3)*1024)); vhi[i]=vtr(vp_+(((i)>>2)*4096+((i)&3)*1024+512)); }while(0)
  #define KRD(G,j) do{ if(G){ kload2(kf,kp0+sl_next,j); SBAR(); } }while(0)
  #define STEP(C0,C1,P0,P1,t,GK,GV,GL) do{ SBAR(); \
    const lds_cptr vp_=vp0+sl_prev; \
    VRD(0); SBAR(); float sacc=(P0[0]+P0[1]); \
    GAPA(C0=__builtin_amdgcn_mfma_f32_32x32x16_bf16(kf[0],qr[0],negm,0,0,0), P0[2],P0[3],P0[4],P0[5],     pw0[0]=PKW(P0,0), pw0[1]=PKW(P0,2), pw0); \
    VRD(4); SBAR(); GAPA(C1=__builtin_amdgcn_mfma_f32_32x32x16_bf16(kf[1],qr[0],negm,0,0,0), P0[6],P0[7],P0[8],P0[9],     pw0[2]=PKW(P0,4), pw0[3]=PKW(P0,6), pw0); \
    VRD(1); SBAR(); GAPA(C0=__builtin_amdgcn_mfma_f32_32x32x16_bf16(kf[2],qr[1],C0,0,0,0),   P0[10],P0[11],P0[12],P0[13], pw1[0]=PKW(P0,8), pw1[1]=PKW(P0,10), pw1); \
    VRD(5); SBAR(); GAPA(C1=__builtin_amdgcn_mfma_f32_32x32x16_bf16(kf[3],qr[1],C1,0,0,0),   P0[14],P0[15],P1[0],P1[1],   pw1[2]=PKW(P0,12),pw1[3]=PKW(P0,14), pw1); \
    VRD(2); SBAR(); GAPA(C0=__builtin_amdgcn_mfma_f32_32x32x16_bf16(kf[4],qr[2],C0,0,0,0),   P1[2],P1[3],P1[4],P1[5],     pw2[0]=PKW(P1,0), pw2[1]=PKW(P1,2), pw2); \
    VRD(6); SBAR(); GAPA(C1=__builtin_amdgcn_mfma_f32_32x32x16_bf16(kf[5],qr[2],C1,0,0,0),   P1[6],P1[7],P1[8],P1[9],     pw2[2]=PKW(P1,4), pw2[3]=PKW(P1,6), pw2); \
    VRD(3); SBAR(); GAPA(C0=__builtin_amdgcn_mfma_f32_32x32x16_bf16(kf[6],qr[3],C0,0,0,0),   P1[10],P1[11],P1[12],P1[13], pw3[0]=PKW(P1,8), pw3[1]=PKW(P1,10), pw3); \
    VRD(7); SBAR(); GAPA(C1=__builtin_amdgcn_mfma_f32_32x32x16_bf16(kf[7],qr[3],C1,0,0,0),   P1[14],P1[15],0.f,0.f,       pw3[2]=PKW(P1,12),pw3[3]=PKW(P1,14), pw3); \
    l_reg+=sacc; \
    if(GK){DMA_K((t)+3,sl_cur);} if(GV){DMA_V((t)+1,sl_next);} \
    { float a=MX3(C0[0],C0[1],C1[0]),b=MX3(C0[2],C0[3],C1[1]); a=MX3(a,C1[2],C1[3]); \
      _Pragma("unroll") for(int r=4;r<16;r+=4){a=MX3(a,C0[r],C0[r+1]);b=MX3(b,C0[r+2],C0[r+3]);a=MX3(a,C1[r],C1[r+1]);b=MX3(b,C1[r+2],C1[r+3]);} \
      float rm=__builtin_fmaxf(a,b); { auto rr=__builtin_amdgcn_permlane32_swap(__float_as_uint(rm),__float_as_uint(rm),false,false); rm=__builtin_fmaxf(__uint_as_float(rr[0]),__uint_as_float(rr[1])); } \
      resc=false; \
      if(__builtin_expect(__any(rm>(float)THRL),0)){ const float dl=__builtin_fmaxf(rm,0.f); mhat+=dl; \
        _Pragma("unroll") for(int r=0;r<16;++r){C0[r]-=dl;C1[r]-=dl;} \
        _Pragma("unroll") for(int r=0;r<16;++r)negm[r]=-mhat; asm volatile("":"+v"(negm)); \
        const float f=__builtin_amdgcn_exp2f(-dl); l_reg*=f; if(hi==0)wsf[r32]=f; resc=true; } } \
    SBAR(); \
    GAPB(o[0]=__builtin_amdgcn_mfma_f32_32x32x16_bf16(PAF(0),VFR(0),o[0],0,0,0), C0,0); \
    GAPB(o[1]=__builtin_amdgcn_mfma_f32_32x32x16_bf16(PAF(0),VFR(4),o[1],0,0,0), C0,4); \
    KRD(GL,0); GAPB(o[0]=__builtin_amdgcn_mfma_f32_32x32x16_bf16(PAF(1),VFR(1),o[0],0,0,0), C0,8); \
    KRD(GL,1); GAPB(o[1]=__builtin_amdgcn_mfma_f32_32x32x16_bf16(PAF(1),VFR(5),o[1],0,0,0), C0,12); \
    KRD(GL,2); GAPB(o[0]=__builtin_amdgcn_mfma_f32_32x32x16_bf16(PAF(2),VFR(2),o[0],0,0,0), C1,0); \
    KRD(GL,3); GAPB(o[1]=__builtin_amdgcn_mfma_f32_32x32x16_bf16(PAF(2),VFR(6),o[1],0,0,0), C1,4); \
    GAPB(o[0]=__builtin_amdgcn_mfma_f32_32x32x16_bf16(PAF(3),VFR(3),o[0],0,0,0), C1,8); \
    GAPB(o[1]=__builtin_amdgcn_mfma_f32_32x32x16_bf16(PAF(3),VFR(7),o[1],0,0,0), C1,12); \
    }while(0)
  int t=1;
  for(;t+5<NT;t+=2){
    STEP(pB0,pB1,pA0,pA1,t,true,true,true);     WAIT_BAR(2); RESC(); ROT();
    STEP(pA0,pA1,pB0,pB1,t+1,true,true,true);   WAIT_BAR(2); RESC(); ROT();
  }
  #define ENDW(tt) do{ if((tt)+3<NT){WAIT_BAR(2);} else if((tt)+2<NT){WAIT_BAR(1);} else {WAIT_BAR(0);} }while(0)
  for(;t+1<NT;t+=2){
    STEP(pB0,pB1,pA0,pA1,t,(t+3<NT),(t+1<NT),(t+1<NT));       ENDW(t);   RESC(); ROT();
    STEP(pA0,pA1,pB0,pB1,t+1,(t+4<NT),(t+2<NT),(t+2<NT));     ENDW(t+1); RESC(); ROT();
  }
  STEP(pB0,pB1,pA0,pA1,NT-1,false,false,false); RESC();
  { float sacc=pB0[0]+pB0[1]; _Pragma("unroll") for(int r=2;r<16;++r)sacc+=pB0[r]; _Pragma("unroll") for(int r=0;r<16;++r)sacc+=pB1[r]; l_reg+=sacc;
    pw0=(u32x4){PKW(pB0,0),PKW(pB0,2),PKW(pB0,4),PKW(pB0,6)};pw1=(u32x4){PKW(pB0,8),PKW(pB0,10),PKW(pB0,12),PKW(pB0,14)};pw2=(u32x4){PKW(pB1,0),PKW(pB1,2),PKW(pB1,4),PKW(pB1,6)};pw3=(u32x4){PKW(pB1,8),PKW(pB1,10),PKW(pB1,12),PKW(pB1,14)};
    SBAR(); pv(o,vb0+sl_cur,PAF(0),PAF(1),PAF(2),PAF(3)); }
  #undef PKW
  #undef PAF
  #undef VFR
  #undef PIN
  #undef MX3
  #undef GAPA
  #undef GAPB
  #undef EX
  #undef VRD
  #undef KRD
  #undef STEP
  #undef ENDW
  {auto rr=__builtin_amdgcn_permlane32_swap(__float_as_uint(l_reg),__float_as_uint(l_reg),false,false);l_reg=__uint_as_float(rr[0])+__uint_as_float(rr[1]);}
  if(hi==0)wsf[32+r32]=l_reg;asm volatile("s_waitcnt lgkmcnt(0)":::"memory");
  float rli[16];
  #pragma unroll
  for(int r=0;r<16;++r)rli[r]=__builtin_amdgcn_rcpf(wsf[32+crow(r,hi)]);
  bf16*Ow=Ou+(long)(wid*QBLK)*QP;
  { bf16*stg=(bf16*)(shm+LDS_OST)+wid*2048;
    #pragma unroll
    for(int r=0;r<16;++r){const int orow=crow(r,hi);
      #pragma unroll
      for(int d0=0;d0<2;++d0)stg[orow*64+d0*32+r32]=__float2bfloat16(o[d0][r]*rli[r]);}
    asm volatile("s_waitcnt lgkmcnt(0)":::"memory");
    #pragma unroll
    for(int i=0;i<4;++i){const int row=i*8+(lane>>3),ch=lane&7; const u32x4 v=*(const u32x4*)(stg+row*64+ch*8); ATTN_STORE16(Ow+(long)row*QP+ch*8,v);} }
  asm volatile("s_waitcnt lgkmcnt(0)\n\ts_barrier":::"memory");
  #undef DMA_K
  #undef DMA_V
  #undef START
  #undef RESC
  #undef ROT
}
#undef SBAR
#undef WAIT_BAR
}

constexpr int NWAVES = 8;
constexpr int N_LAUNCHES = MK_N_LAUNCHES;
constexpr int N_PHASES = 17;

constexpr size_t MiB = 1u << 20;
constexpr size_t WS_CTL = 0, CTL_ZERO_BYTES = 1 * MiB;
constexpr size_t WS_MOD = 1 * MiB;
constexpr size_t WS_ROPE = 1 * MiB + 512 * 1024;
constexpr size_t WS_RBIAS = WS_ROPE + 16 * 1024;
constexpr size_t WS_DFTC = 1 * MiB + 768 * 1024;
constexpr size_t WS_RW = 2 * MiB;
constexpr size_t WS_WQKV = 6 * MiB, WS_WO = 9 * MiB, WS_WF = 11 * MiB;
constexpr size_t WS_LIST = 13 * MiB;
constexpr size_t WS_GATE = 17 * MiB;
constexpr size_t WS_W13 = 18 * MiB;
constexpr size_t WS_W2 = 146 * MiB;
constexpr size_t WS_ZT = 210 * MiB;
constexpr size_t WS_YP = 342 * MiB;
constexpr size_t WS_XN = 274 * MiB;
constexpr size_t WS_XNC = 338 * MiB;
constexpr size_t WS_QO = 342 * MiB;
constexpr size_t WS_K = 406 * MiB, WS_V = 423 * MiB;
constexpr size_t WS_H1 = 342 * MiB;
constexpr size_t WS_Y = 440 * MiB;
constexpr size_t WS_END = 568 * MiB;
constexpr int CW_TMO = 0, CW_CODE = 1, CW_BAR = 4096, CW_CNT = 16384;

constexpr int RING_OFF = 0, RING_BYTES = 131072;
constexpr int LDSCTL_OFF = RING_BYTES, MISC_OFF = LDSCTL_OFF + 320;
constexpr int TS_OFF = LDSCTL_OFF + 512;
constexpr int HIST_OFF = LDSCTL_OFF + 1024;
constexpr int GTAB_OFF = LDSCTL_OFF + 2048;
constexpr int LDS_BYTES = 147456;

#define GAS __attribute__((address_space(1)))
#define LAS __attribute__((address_space(3)))
typedef unsigned short bf16;
typedef unsigned v4u __attribute__((ext_vector_type(4)));
typedef unsigned v2u __attribute__((ext_vector_type(2)));
typedef float f32x4 __attribute__((ext_vector_type(4)));
typedef short bf16x8 __attribute__((ext_vector_type(8)));
typedef GAS unsigned gu32;
#define RLX_AGENT __ATOMIC_RELAXED, __HIP_MEMORY_SCOPE_AGENT
#define LDS_WAIT() asm volatile("s_waitcnt lgkmcnt(0)" ::: "memory")
#define VM_WAIT() asm volatile("s_waitcnt vmcnt(0)" ::: "memory")
__device__ __forceinline__ unsigned f2bf(float f) { unsigned u = __builtin_bit_cast(unsigned, f); return (u + 0x7fffu + ((u >> 16) & 1u)) >> 16; }
__device__ __forceinline__ unsigned pk2(float lo, float hi) { return f2bf(lo) | (f2bf(hi) << 16); }
__device__ __forceinline__ float bf2f(unsigned h) { return __builtin_bit_cast(float, h << 16); }

#define XB_TMO      128
#define XB_XCNT(j)  (256  + 64 * (j))
#define XB_XSUB(j)  (1280 + 64 * (j))
#define XB_XGEN(j)  (2304 + 64 * (j))
#define XB_TOP      3328
#define XB_TOPGEN   3392
#define XCD_BAR_WORDS 3456
#define XB_SPIN_CAP (1u << 18)
__device__ __forceinline__ unsigned xb_ld(unsigned* p)              { return __hip_atomic_load(p, __ATOMIC_RELAXED, __HIP_MEMORY_SCOPE_AGENT); }
__device__ __forceinline__ unsigned xb_add(unsigned* p, unsigned v) { return __hip_atomic_fetch_add(p, v, __ATOMIC_RELAXED, __HIP_MEMORY_SCOPE_AGENT); }
__device__ __forceinline__ unsigned xb_xcc_id() { return (unsigned)__builtin_amdgcn_s_getreg((3 << 11) | 20) & 0xFu; }
#define XB_SPIN(cond, bar) do { unsigned _sp = 0; while (cond) { __builtin_amdgcn_s_sleep(1); \
    if ((++_sp & 255u) == 0u) { if (xb_ld(&(bar)[XB_TMO])) break; if (_sp > XB_SPIN_CAP) { atomicAdd(&(bar)[XB_TMO], 1u); break; } } } } while (0)
struct XcdBarrier { unsigned* bar; unsigned x; volatile LAS unsigned* st; };
__device__ __forceinline__ XcdBarrier xcd_barrier_post(unsigned* bar, volatile LAS unsigned* st) {
    XcdBarrier b; b.bar = bar; b.x = xb_xcc_id(); b.st = st;
    if (threadIdx.x == 0) (void)xb_add(&bar[XB_XCNT(b.x)], 1u);
    return b;
}
__device__ __forceinline__ void xcd_barrier_complete(unsigned* bar, unsigned x, unsigned& nloc, unsigned& nx) {
    const unsigned G = gridDim.x * gridDim.y * gridDim.z;
    unsigned sum, cnt, mine, sp = 0u;
    for (;;) {
        sum = 0u; cnt = 0u; mine = 0u;
#pragma unroll
        for (unsigned j = 0; j < 16; ++j) { const unsigned c = xb_ld(&bar[XB_XCNT(j)]); sum += c; cnt += (c > 0u) ? 1u : 0u; mine = (j == x) ? c : mine; }
        if (sum == G) break;
        __builtin_amdgcn_s_sleep(1);
        if ((++sp & 255u) == 0u) { if (xb_ld(&bar[XB_TMO])) break; if (sp > XB_SPIN_CAP) { atomicAdd(&bar[XB_TMO], 1u); break; } }
    }
    nloc = mine > 0u ? mine : 1u; nx = cnt > 0u ? cnt : 1u;
}
__device__ __forceinline__ void xcd_barrier(const XcdBarrier& b) {
    asm volatile("s_waitcnt vmcnt(0)" ::: "memory");
    __syncthreads();
    if (threadIdx.x == 0) {
        unsigned* bar = b.bar;
        __builtin_amdgcn_s_waitcnt(0);
        unsigned nloc = b.st[0], nx = b.st[1];
        if (nloc == 0u) { xcd_barrier_complete(bar, b.x, nloc, nx); b.st[0] = nloc; b.st[1] = nx; }
        const unsigned old = xb_add(&bar[XB_XSUB(b.x)], 1u);
        const unsigned gen = old / nloc;
        if (old + 1u == (gen + 1u) * nloc) {
            __builtin_amdgcn_fence(__ATOMIC_RELEASE, "agent");
            asm volatile("s_waitcnt vmcnt(0)" ::: "memory");
            const unsigned og = xb_add(&bar[XB_TOP], 1u);
            const unsigned tg = og / nx;
            if (og + 1u == (tg + 1u) * nx) xb_add(&bar[XB_TOPGEN], 1u);
            else XB_SPIN(xb_ld(&bar[XB_TOPGEN]) == tg, bar);
            __builtin_amdgcn_fence(__ATOMIC_ACQUIRE, "agent");
            xb_add(&bar[XB_XGEN(b.x)], 1u);
            asm volatile("s_waitcnt vmcnt(0)" ::: "memory");
        } else {
            XB_SPIN(xb_ld(&bar[XB_XGEN(b.x)]) == gen, bar);
            __builtin_amdgcn_fence(__ATOMIC_ACQUIRE, "agent");
            asm volatile("s_waitcnt vmcnt(0)" ::: "memory");
        }
    }
    __syncthreads();
}

struct Args { const float* in[21]; float* out; unsigned char* ws; int ph_lo, ph_hi; };
struct Frame {
    LAS unsigned char* lds;
    volatile LAS unsigned* MISC;
    gu32* ctl;
    int tid, lane, wave;
    int vcu, G;
    unsigned char* ws;
    float* out;
};
enum { I_X = 0, I_C, I_CTX, I_CCTX, I_WMOD, I_BMOD, I_NMIX, I_NFFN, I_WQKV, I_QN, I_KN, I_WO, I_WF, I_WRG, I_BRG, I_WRE, I_BRE, I_W1, I_W3, I_W2, I_FN };

__device__ __forceinline__ float wave_sum(float v) {
#pragma unroll
    for (int o = 1; o < 64; o <<= 1) v += __shfl_xor(v, o);
    return v;
}

__device__ __forceinline__ void p0_transpose_item(const float* W, int N, bf16* WT, int ldk, int row_off, LAS float* scr, int kb, int nb, int lane) {
    const int k0 = 64 * kb, n0 = 32 * nb;
    f32x4 v[8];
#pragma unroll
    for (int i = 0; i < 8; ++i) v[i] = *(const GAS f32x4*)(W + (size_t)(k0 + (lane >> 3) + 8 * i) * N + n0 + 4 * (lane & 7));
#pragma unroll
    for (int i = 0; i < 8; ++i) { LAS float* d = scr + ((lane >> 3) + 8 * i) * 33 + 4 * (lane & 7); d[0] = v[i].x; d[1] = v[i].y; d[2] = v[i].z; d[3] = v[i].w; }
    LDS_WAIT(); asm volatile("" ::: "memory");
    const int c = lane & 7;
#pragma unroll
    for (int j = 0; j < 4; ++j) { const int n = (lane >> 3) + 8 * j; const LAS float* s = scr + (8 * c) * 33 + n;
        v4u o; o.x = pk2(s[0 * 33], s[1 * 33]); o.y = pk2(s[2 * 33], s[3 * 33]); o.z = pk2(s[4 * 33], s[5 * 33]); o.w = pk2(s[6 * 33], s[7 * 33]);
        *(GAS v4u*)(WT + (size_t)(row_off + n0 + n) * ldk + k0 + 8 * c) = o; }
    LDS_WAIT(); asm volatile("" ::: "memory");
}

__device__ __forceinline__ void p0_prologue(const Args& A, Frame& F) {
    LAS float* L = (LAS float*)(F.lds);
    if (F.vcu < 192) {
        const int l = F.vcu / 96, cg = F.vcu % 96;
        LAS float* sc = L;
        LAS float* part = L + 10240;
        for (int i = F.tid; i < 9 * 1024; i += NWAVES * 64) { const int r = i >> 10, k = i & 1023; const float c = (r < 8) ? A.in[I_C][r * 1024 + k] : A.in[I_CCTX][k]; sc[i] = c / (1.f + __expf(-c)); }
        __syncthreads();
        float acc[9];
#pragma unroll
        for (int r = 0; r < 9; ++r) acc[r] = 0.f;
        const float* wp = A.in[I_WMOD] + (size_t)l * 1024 * 6144 + cg * 64 + F.lane;
        const int kb = F.wave * 128;
#pragma unroll 4
        for (int k = 0; k < 128; ++k) { const float w = wp[(size_t)(kb + k) * 6144];
#pragma unroll
            for (int r = 0; r < 9; ++r) acc[r] += sc[r * 1024 + kb + k] * w; }
#pragma unroll
        for (int r = 0; r < 9; ++r) part[(F.wave * 9 + r) * 64 + F.lane] = acc[r];
        __syncthreads();
        for (int i = F.tid; i < 9 * 64; i += NWAVES * 64) { const int r = i >> 6, c = i & 63; float s = 0.f;
#pragma unroll
            for (int w = 0; w < 8; ++w) s += part[(w * 9 + r) * 64 + c];
            ((float*)(F.ws + WS_MOD))[(l * 9 + r) * 6144 + cg * 64 + c] = s + A.in[I_BMOD][l * 6144 + cg * 64 + c]; }
        __syncthreads();
    }
    LAS float* tab = L + 16384;
    for (int i = F.tid; i < 4096; i += NWAVES * 64) tab[i] = cospif((float)i * (1.0f / 2048.0f));
    __syncthreads();
    const int gw = F.vcu * NWAVES + F.wave, NGW = F.G * NWAVES;
    {
      bf16* DC = (bf16*)(F.ws + WS_DFTC);
      for (int m = gw; m < 256; m += NGW) { const int c0 = 8 * F.lane; float v[8];
#pragma unroll
          for (int i = 0; i < 8; ++i) { const int c = c0 + i; const int cc = c & 255; const int idx = (m * cc * 16) & 4095; v[i] = (c < 256) ? tab[idx] * (1.0f / 16.0f) : -tab[(idx - 1024) & 4095] * (1.0f / 16.0f); }
          v4u o; o.x = pk2(v[0], v[1]); o.y = pk2(v[2], v[3]); o.z = pk2(v[4], v[5]); o.w = pk2(v[6], v[7]);
          *(GAS v4u*)(DC + (size_t)m * 512 + c0) = o; }
      if (F.vcu == F.G - 1) { float* R = (float*)(F.ws + WS_ROPE);
          for (int i = F.tid; i < 1024; i += NWAVES * 64) { const int pos = i >> 4, j = i & 15; const float inv = powf(10000.0f, -(float)j / 16.0f); const float ang = (float)pos * inv; R[i] = cosf(ang); R[1024 + i] = sinf(ang); } }
    }
    __syncthreads();
    LAS float* scr = (LAS float*)(F.lds + F.wave * 16384);
    constexpr int I_QKV = 16 * 48, I_SQ = 16 * 32, I_MOE = 768 * 64;
    constexpr int NITEMS = I_QKV + 2 * I_SQ + I_MOE;
    for (int it = gw; it < NITEMS; it += NGW) {
        int r = it;
        if (r < I_QKV) { p0_transpose_item(A.in[I_WQKV], QKVN, (bf16*)(F.ws + WS_WQKV), 1024, 0, scr, r / 48, r % 48, F.lane); continue; } r -= I_QKV;
        if (r < I_SQ) { p0_transpose_item(A.in[I_WO], 1024, (bf16*)(F.ws + WS_WO), 1024, 0, scr, r / 32, r % 32, F.lane); continue; } r -= I_SQ;
        if (r < I_SQ) { p0_transpose_item(A.in[I_WF], 1024, (bf16*)(F.ws + WS_WF), 1024, 0, scr, r / 32, r % 32, F.lane); continue; } r -= I_SQ;
        const int le = r / 768, q = r % 768;
        if (q < 256) p0_transpose_item(A.in[I_W1] + (size_t)le * 1024 * 512, 512, (bf16*)(F.ws + WS_W13) + (size_t)le * 1024 * 1024, 1024, 0, scr, q / 16, q % 16, F.lane);
        else if (q < 512) p0_transpose_item(A.in[I_W3] + (size_t)le * 1024 * 512, 512, (bf16*)(F.ws + WS_W13) + (size_t)le * 1024 * 1024, 1024, 512, scr, (q - 256) / 16, (q - 256) % 16, F.lane);
        else p0_transpose_item(A.in[I_W2] + (size_t)le * 512 * 1024, 1024, (bf16*)(F.ws + WS_W2) + (size_t)le * 1024 * 512, 512, 0, scr, (q - 512) / 32, (q - 512) % 32, F.lane);
    }
}

struct RowVec { f32x4 v[4]; };
__device__ __forceinline__ RowVec ld_row(const float* p, int lane) { RowVec r; const GAS f32x4* q = (const GAS f32x4*)p + lane;
#pragma unroll
    for (int j = 0; j < 4; ++j) r.v[j] = q[64 * j]; return r; }
__device__ __forceinline__ void st_row(float* p, int lane, const RowVec& r) { GAS f32x4* q = (GAS f32x4*)p + lane;
#pragma unroll
    for (int j = 0; j < 4; ++j) q[64 * j] = r.v[j]; }
__device__ __forceinline__ RowVec ld_row_bf16(const bf16* p, int lane) { RowVec r; const GAS v2u* q = (const GAS v2u*)p + lane;
#pragma unroll
    for (int j = 0; j < 4; ++j) { const v2u w = q[64 * j]; r.v[j] = (f32x4){bf2f(w.x & 0xffffu), bf2f(w.x >> 16), bf2f(w.y & 0xffffu), bf2f(w.y >> 16)}; } return r; }
__device__ __forceinline__ void st_row_bf16(bf16* p, int lane, const RowVec& r) { GAS v2u* q = (GAS v2u*)p + lane;
#pragma unroll
    for (int j = 0; j < 4; ++j) { v2u w; w.x = pk2(r.v[j].x, r.v[j].y); w.y = pk2(r.v[j].z, r.v[j].w); q[64 * j] = w; } }
__device__ __forceinline__ float row_ss(const RowVec& r) { float s = 0.f;
#pragma unroll
    for (int j = 0; j < 4; ++j) s += (r.v[j].x * r.v[j].x + r.v[j].y * r.v[j].y) + (r.v[j].z * r.v[j].z + r.v[j].w * r.v[j].w);
    return wave_sum(s); }
__device__ __forceinline__ void ld_mod(const float* gain, const float* scale, const float* shift, int lane, RowVec& gm, RowVec& sh) {
    const RowVec g = ld_row(gain, lane), s = ld_row(scale, lane); sh = ld_row(shift, lane);
#pragma unroll
    for (int j = 0; j < 4; ++j) gm.v[j] = g.v[j] * (s.v[j] + 1.0f);
}
__device__ __forceinline__ const float* modp(Frame& F, int l, int r, int chunk) { return (const float*)(F.ws + WS_MOD) + (size_t)(l * 9 + r) * 6144 + chunk * 1024; }

__device__ __forceinline__ void p1_phase(const Args& A, Frame& F) {
    const int gw = F.vcu * NWAVES + F.wave, NGW = F.G * NWAVES;
    for (int it = gw; it < NT_TOK / 16; it += NGW) { const int t0 = it * 16, b = t0 / SEQ; RowVec gm, sh; ld_mod(A.in[I_NMIX], modp(F, 0, b, 1), modp(F, 0, b, 0), F.lane, gm, sh);
        for (int r = 0; r < 16; ++r) { RowVec x = ld_row(A.in[I_X] + (size_t)(t0 + r) * DM, F.lane); const float rstd = rsqrtf(row_ss(x) * (1.0f / DM) + EPS);
#pragma unroll
            for (int j = 0; j < 4; ++j) x.v[j] = x.v[j] * rstd * gm.v[j] + sh.v[j];
            st_row_bf16((bf16*)(F.ws + WS_XN) + (size_t)(t0 + r) * DM, F.lane, x); } }
    for (int it = gw; it < NCTX / 16; it += NGW) { const int t0 = it * 16; RowVec gm, sh; ld_mod(A.in[I_NMIX], modp(F, 0, 8, 1), modp(F, 0, 8, 0), F.lane, gm, sh);
        for (int r = 0; r < 16; ++r) { RowVec x = ld_row(A.in[I_CTX] + (size_t)(t0 + r) * DM, F.lane); const float rstd = rsqrtf(row_ss(x) * (1.0f / DM) + EPS);
#pragma unroll
            for (int j = 0; j < 4; ++j) x.v[j] = x.v[j] * rstd * gm.v[j] + sh.v[j];
            st_row_bf16((bf16*)(F.ws + WS_XNC) + (size_t)(t0 + r) * DM, F.lane, x); } }
    for (int it = gw; it < 2 * 8 * 48; it += NGW) { const int l = it / 384, b = (it / 48) % 8, c = it % 48;
        bf16* hi = (bf16*)(F.ws + WS_RW) + ((size_t)((l * 8 + b) * 2 + 0) * 48 + c) * 1024; bf16* lo = hi + 48 * 1024;
        const float* gain = A.in[I_NFFN] + l * 1024; const float* sc2 = modp(F, l, b, 4); const float* sh2 = modp(F, l, b, 3);
        float bs = 0.f;
        for (int j = 0; j < 16; ++j) { const int k = F.lane + 64 * j; float w = 0.f;
            if (c < 4) w = A.in[I_WRG][(size_t)l * 1024 * 4 + k * 4 + c]; else if (c < 36) w = A.in[I_WRE][(size_t)l * 1024 * 32 + k * 32 + (c - 4)];
            const float wp = gain[k] * (1.0f + sc2[k]) * w; const unsigned h = f2bf(wp); hi[k] = (bf16)h; lo[k] = (bf16)f2bf(wp - bf2f(h)); bs += sh2[k] * w; }
        bs = wave_sum(bs);
        if (F.lane == 0) { float br = 0.f; if (c < 4) br = A.in[I_BRG][l * 4 + c]; else if (c < 36) br = A.in[I_BRE][l * 32 + (c - 4)]; ((float*)(F.ws + WS_RBIAS))[(l * 8 + b) * 48 + c] = bs + br; } }
}

using pg8::Unit; using pg8::perm32;
template <bool PERM> struct ProbStd {
    static constexpr bool GATHER = false; static constexpr int tab_off = 0;
    int nt; const char* A; const char* B; int lda2, ldb2;
    __device__ __forceinline__ const char* a_unit(const Unit& u) const { return A + (size_t)u.pm * 256 * lda2; }
    __device__ __forceinline__ size_t a_hstep() const { return (size_t)128 * lda2; }
    __device__ __forceinline__ size_t a_kt(int t) const { return (size_t)t * 128; }
    __device__ __forceinline__ unsigned a_voff(int R, int C) const { return (unsigned)(R * lda2 + C * 2); }
    __device__ __forceinline__ const char* b_unit(const Unit& u) const { return B + (size_t)u.pn * 256 * ldb2; }
    __device__ __forceinline__ size_t b_hstep() const { return (size_t)128 * ldb2; }
    __device__ __forceinline__ size_t b_kt(int t) const { return (size_t)t * 128; }
    __device__ __forceinline__ unsigned b_voff(int R, int C) const { const int Rb = PERM ? ((R & ~31) + perm32(R & 31)) : R; return (unsigned)(Rb * ldb2 + C * 2); }
};
struct ProbQKV {
    static constexpr bool GATHER = false; static constexpr int tab_off = 0;
    int nt; const char* XN; const char* XNC; const char* W;
    __device__ __forceinline__ const char* a_unit(const Unit& u) const { return XN + (size_t)u.e * (size_t)(WS_XNC - WS_XN) + (size_t)u.pm * 256 * 2048; }
    __device__ __forceinline__ size_t a_hstep() const { return (size_t)128 * 2048; }
    __device__ __forceinline__ size_t a_kt(int t) const { return (size_t)t * 128; }
    __device__ __forceinline__ unsigned a_voff(int R, int C) const { return (unsigned)(R * 2048 + C * 2); }
    __device__ __forceinline__ const char* b_unit(const Unit& u) const { return W + (size_t)u.pn * 256 * 2048; }
    __device__ __forceinline__ size_t b_hstep() const { return (size_t)32 * 2048; }
    __device__ __forceinline__ size_t b_kt(int t) const { return (size_t)t * 128; }
    __device__ __forceinline__ unsigned b_voff(int R, int C) const { return (unsigned)((64 * (R >> 5) + (R & 31)) * 2048 + C * 2); }
};
struct ProbUp {
    static constexpr bool GATHER = true; static constexpr int tab_off = GTAB_OFF;
    int nt; const char* XN; const char* W;
    __device__ __forceinline__ const char* a_unit(const Unit&) const { return XN; }
    __device__ __forceinline__ size_t a_hstep() const { return 0; }
    __device__ __forceinline__ size_t a_kt(int t) const { return (size_t)t * 128; }
    __device__ __forceinline__ unsigned a_voff(int, int) const { return 0u; }
    __device__ __forceinline__ const char* b_unit(const Unit& u) const { return W + ((size_t)u.e * 1024 + 128 * u.pn) * 2048; }
    __device__ __forceinline__ size_t b_hstep() const { return (size_t)512 * 2048; }
    __device__ __forceinline__ size_t b_kt(int t) const { return (size_t)t * 128; }
    __device__ __forceinline__ unsigned b_voff(int R, int C) const { const int Rb = (R & ~31) + perm32(R & 31); return (unsigned)(Rb * 2048 + C * 2); }
};
struct ProbDown {
    static constexpr bool GATHER = false; static constexpr int tab_off = 0;
    int nt; const char* H1; const char* W;
    __device__ __forceinline__ const char* a_unit(const Unit& u) const { return H1 + (size_t)u.rb * 1024; }
    __device__ __forceinline__ size_t a_hstep() const { return (size_t)128 * 1024; }
    __device__ __forceinline__ size_t a_kt(int t) const { return (size_t)t * 128; }
    __device__ __forceinline__ unsigned a_voff(int R, int C) const { return (unsigned)(R * 1024 + C * 2); }
    __device__ __forceinline__ const char* b_unit(const Unit& u) const { return W + ((size_t)u.e * 1024 + 256 * u.pn) * 1024; }
    __device__ __forceinline__ size_t b_hstep() const { return (size_t)128 * 1024; }
    __device__ __forceinline__ size_t b_kt(int t) const { return (size_t)t * 128; }
    __device__ __forceinline__ unsigned b_voff(int R, int C) const { const int Rb = (R & ~31) + perm32(R & 31); return (unsigned)(Rb * 1024 + C * 2); }
};
struct ProbC {
    static constexpr bool GATHER = false; static constexpr int tab_off = 0;
    int nt; const char* ZT; const char* DC;
    __device__ __forceinline__ const char* a_unit(const Unit& u) const { return ZT + (((size_t)(u.pm >> 4) * 8192 + (u.pm & 15) * 256) * 1024 + 256 * u.pn) * 2; }
    __device__ __forceinline__ size_t a_hstep() const { return (size_t)128 * 2048; }
    __device__ __forceinline__ size_t a_kt(int t) const { return (size_t)(t & 3) * 128 + (size_t)(t >> 2) * ((size_t)4096 * 2048); }
    __device__ __forceinline__ unsigned a_voff(int R, int C) const { return (unsigned)(R * 2048 + C * 2); }
    __device__ __forceinline__ const char* b_unit(const Unit&) const { return DC; }
    __device__ __forceinline__ size_t b_hstep() const { return (size_t)128 * 1024; }
    __device__ __forceinline__ size_t b_kt(int t) const { return (size_t)t * 128; }
    __device__ __forceinline__ unsigned b_voff(int R, int C) const { const int Rb = (R & ~31) + perm32(R & 31); return (unsigned)(Rb * 1024 + C * 2); }
};

struct SchedQKV {
    pg8::StaticOrder base;
    __device__ __forceinline__ bool next(int i, Unit& u) const {
        if (base.next(i, u)) return true;
        const int L = i * base.G + base.c - base.nwg; if (L < 0 || L >= 16) return false;
        u.pm = L >> 1; u.pn = 4 + (L & 1); u.e = 1; u.r0 = 0; u.cnt = 0; u.rb = 0; u.ui = i; return true;
    }
};
struct GroupedOrder {
    const LAS int* ts; int G, c, layer;
    __device__ __forceinline__ bool next(int i, Unit& u) const {
        const int nrt = ts[32], nwg = nrt * 4; const int L = i * G + c; if (L >= nwg) return false;
        const int wgid = pg8::xcd_remap(L, nwg); const int rt = wgid >> 2;
        int e = 0;
#pragma unroll 1
        for (int j = 1; j < 32; ++j) if (ts[j] <= rt) e = j;
        e = __builtin_amdgcn_readfirstlane(e);
        u.pm = __builtin_amdgcn_readfirstlane(rt); u.pn = __builtin_amdgcn_readfirstlane(wgid & 3); u.e = layer * 32 + e;
        u.r0 = __builtin_amdgcn_readfirstlane((rt - ts[e]) * 256); u.cnt = __builtin_amdgcn_readfirstlane(ts[33 + e]); u.rb = u.pm * 256; u.ui = i; return true;
    }
};

typedef pg8::f32x4 (AccT)[2][2][4][2];
struct EpiQKV {
    bf16* Q; bf16* K; bf16* V; const float* qn; const float* kn; const float* rope;
    __device__ __forceinline__ void operator()(const AccT& acc, const Unit& u, int wr, int wc, int fr, int fq) const {
        const int pn = u.pn; const bool ctx = u.e != 0;
        f32x4 gv[2][2];
        if (pn != 5) { const float* g = (pn == 4) ? kn : qn;
#pragma unroll
            for (int bj = 0; bj < 2; ++bj)
#pragma unroll
                for (int n = 0; n < 2; ++n) gv[bj][n] = *(const f32x4*)(g + 32 * bj + 16 * n + 4 * fq); }
#pragma unroll
        for (int ai = 0; ai < 2; ++ai)
#pragma unroll
            for (int m = 0; m < 4; ++m) {
                const int row = 128 * ai + 64 * wr + 16 * m + fr; const int tok = u.pm * 256 + row; const int pos = tok & (SEQ - 1);
                const size_t krow = ctx ? ((size_t)u.pm * LK + SEQ + row) : ((size_t)(tok >> 12) * LK + pos);
                f32x4 y[2][2];
#pragma unroll
                for (int bj = 0; bj < 2; ++bj)
#pragma unroll
                    for (int n = 0; n < 2; ++n) y[bj][n] = acc[ai][bj][m][n];
                if (pn != 5) {
                    float ss = 0.f;
#pragma unroll
                    for (int bj = 0; bj < 2; ++bj)
#pragma unroll
                        for (int n = 0; n < 2; ++n) ss += (y[bj][n].x * y[bj][n].x + y[bj][n].y * y[bj][n].y) + (y[bj][n].z * y[bj][n].z + y[bj][n].w * y[bj][n].w);
                    ss += __shfl_xor(ss, 16); ss += __shfl_xor(ss, 32);
                    const float rstd = rsqrtf(ss * (1.0f / 64.0f) + EPS);
#pragma unroll
                    for (int bj = 0; bj < 2; ++bj)
#pragma unroll
                        for (int n = 0; n < 2; ++n) y[bj][n] = y[bj][n] * rstd * gv[bj][n];
                    if (!ctx) {
                        const int pr[2] = {pos >> 6, pos & 63};
#pragma unroll
                        for (int bj = 0; bj < 2; ++bj) { const f32x4 cs = *(const f32x4*)(rope + pr[bj] * 16 + 4 * fq), sn = *(const f32x4*)(rope + 1024 + pr[bj] * 16 + 4 * fq);
                            const f32x4 a = y[bj][0], b2 = y[bj][1]; y[bj][0] = a * cs - b2 * sn; y[bj][1] = b2 * cs + a * sn; }
                    }
                }
                bf16* dst;
                if (pn < 4) { dst = Q + (size_t)tok * 1024 + (4 * pn + wc) * 64;
#pragma unroll
                    for (int bj = 0; bj < 2; ++bj)
#pragma unroll
                        for (int n = 0; n < 2; ++n) y[bj][n] = y[bj][n] * attn_body::C2; }
                else dst = ((pn == 4) ? K : V) + krow * KVP + wc * 64;
#pragma unroll
                for (int bj = 0; bj < 2; ++bj)
#pragma unroll
                    for (int n = 0; n < 2; ++n) { v2u w; w.x = pg8::cvt_pk_bf16(y[bj][n].x, y[bj][n].y); w.y = pg8::cvt_pk_bf16(y[bj][n].z, y[bj][n].w); *(v2u*)(dst + 32 * bj + 16 * n + 4 * fq) = w; }
                asm volatile("" ::: "memory");
            }
    }
};
struct EpiResid {
    const float* base; float* out; const float* gate;
    __device__ __forceinline__ void operator()(const AccT& acc, const Unit& u, int wr, int wc, int fr, int fq) const {
        const int b = (u.pm * 256) >> 12; const int col0 = u.pn * 256 + wc * 32 + 4 * fq; const float* g = gate + b * 6144 + col0;
        f32x4 gv[2][2];
#pragma unroll
        for (int bj = 0; bj < 2; ++bj)
#pragma unroll
            for (int n = 0; n < 2; ++n) gv[bj][n] = *(const f32x4*)(g + bj * 128 + n * 16);
#pragma unroll
        for (int ai = 0; ai < 2; ++ai)
#pragma unroll
            for (int m = 0; m < 4; ++m) { const size_t off = (size_t)(u.pm * 256 + ai * 128 + wr * 64 + m * 16 + fr) * 1024 + col0;
#pragma unroll
                for (int bj = 0; bj < 2; ++bj)
#pragma unroll
                    for (int n = 0; n < 2; ++n) { const f32x4 bs = *(const f32x4*)(base + off + bj * 128 + n * 16); *(f32x4*)(out + off + bj * 128 + n * 16) = bs + gv[bj][n] * acc[ai][bj][m][n]; } }
    }
};
__device__ __forceinline__ v4u pack8(const f32x4& a, const f32x4& b) { v4u w; w.x = pg8::cvt_pk_bf16(a.x, a.y); w.y = pg8::cvt_pk_bf16(a.z, a.w); w.z = pg8::cvt_pk_bf16(b.x, b.y); w.w = pg8::cvt_pk_bf16(b.z, b.w); return w; }
struct EpiUp {
    bf16* H1;
    __device__ __forceinline__ void operator()(const AccT& acc, const Unit& u, int wr, int wc, int fr, int fq) const {
#pragma unroll
        for (int ai = 0; ai < 2; ++ai)
#pragma unroll
            for (int m = 0; m < 4; ++m) { f32x4 h[2];
#pragma unroll
                for (int n = 0; n < 2; ++n) { const f32x4 a = acc[ai][0][m][n], b = acc[ai][1][m][n];
#pragma unroll
                    for (int i = 0; i < 4; ++i) h[n][i] = a[i] * __builtin_amdgcn_rcpf(1.0f + __builtin_amdgcn_exp2f(-1.4426950408889634f * a[i])) * b[i]; }
                *(v4u*)(H1 + (size_t)(u.rb + 128 * ai + 64 * wr + 16 * m + fr) * 512 + 128 * u.pn + 32 * wc + 8 * fq) = pack8(h[0], h[1]); }
    }
};
struct EpiDown {
    bf16* Y; const int* list; const float* gate;
    __device__ __forceinline__ void operator()(const AccT& acc, const Unit& u, int wr, int wc, int fr, int fq) const {
        const int* le = list + (size_t)(u.e & 31) * NT_TOK;
#pragma unroll
        for (int ai = 0; ai < 2; ++ai)
#pragma unroll
            for (int m = 0; m < 4; ++m) { const int ridx = u.r0 + 128 * ai + 64 * wr + 16 * m + fr;
                if (ridx < u.cnt) { const int a = le[ridx]; const float g = gate[a]; bf16* dst = Y + (size_t)a * 1024 + 256 * u.pn + 32 * wc + 8 * fq;
#pragma unroll
                    for (int bj = 0; bj < 2; ++bj) *(v4u*)(dst + 128 * bj) = pack8(acc[ai][bj][m][0] * g, acc[ai][bj][m][1] * g); } }
    }
};
struct EpiS {
    bf16* ZT;
    __device__ __forceinline__ void operator()(const AccT& acc, const Unit& u, int wr, int wc, int fr, int fq) const {
#pragma unroll
        for (int ai = 0; ai < 2; ++ai)
#pragma unroll
            for (int m = 0; m < 4; ++m) { const int kp = u.pm * 256 + 128 * ai + 64 * wr + 16 * m + fr;
#pragma unroll
                for (int bj = 0; bj < 2; ++bj) { const int col = u.pn * 256 + 128 * bj + 32 * wc + 8 * fq; const int b = col >> 10, c = col & 1023;
                    *(v4u*)(ZT + ((size_t)b * 8192 + kp) * 1024 + c) = pack8(acc[ai][bj][m][0], acc[ai][bj][m][1]); } }
    }
};
struct EpiC {
    bf16* Fm;
    __device__ __forceinline__ void operator()(const AccT& acc, const Unit& u, int wr, int wc, int fr, int fq) const {
#pragma unroll
        for (int ai = 0; ai < 2; ++ai)
#pragma unroll
            for (int m = 0; m < 4; ++m) { bf16* dst = Fm + (size_t)(u.pm * 256 + 128 * ai + 64 * wr + 16 * m + fr) * 1024 + u.pn * 256 + 32 * wc + 8 * fq;
#pragma unroll
                for (int bj = 0; bj < 2; ++bj) *(v4u*)(dst + 128 * bj) = pack8(acc[ai][bj][m][0], acc[ai][bj][m][1]); }
    }
};

__device__ __forceinline__ void moe_in_phase(const Args& A, Frame& F, int l) {
    const float* X = F.out;
    LAS unsigned* hist = (LAS unsigned*)(F.lds + HIST_OFF); LAS unsigned* hbase = hist + 32;
    unsigned* cnt = (unsigned*)(F.ctl + CW_CNT) + l * 32;
    int* list = (int*)(F.ws + WS_LIST); float* gate = (float*)(F.ws + WS_GATE);
    for (int blk = F.vcu; blk < NT_TOK / 128; blk += F.G) {
        const int tokb = blk * 128, tok0 = tokb + F.wave * 16, b = tokb / SEQ;
        if (F.tid < 32) hist[F.tid] = 0u;
        __syncthreads();
        const int ti = F.lane & 15, kq = F.lane >> 4;
        const float* xr = X + (size_t)(tok0 + ti) * DM + 8 * kq;
        const bf16* wh = (const bf16*)(F.ws + WS_RW) + (size_t)((l * 8 + b) * 2) * 48 * 1024 + (size_t)ti * 1024 + 8 * kq;
        const bf16* wl = wh + 48 * 1024;
        f32x4 acc[3]; acc[0] = (f32x4){0.f, 0.f, 0.f, 0.f}; acc[1] = acc[0]; acc[2] = acc[0];
        float ss = 0.f;
#pragma unroll 2
        for (int s = 0; s < 32; ++s) {
            const f32x4 x0 = *(const GAS f32x4*)(xr + 32 * s), x1 = *(const GAS f32x4*)(xr + 32 * s + 4);
            ss += (x0.x * x0.x + x0.y * x0.y) + (x0.z * x0.z + x0.w * x0.w) + (x1.x * x1.x + x1.y * x1.y) + (x1.z * x1.z + x1.w * x1.w);
            v4u h, lo;
            h.x = pg8::cvt_pk_bf16(x0.x, x0.y); h.y = pg8::cvt_pk_bf16(x0.z, x0.w); h.z = pg8::cvt_pk_bf16(x1.x, x1.y); h.w = pg8::cvt_pk_bf16(x1.z, x1.w);
            lo.x = pg8::cvt_pk_bf16(x0.x - bf2f(h.x & 0xffffu), x0.y - bf2f(h.x >> 16)); lo.y = pg8::cvt_pk_bf16(x0.z - bf2f(h.y & 0xffffu), x0.w - bf2f(h.y >> 16));
            lo.z = pg8::cvt_pk_bf16(x1.x - bf2f(h.z & 0xffffu), x1.y - bf2f(h.z >> 16)); lo.w = pg8::cvt_pk_bf16(x1.z - bf2f(h.w & 0xffffu), x1.w - bf2f(h.w >> 16));
            const bf16x8 ah = __builtin_bit_cast(bf16x8, h), al = __builtin_bit_cast(bf16x8, lo);
#pragma unroll
            for (int cb = 0; cb < 3; ++cb) { const bf16x8 bh = *(const GAS bf16x8*)(wh + cb * 16 * 1024 + 32 * s), bl = *(const GAS bf16x8*)(wl + cb * 16 * 1024 + 32 * s);
                acc[cb] = __builtin_amdgcn_mfma_f32_16x16x32_bf16(ah, bh, acc[cb], 0, 0, 0);
                acc[cb] = __builtin_amdgcn_mfma_f32_16x16x32_bf16(al, bh, acc[cb], 0, 0, 0);
                acc[cb] = __builtin_amdgcn_mfma_f32_16x16x32_bf16(ah, bl, acc[cb], 0, 0, 0); }
        }
        ss += __shfl_xor(ss, 16); ss += __shfl_xor(ss, 32);
        LAS float* scr = (LAS float*)(F.lds + F.wave * 16384);
#pragma unroll
        for (int cb = 0; cb < 3; ++cb)
#pragma unroll
            for (int r = 0; r < 4; ++r) scr[(4 * kq + r) * 49 + 16 * cb + ti] = acc[cb][r];
        if (kq == 0) scr[16 * 49 + ti] = rsqrtf(ss * (1.0f / DM) + EPS);
        LDS_WAIT(); asm volatile("" ::: "memory");
        int e0 = 0, e1 = 0; unsigned rk0 = 0, rk1 = 0; float w0 = 0.f, w1 = 0.f;
        if (F.lane < 16) {
            const float rstd = scr[16 * 49 + F.lane]; const float* bias = (const float*)(F.ws + WS_RBIAS) + (l * 8 + b) * 48; const LAS float* raw = scr + F.lane * 49;
            float lg[4];
#pragma unroll
            for (int g = 0; g < 4; ++g) lg[g] = rstd * raw[g] + bias[g];
            int gs = 0; float mx = lg[0];
#pragma unroll
            for (int g = 1; g < 4; ++g) if (lg[g] > mx) { mx = lg[g]; gs = g; }
            float den = 0.f;
#pragma unroll
            for (int g = 0; g < 4; ++g) den += __expf(lg[g] - mx);
            const float pgrp = 1.0f / den;
            float le[8];
#pragma unroll
            for (int j = 0; j < 8; ++j) le[j] = rstd * raw[4 + gs * 8 + j] + bias[4 + gs * 8 + j];
            int i0 = 0; float m0 = le[0];
#pragma unroll
            for (int j = 1; j < 8; ++j) if (le[j] > m0) { m0 = le[j]; i0 = j; }
            int i1 = -1; float m1 = -INFINITY;
#pragma unroll
            for (int j = 0; j < 8; ++j) if (j != i0 && le[j] > m1) { m1 = le[j]; i1 = j; }
            const float d = __expf(m1 - m0); w0 = pgrp / (1.0f + d); w1 = pgrp * d / (1.0f + d);
            e0 = gs * 8 + i0; e1 = gs * 8 + i1;
            rk0 = __hip_atomic_fetch_add(hist + e0, 1u, __ATOMIC_RELAXED, __HIP_MEMORY_SCOPE_WORKGROUP);
            rk1 = __hip_atomic_fetch_add(hist + e1, 1u, __ATOMIC_RELAXED, __HIP_MEMORY_SCOPE_WORKGROUP);
        }
        __syncthreads();
        if (F.tid < 32) hbase[F.tid] = __hip_atomic_fetch_add(cnt + F.tid, hist[F.tid], __ATOMIC_RELAXED, __HIP_MEMORY_SCOPE_AGENT);
        __syncthreads();
        if (F.lane < 16) { const int t = tok0 + F.lane;
            list[(size_t)e0 * NT_TOK + hbase[e0] + rk0] = 2 * t; list[(size_t)e1 * NT_TOK + hbase[e1] + rk1] = 2 * t + 1;
            gate[2 * t] = w0; gate[2 * t + 1] = w1; }
        RowVec gm, sh; ld_mod(A.in[I_NFFN] + l * 1024, modp(F, l, b, 4), modp(F, l, b, 3), F.lane, gm, sh);
        for (int r = 0; r < 16; ++r) { RowVec x = ld_row(X + (size_t)(tok0 + r) * DM, F.lane); const float rstd = scr[16 * 49 + r];
#pragma unroll
            for (int j = 0; j < 4; ++j) x.v[j] = x.v[j] * rstd * gm.v[j] + sh.v[j];
            st_row_bf16((bf16*)(F.ws + WS_XN) + (size_t)(tok0 + r) * DM, F.lane, x); }
        __syncthreads();
    }
}

__device__ __forceinline__ void grouped_setup(Frame& F, int l, bool with_tab) {
    LAS int* ts = (LAS int*)(F.lds + TS_OFF);
    const unsigned* cnt = (const unsigned*)(F.ctl + CW_CNT) + l * 32;
    if (F.tid < 32) ts[33 + F.tid] = (int)__hip_atomic_load(cnt + F.tid, __ATOMIC_RELAXED, __HIP_MEMORY_SCOPE_AGENT);
    __syncthreads();
    if (F.tid == 0) { int s = 0; for (int e = 0; e < 32; ++e) { ts[e] = s; s += (ts[33 + e] + 255) >> 8; } ts[32] = s; }
    __syncthreads();
    if (with_tab) {
        GroupedOrder S{(const LAS int*)ts, F.G, (int)blockIdx.x, l}; Unit u;
        LAS unsigned* tab = (LAS unsigned*)(F.lds + GTAB_OFF);
        const int* list = (const int*)(F.ws + WS_LIST);
        for (int i = 0; i < 5; ++i) { if (!S.next(i, u)) break;
            if (F.tid < 256) { const int ridx = u.r0 + F.tid; int tok = 0; if (ridx < u.cnt) tok = list[(size_t)(u.e & 31) * NT_TOK + ridx] >> 1; tab[i * 256 + F.tid] = (unsigned)tok * 2048u; } }
        __syncthreads();
    }
}

__device__ __forceinline__ void p8_phase(const Args& A, Frame& F) {
    LAS unsigned char* tile = F.lds;
    const bf16* Y = (const bf16*)(F.ws + WS_Y); bf16* hT = (bf16*)(F.ws + WS_XN);
    for (int it = F.vcu; it < NT_TOK / 32; it += F.G) {
        const int b = it >> 7, rr = (it >> 1) & 63, qh = it & 1;
        const RowVec g2 = ld_row(modp(F, 0, b, 5), F.lane); RowVec gm, sh; ld_mod(A.in[I_NMIX] + 1024, modp(F, 1, b, 1), modp(F, 1, b, 0), F.lane, gm, sh);
        for (int q = 0; q < 4; ++q) { const int r = F.wave * 4 + q; const size_t t = (size_t)b * SEQ + 64 * (32 * qh + r) + rr;
            RowVec x = ld_row(F.out + t * DM, F.lane); const RowVec y0 = ld_row_bf16(Y + (2 * t) * DM, F.lane), y1 = ld_row_bf16(Y + (2 * t + 1) * DM, F.lane);
#pragma unroll
            for (int j = 0; j < 4; ++j) x.v[j] = x.v[j] + g2.v[j] * (y0.v[j] + y1.v[j]);
            st_row(F.out + t * DM, F.lane, x);
            const float rstd = rsqrtf(row_ss(x) * (1.0f / DM) + EPS);
#pragma unroll
            for (int j = 0; j < 4; ++j) { const f32x4 h = x.v[j] * rstd * gm.v[j] + sh.v[j]; v2u w; w.x = pk2(h.x, h.y); w.y = pk2(h.z, h.w); *(LAS v2u*)(tile + r * 2056 + 8 * F.lane + 512 * j) = w; } }
        __syncthreads();
        const int tg = F.lane & 3;
        for (int ic = 0; ic < 8; ++ic) { const int c = 128 * F.wave + 16 * ic + (F.lane >> 2); unsigned e[8];
#pragma unroll
            for (int i = 0; i < 8; ++i) e[i] = *(const LAS unsigned short*)(tile + (8 * tg + i) * 2056 + 2 * c);
            v4u o; o.x = e[0] | (e[1] << 16); o.y = e[2] | (e[3] << 16); o.z = e[4] | (e[5] << 16); o.w = e[6] | (e[7] << 16);
            *(GAS v4u*)(hT + ((size_t)(b * 1024 + c) * 4096 + rr * 64 + 32 * qh + 8 * tg)) = o; }
        __syncthreads();
    }
}

__device__ __forceinline__ void final_phase(const Args& A, Frame& F) {
    const int gw = F.vcu * NWAVES + F.wave, NGW = F.G * NWAVES; const bf16* Y = (const bf16*)(F.ws + WS_Y);
    const RowVec fn = ld_row(A.in[I_FN], F.lane);
    for (int it = gw; it < NT_TOK / 16; it += NGW) { const int t0 = it * 16, b = t0 / SEQ; const RowVec g2 = ld_row(modp(F, 1, b, 5), F.lane);
        for (int r = 0; r < 16; ++r) { const size_t t = (size_t)t0 + r; RowVec x = ld_row(F.out + t * DM, F.lane); const RowVec y0 = ld_row_bf16(Y + (2 * t) * DM, F.lane), y1 = ld_row_bf16(Y + (2 * t + 1) * DM, F.lane);
#pragma unroll
            for (int j = 0; j < 4; ++j) x.v[j] = x.v[j] + g2.v[j] * (y0.v[j] + y1.v[j]);
            const float rstd = rsqrtf(row_ss(x) * (1.0f / DM) + EPS);
#pragma unroll
            for (int j = 0; j < 4; ++j) x.v[j] = x.v[j] * rstd * fn.v[j];
            st_row(F.out + t * DM, F.lane, x); } }
}

typedef float f32x16 __attribute__((ext_vector_type(16)));
__device__ __forceinline__ void fft_cos_table(Frame& F, LAS float* tab) {
    for (int i = F.tid; i < 4096; i += NWAVES * 64) tab[i] = cospif((float)i * (1.0f / 2048.0f));
    __syncthreads();
}
__device__ __forceinline__ void fft_pass_a(Frame& F) {
    LAS float* tab = (LAS float*)F.lds; LAS float* twc = tab + 4096; LAS float* tws = tab + 8192; LAS v4u* bfl = (LAS v4u*)(F.lds + 49152);
    fft_cos_table(F, tab);
    for (int i = F.tid; i < 4096; i += NWAVES * 64) { const int r = i >> 6, k1 = i & 63; twc[i] = tab[r * k1]; tws[i] = tab[(r * k1 - 1024) & 4095]; }
    for (int i = F.tid; i < 16 * 64; i += NWAVES * 64) { const int ln = i & 63, cb = (i >> 6) & 3, s = i >> 8, r32 = ln & 31, h = ln >> 5; float v[8];
        const int col = 32 * cb + r32, k1 = col & 63, cs = col >> 6;
#pragma unroll
        for (int jj = 0; jj < 8; ++jj) { const int k = 16 * s + 8 * h + jj; const int idx = (k * k1 * 64) & 4095; v[jj] = (cs ? -tab[(idx - 1024) & 4095] : tab[idx]) * 0.125f; }
        v4u o; o.x = pk2(v[0], v[1]); o.y = pk2(v[2], v[3]); o.z = pk2(v[4], v[5]); o.w = pk2(v[6], v[7]); bfl[i] = o; }
    __syncthreads();
    const int gw = F.vcu * NWAVES + F.wave, NGW = F.G * NWAVES, r32 = F.lane & 31, h = F.lane >> 5;
    const bf16* hP = (const bf16*)(F.ws + WS_XN); bf16* YP = (bf16*)(F.ws + WS_YP);
    for (int it = gw; it < 16384; it += NGW) { const int bc = it >> 1, r0 = (it & 1) * 32, b = bc >> 10, c = bc & 1023;
        const bf16* arow = hP + (size_t)bc * 4096 + (r0 + r32) * 64 + 8 * h;
        bf16x8 a[4];
#pragma unroll
        for (int s = 0; s < 4; ++s) a[s] = *(const GAS bf16x8*)(arow + 16 * s);
        f32x16 acc[4];
#pragma unroll
        for (int cb = 0; cb < 4; ++cb) { acc[cb] = (f32x16){};
#pragma unroll
            for (int s = 0; s < 4; ++s) acc[cb] = __builtin_amdgcn_mfma_f32_32x32x16_bf16(a[s], __builtin_bit_cast(bf16x8, bfl[(s * 4 + cb) * 64 + F.lane]), acc[cb], 0, 0, 0); }
#pragma unroll
        for (int kb = 0; kb < 2; ++kb) { const int k1 = r32 + 32 * kb; bf16* dst = YP + (((size_t)(b * 64 + k1) * 1024 + c) * 128) + r0 + 4 * h;
#pragma unroll
            for (int g = 0; g < 4; ++g) { float yr[4], yi[4];
#pragma unroll
                for (int i = 0; i < 4; ++i) { const int r = r0 + i + 8 * g + 4 * h; const float cc = twc[r * 64 + k1], ss = tws[r * 64 + k1]; const float ar = acc[kb][4 * g + i], ai = acc[2 + kb][4 * g + i];
                    yr[i] = ar * cc + ai * ss; yi[i] = ai * cc - ar * ss; }
                v2u w; w.x = pk2(yr[0], yr[1]); w.y = pk2(yr[2], yr[3]); *(GAS v2u*)(dst + 8 * g) = w;
                w.x = pk2(yi[0], yi[1]); w.y = pk2(yi[2], yi[3]); *(GAS v2u*)(dst + 64 + 8 * g) = w; } }
    }
}
__device__ __forceinline__ void fft_pass_c(Frame& F) {
    LAS float* tab = (LAS float*)F.lds; LAS v4u* bfl = (LAS v4u*)(F.lds + 16384);
    fft_cos_table(F, tab);
    for (int i = F.tid; i < 32 * 64; i += NWAVES * 64) { const int ln = i & 63, cb = (i >> 6) & 3, s = i >> 8, r32 = ln & 31, h = ln >> 5; float v[8];
        const int col = 32 * cb + r32, k2 = col & 63, cso = col >> 6;
#pragma unroll
        for (int jj = 0; jj < 8; ++jj) { const int k = 16 * s + 8 * h + jj, csi = k >> 6, r = k & 63; const int idx = (r * k2 * 64) & 4095; const float cv = tab[idx], sv = tab[(idx - 1024) & 4095];
            v[jj] = ((csi == cso) ? (csi ? -cv : cv) : sv) * 0.125f; }
        v4u o; o.x = pk2(v[0], v[1]); o.y = pk2(v[2], v[3]); o.z = pk2(v[4], v[5]); o.w = pk2(v[6], v[7]); bfl[i] = o; }
    __syncthreads();
    const int gw = F.vcu * NWAVES + F.wave, NGW = F.G * NWAVES, r32 = F.lane & 31, h = F.lane >> 5;
    const bf16* YP = (const bf16*)(F.ws + WS_YP); bf16* ZT = (bf16*)(F.ws + WS_ZT);
    for (int it = gw; it < 16384; it += NGW) { const int b = it >> 11, k1 = (it >> 5) & 63, cblk = it & 31;
        const bf16* arow = YP + (((size_t)(b * 64 + k1) * 1024 + 32 * cblk + r32) * 128) + 8 * h;
        bf16x8 a[8];
#pragma unroll
        for (int s = 0; s < 8; ++s) a[s] = *(const GAS bf16x8*)(arow + 16 * s);
#pragma unroll 1
        for (int cb = 0; cb < 4; ++cb) { f32x16 acc = (f32x16){};
#pragma unroll
            for (int s = 0; s < 8; ++s) acc = __builtin_amdgcn_mfma_f32_32x32x16_bf16(a[s], __builtin_bit_cast(bf16x8, bfl[(s * 4 + cb) * 64 + F.lane]), acc, 0, 0, 0);
            const int k2 = r32 + 32 * (cb & 1), kp = k1 + 64 * k2 + 4096 * (cb >> 1);
            bf16* dst = ZT + ((size_t)b * 8192 + kp) * 1024 + 32 * cblk + 4 * h;
#pragma unroll
            for (int g = 0; g < 4; ++g) { v2u w; w.x = pk2(acc[4 * g], acc[4 * g + 1]); w.y = pk2(acc[4 * g + 2], acc[4 * g + 3]); *(GAS v2u*)(dst + 8 * g) = w; } }
    }
}

#ifndef PROBE_REP
#define PROBE_REP -1
#endif
template <int K> __device__ __forceinline__ void run_phase(const Args& A, Frame& F, unsigned char* lds, unsigned char* obuf) {
    unsigned char* ws = F.ws;
    constexpr int l = (K >= 13) ? 1 : 0;
    { int ln = threadIdx.x & 63; asm volatile("" : "+v"(ln)); F.lane = ln; }
    if constexpr (K == 0) p0_prologue(A, F);
    else if constexpr (K == 1) p1_phase(A, F);
    else if constexpr (K == 2) { ProbQKV P{16, (const char*)(ws + WS_XN), (const char*)(ws + WS_XNC), (const char*)(ws + WS_WQKV)};
        SchedQKV S; S.base.init(NT_TOK / 256, QKVN / 256, F.G, (int)blockIdx.x);
        EpiQKV E{(bf16*)(ws + WS_QO), (bf16*)(ws + WS_K), (bf16*)(ws + WS_V), A.in[I_QN], A.in[I_KN], (const float*)(ws + WS_ROPE)};
        pg8::gemm_phase<ProbQKV, EpiQKV, SchedQKV, true>(F.lds + RING_OFF, P, S, E); }
    else if constexpr (K == 3) { const int x = F.vcu >> 5, j = F.vcu & 31;
        for (int i = 0; i < 8; ++i) { const int pair = 4 * x + (i >> 1), b = pair >> 2, kvh = pair & 3, un = (i & 1) * 32 + j, h = kvh * 4 + (un >> 4), qb = un & 15;
            const attn_body::bf16* Qu = (const attn_body::bf16*)(ws + WS_QO) + ((size_t)b * SEQ + qb * 256) * 1024 + h * 64;
            attn_body::attn_unit<8, LK / 64>(Qu, (const attn_body::bf16*)(ws + WS_K) + (size_t)b * LK * KVP + kvh * 64, (const attn_body::bf16*)(ws + WS_V) + (size_t)b * LK * KVP + kvh * 64,
                                              (attn_body::bf16*)(obuf) + ((size_t)b * SEQ + qb * 256) * 1024 + h * 64, (char*)lds + RING_OFF); } }
    else if constexpr (K == 4) { ProbStd<false> P{16, (const char*)(ws + WS_QO), (const char*)(ws + WS_WO), 2048, 2048};
        pg8::StaticOrder S; S.init(NT_TOK / 256, 4, F.G, (int)blockIdx.x);
        EpiResid E{A.in[I_X], F.out, modp(F, 0, 0, 2)};
        pg8::gemm_phase<ProbStd<false>, EpiResid, pg8::StaticOrder, true>(F.lds + RING_OFF, P, S, E); }
    else if constexpr (K == 5 || K == 13) moe_in_phase(A, F, l);
    else if constexpr (K == 6 || K == 14) { grouped_setup(F, l, true);
        ProbUp P{16, (const char*)(ws + WS_XN), (const char*)(ws + WS_W13)};
        GroupedOrder S{(const LAS int*)(F.lds + TS_OFF), F.G, (int)blockIdx.x, l};
        EpiUp E{(bf16*)(ws + WS_H1)};
        pg8::gemm_phase<ProbUp, EpiUp, GroupedOrder, true>(F.lds + RING_OFF, P, S, E); }
    else if constexpr (K == 7 || K == 15) { grouped_setup(F, l, false);
        ProbDown P{8, (const char*)(ws + WS_H1), (const char*)(ws + WS_W2)};
        GroupedOrder S{(const LAS int*)(F.lds + TS_OFF), F.G, (int)blockIdx.x, l};
        EpiDown E{(bf16*)(ws + WS_Y), (const int*)(ws + WS_LIST), (const float*)(ws + WS_GATE)};
        pg8::gemm_phase<ProbDown, EpiDown, GroupedOrder, true>(F.lds + RING_OFF, P, S, E); }
    else if constexpr (K == 8) p8_phase(A, F);
    else if constexpr (K == 9) fft_pass_a(F);
    else if constexpr (K == 10) fft_pass_c(F);
    else if constexpr (K == 11) { ProbC P{8, (const char*)(ws + WS_ZT), (const char*)(ws + WS_DFTC)};
        pg8::StaticOrder S; S.init(NT_TOK / 256, 4, F.G, (int)blockIdx.x);
        EpiC E{(bf16*)(ws + WS_QO)};
        pg8::gemm_phase<ProbC, EpiC, pg8::StaticOrder, true>(F.lds + RING_OFF, P, S, E); }
    else if constexpr (K == 12) { ProbStd<false> P{16, (const char*)(ws + WS_QO), (const char*)(ws + WS_WF), 2048, 2048};
        pg8::StaticOrder S; S.init(NT_TOK / 256, 4, F.G, (int)blockIdx.x);
        EpiResid E{F.out, F.out, modp(F, 1, 0, 2)};
        pg8::gemm_phase<ProbStd<false>, EpiResid, pg8::StaticOrder, true>(F.lds + RING_OFF, P, S, E); }
    else if constexpr (K == 16) final_phase(A, F);
}

__global__ void __launch_bounds__(NWAVES * 64, 2) fwd_megakernel(Args args) {
    extern __shared__ __attribute__((aligned(16))) unsigned char lds[];
    Frame F;
    F.lds = (LAS unsigned char*)lds;
    F.MISC = (volatile LAS unsigned*)(F.lds + MISC_OFF);
    F.tid = threadIdx.x; F.lane = F.tid & 63; F.wave = __builtin_amdgcn_readfirstlane(F.tid >> 6);
    F.G = gridDim.x; { const int bx = blockIdx.x; F.vcu = (F.G % 8 == 0) ? (bx % 8) * (F.G / 8) + bx / 8 : bx; }
    F.ws = args.ws; F.out = args.out; F.ctl = (gu32*)(args.ws + WS_CTL);
    for (int u = F.tid; u < (LDS_BYTES - LDSCTL_OFF) / 4; u += NWAVES * 64) ((LAS unsigned*)(F.lds + LDSCTL_OFF))[u] = 0u;
    __syncthreads();
    XcdBarrier bar; bar.bar = (unsigned*)(F.ctl + CW_BAR); bar.x = 0; bar.st = nullptr;
    if (N_LAUNCHES == 1) bar = xcd_barrier_post((unsigned*)(F.ctl + CW_BAR), F.MISC + 8);
    const Args& A = args;
    const int lo = args.ph_lo, hi = args.ph_hi;
#define PH(k) do { if (PH_EN(k) && lo <= (k) && (k) < hi) { \
        if constexpr (PROBE_REP == (k)) { run_phase<k>(A, F, lds, args.ws + WS_XN); xcd_barrier(bar); } \
        run_phase<k>(A, F, lds, args.ws + WS_QO); } \
        if (lo <= (k) && (k) + 1 < hi) xcd_barrier(bar); } while (0)
    PH(0); PH(1); PH(2); PH(3); PH(4); PH(5); PH(6); PH(7); PH(8); PH(9); PH(10); PH(11); PH(12); PH(13); PH(14); PH(15); PH(16);
#undef PH
}

extern "C" void kernel_launch(void* const* d_in, const int* in_sizes, int n_in, void* d_out, int out_size, void* d_ws, size_t ws_size, hipStream_t stream) {
    static int grid = 0;
    if (grid == 0) {
        if (n_in != 21 || out_size != NT_TOK * DM || ws_size < WS_END) { fprintf(stderr, "kernel_launch: unexpected problem (n_in %d, out %d, ws %zu < %zu)\n", n_in, out_size, ws_size, (size_t)WS_END); grid = -1; return; }
        int dev = 0, cus = 0;
        if (hipGetDevice(&dev) != hipSuccess || hipDeviceGetAttribute(&cus, hipDeviceAttributeMultiprocessorCount, dev) != hipSuccess) { grid = -1; return; }
        if (hipFuncSetAttribute((const void*)fwd_megakernel, hipFuncAttributeMaxDynamicSharedMemorySize, LDS_BYTES) != hipSuccess) { fprintf(stderr, "kernel_launch: hipFuncSetAttribute failed\n"); grid = -1; return; }
        int per_cu = 0;
        if (hipOccupancyMaxActiveBlocksPerMultiprocessor(&per_cu, (const void*)fwd_megakernel, NWAVES * 64, LDS_BYTES) != hipSuccess || per_cu < 1) fprintf(stderr, "kernel_launch: occupancy query says %d\n", per_cu);
        (void)hipGetLastError();
        grid = 256;
        if (cus != 256) fprintf(stderr, "kernel_launch: device has %d CUs, kernel built for 256\n", cus);
    }
    if (grid < 0) return;
    (void)hipMemsetAsync((char*)d_ws + WS_CTL, 0, CTL_ZERO_BYTES, stream);
    Args a{};
    for (int i = 0; i < 21; ++i) a.in[i] = (const float*)d_in[i];
    a.out = (float*)d_out; a.ws = (unsigned char*)d_ws;
    if (N_LAUNCHES == 1) { a.ph_lo = 0; a.ph_hi = N_PHASES; hipLaunchKernelGGL(fwd_megakernel, dim3(grid), dim3(NWAVES * 64), LDS_BYTES, stream, a); }
    else for (int p = 0; p < N_PHASES; ++p) { a.ph_lo = p; a.ph_hi = p + 1; hipLaunchKernelGGL(fwd_megakernel, dim3(grid), dim3(NWAVES * 64), LDS_BYTES, stream, a); }
}
```

```cpp
#include <hip/hip_runtime.h>
#include <hip/hip_bf16.h>
#include <cstdio>
#include <cstdint>
#include <cmath>

#ifndef PHMASK
#define PHMASK 0x1FFFF
#endif
#define PH_EN(k) (((PHMASK) >> (k)) & 1)
#ifndef MK_N_LAUNCHES
#define MK_N_LAUNCHES 1
#endif

constexpr int NB = 8, SEQ = 4096, DM = 1024, NT_TOK = NB * SEQ, CTXL = 256, NCTX = NB * CTXL, LK = SEQ + CTXL;
constexpr int NHEAD = 16, NKVH = 4, HD = 64, QKVN = 1536, KVP = 256;
constexpr int NEXP = 32, DEXP = 512, NGRP = 4, EPG = 8;
constexpr float EPS = 1e-6f;

namespace pg8 {
#define PG8_LAS __attribute__((address_space(3)))
typedef unsigned short bf16_t;
typedef short bf16x8 __attribute__((ext_vector_type(8)));
typedef float f32x4 __attribute__((ext_vector_type(4)));
typedef unsigned u32x4 __attribute__((ext_vector_type(4)));
typedef unsigned u32x2 __attribute__((ext_vector_type(2)));
constexpr int BM = 256, BK = 64, HALF = 128, HTB = HALF * BK * 2, STAGE_BYTES = 8 * HTB, NXCD = 8, WGM = 8;

__host__ __device__ __forceinline__ int lds_byte(int r, int c) { const int st = (r >> 4) * 2 + (c >> 5), rr = r & 15, cc = c & 31, ob = rr * 64 + cc * 2; return st * 1024 + (ob ^ (((ob >> 9) & 1) << 5)); }
__host__ __device__ __forceinline__ void stage_rc(int b, int& R, int& C) { const int st = b / 1024, sb = b % 1024, swz = sb ^ (((sb >> 9) & 1) << 5); R = (st >> 1) * 16 + swz / 64; C = (st & 1) * 32 + (swz % 64) / 2; }
__host__ __device__ __forceinline__ int perm32(int rho) { const int n = rho >> 4, i = rho & 15; return 8 * (i >> 2) + 4 * n + (i & 3); }

struct Unit { int pm, pn, e, r0, cnt, rb, ui; };

__device__ __forceinline__ int xcd_remap(int wgid, int nwg) { const int q = nwg / NXCD, r = nwg % NXCD, xcd = wgid % NXCD, off = wgid / NXCD; return (xcd < r ? xcd * (q + 1) : r * (q + 1) + (xcd - r) * q) + off; }

struct StaticOrder {
    int nM, nN, nwg, G, c;
    __device__ void init(int nM_, int nN_, int G_, int c_) { nM = nM_; nN = nN_; nwg = nM * nN; G = G_; c = c_; }
    __device__ bool next(int i, Unit& u) const {
        const long L = (long)i * G + c; if (L >= nwg) return false;
        const int wgid = xcd_remap((int)L, nwg);
        const int nig = WGM * nN, gid = wgid / nig, fm = gid * WGM, gsz = (nM - fm) < WGM ? (nM - fm) : WGM;
        u.pm = fm + ((wgid % nig) % gsz); u.pn = (wgid % nig) / gsz; u.e = 0; u.r0 = 0; u.cnt = 0; u.rb = 0; u.ui = i; return true;
    }
};

__device__ __forceinline__ unsigned cvt_pk_bf16(float lo, float hi) { unsigned r; asm volatile("v_cvt_pk_bf16_f32 %0, %1, %2" : "=v"(r) : "v"(lo), "v"(hi)); return r; }

template <class Prob, class Epi, class Sched, bool ALIGN_EPI>
__device__ __forceinline__ void gemm_phase(PG8_LAS unsigned char* lds, const Prob& P, const Sched& S, const Epi& E) {
    const int tid = threadIdx.x, wid = __builtin_amdgcn_readfirstlane(tid >> 6), lane = tid & 63, wr = wid >> 2, wc = wid & 3, fr = lane & 15, fq = lane >> 4;
    const int nt = P.nt;
    int Rr[2], Cc[2];
    unsigned voffA[2], voffB[2];
#pragma unroll
    for (int i = 0; i < 2; ++i) { stage_rc(tid * 16 + i * 8192, Rr[i], Cc[i]); voffA[i] = P.a_voff(Rr[i], Cc[i]); voffB[i] = P.b_voff(Rr[i], Cc[i]); }
    const size_t hstepA = P.a_hstep(), hstepB = P.b_hstep();
    const unsigned ldsw = (unsigned)wid * 1024u;
    const int aoff = lds_byte(wr * 64 + fr, fq * 8), boff = lds_byte(wc * 32 + fr, fq * 8);
    unsigned cva0[2] = {0, 0}, cva1[2] = {0, 0}, nva0[2] = {0, 0}, nva1[2] = {0, 0};
    const PG8_LAS unsigned* tab = (const PG8_LAS unsigned*)(lds + Prob::tab_off);
#define PG8_SA(b, h) (((b) * 2 + (h)) * HTB)
#define PG8_SB(b, h) ((4 + (b) * 2 + (h)) * HTB)
#define PG8_STAGE(bufoff, gbase, voff) do { _Pragma("unroll") for (int _i = 0; _i < 2; ++_i) \
        __builtin_amdgcn_global_load_lds((const unsigned*)((const char*)(gbase) + (voff)[_i]), (PG8_LAS unsigned*)(lds + (bufoff) + ldsw + _i * 8192), 16, 0, 0); } while (0)
#define PG8_LDA(dst, b, h) do { _Pragma("unroll") for (int m = 0; m < 4; ++m) _Pragma("unroll") for (int k = 0; k < 2; ++k) dst[m][k] = *(const PG8_LAS bf16x8*)(lds + PG8_SA(b, h) + aoff + m * 2048 + k * 1024); } while (0)
#define PG8_LDB(dst, b, h) do { _Pragma("unroll") for (int n = 0; n < 2; ++n) _Pragma("unroll") for (int k = 0; k < 2; ++k) dst[n][k] = *(const PG8_LAS bf16x8*)(lds + PG8_SB(b, h) + boff + n * 2048 + k * 1024); } while (0)
#define PG8_MMA(ai, bj, At, Bt) do { __builtin_amdgcn_s_setprio(1); _Pragma("unroll") for (int m = 0; m < 4; ++m) _Pragma("unroll") for (int n = 0; n < 2; ++n) _Pragma("unroll") for (int k = 0; k < 2; ++k) \
        acc[ai][bj][m][n] = __builtin_amdgcn_mfma_f32_16x16x32_bf16(Bt[n][k], At[m][k], acc[ai][bj][m][n], 0, 0, 0); __builtin_amdgcn_s_setprio(0); } while (0)
#define PG8_WAIT_V(n) asm volatile("s_waitcnt vmcnt(" #n ")" ::: "memory")
#define PG8_WAIT_L(n) asm volatile("s_waitcnt lgkmcnt(" #n ")" ::: "memory")
#define PG8_BAR __builtin_amdgcn_s_barrier()
#define PG8_SCHED __builtin_amdgcn_sched_barrier(0)
#define PG8_STAGE_A(bufoff, gb, h, VO0, VO1) do { if constexpr (Prob::GATHER) { if ((h) == 0) PG8_STAGE(bufoff, gb, VO0); else PG8_STAGE(bufoff, gb, VO1); } else { PG8_STAGE(bufoff, (gb) + (h) * hstepA, voffA); } } while (0)
    Unit cur, nxt; int ui = 0;
    if (!S.next(0, cur)) return;
    f32x4 acc[2][2][4][2];
#pragma unroll
    for (int a = 0; a < 2; ++a)
#pragma unroll
        for (int b = 0; b < 2; ++b)
#pragma unroll
            for (int m = 0; m < 4; ++m)
#pragma unroll
                for (int n = 0; n < 2; ++n) acc[a][b][m][n] = (f32x4){0.f, 0.f, 0.f, 0.f};
    bf16x8 At[4][2], B0[2][2], B1[2][2];
    const char* cA = P.a_unit(cur); const char* cB = P.b_unit(cur);
    if constexpr (Prob::GATHER) {
#pragma unroll
        for (int i = 0; i < 2; ++i) { cva0[i] = tab[cur.ui * 256 + Rr[i]] + (unsigned)Cc[i] * 2u; cva1[i] = tab[cur.ui * 256 + 128 + Rr[i]] + (unsigned)Cc[i] * 2u; }
    }
    PG8_STAGE(PG8_SB(0, 0), cB + P.b_kt(0), voffB); PG8_STAGE(PG8_SB(0, 1), cB + P.b_kt(0) + hstepB, voffB); PG8_STAGE_A(PG8_SA(0, 0), cA + P.a_kt(0), 0, cva0, cva1); PG8_STAGE_A(PG8_SA(0, 1), cA + P.a_kt(0), 1, cva0, cva1);
    if (wr == 1) PG8_BAR;
    PG8_WAIT_V(2); PG8_BAR;
    PG8_STAGE(PG8_SB(1, 0), cB + P.b_kt(1), voffB); PG8_STAGE_A(PG8_SA(1, 0), cA + P.a_kt(1), 0, cva0, cva1); PG8_STAGE(PG8_SB(1, 1), cB + P.b_kt(1) + hstepB, voffB);
    PG8_WAIT_V(6); PG8_BAR;
    for (;;) {
        const bool has_next = S.next(ui + 1, nxt);
        const char* nA = has_next ? P.a_unit(nxt) : cA; const char* nB = has_next ? P.b_unit(nxt) : cB;
        if constexpr (Prob::GATHER) {
            const int nu = has_next ? nxt.ui : cur.ui;
#pragma unroll
            for (int i = 0; i < 2; ++i) { nva0[i] = tab[nu * 256 + Rr[i]] + (unsigned)Cc[i] * 2u; nva1[i] = tab[nu * 256 + 128 + Rr[i]] + (unsigned)Cc[i] * 2u; }
        }
        for (int t = 0; t < nt; t += 2) {
            const bool last = (t == nt - 2);
            const char* a1 = cA + P.a_kt(t + 1);
            const char* a2 = last ? nA + P.a_kt(0) : cA + P.a_kt(t + 2); const char* b2 = last ? nB + P.b_kt(0) : cB + P.b_kt(t + 2);
            const char* a3 = last ? nA + P.a_kt(1) : cA + P.a_kt(t + 3); const char* b3 = last ? nB + P.b_kt(1) : cB + P.b_kt(t + 3);
            unsigned sv0[2] = {0, 0}, sv1[2] = {0, 0};
            if constexpr (Prob::GATHER) {
#pragma unroll
                for (int i = 0; i < 2; ++i) { sv0[i] = last ? nva0[i] : cva0[i]; sv1[i] = last ? nva1[i] : cva1[i]; }
            }
            PG8_LDB(B0, 0, 0); PG8_LDB(B1, 0, 1); PG8_SCHED; PG8_LDA(At, 0, 0); PG8_STAGE_A(PG8_SA(1, 1), a1, 1, cva0, cva1);
            PG8_WAIT_V(8); PG8_WAIT_L(0); PG8_BAR; PG8_MMA(0, 0, At, B0); PG8_MMA(0, 1, At, B1); PG8_BAR; PG8_SCHED;
            PG8_LDA(At, 0, 1); PG8_STAGE(PG8_SB(0, 0), b2, voffB); PG8_STAGE(PG8_SB(0, 1), b2 + hstepB, voffB); PG8_STAGE_A(PG8_SA(0, 0), a2, 0, sv0, sv1);
            PG8_WAIT_V(8); PG8_WAIT_L(0); PG8_BAR; PG8_MMA(1, 0, At, B0); PG8_MMA(1, 1, At, B1); PG8_BAR; PG8_SCHED;
            PG8_LDB(B0, 1, 0); PG8_LDB(B1, 1, 1); PG8_SCHED; PG8_LDA(At, 1, 0); PG8_STAGE_A(PG8_SA(0, 1), a2, 1, sv0, sv1);
            PG8_WAIT_V(8); PG8_WAIT_L(0); PG8_BAR; PG8_MMA(0, 0, At, B0); PG8_MMA(0, 1, At, B1); PG8_BAR; PG8_SCHED;
            PG8_LDA(At, 1, 1); PG8_STAGE(PG8_SB(1, 0), b3, voffB); PG8_STAGE(PG8_SB(1, 1), b3 + hstepB, voffB); PG8_STAGE_A(PG8_SA(1, 0), a3, 0, sv0, sv1);
            PG8_WAIT_V(8); PG8_WAIT_L(0); PG8_BAR; PG8_MMA(1, 0, At, B0); PG8_MMA(1, 1, At, B1); PG8_BAR; PG8_SCHED;
        }
        if constexpr (ALIGN_EPI) { if (wr == 0) PG8_BAR; }
        E(acc, cur, wr, wc, fr, fq);
        if (!has_next) break;
#pragma unroll
        for (int a = 0; a < 2; ++a)
#pragma unroll
            for (int b = 0; b < 2; ++b)
#pragma unroll
                for (int m = 0; m < 4; ++m)
#pragma unroll
                    for (int n = 0; n < 2; ++n) acc[a][b][m][n] = (f32x4){0.f, 0.f, 0.f, 0.f};
        cur = nxt; cA = nA; cB = nB; ++ui;
        if constexpr (Prob::GATHER) {
#pragma unroll
            for (int i = 0; i < 2; ++i) { cva0[i] = nva0[i]; cva1[i] = nva1[i]; }
        }
        if constexpr (ALIGN_EPI) { if (wr == 1) PG8_BAR; }
    }
    PG8_WAIT_V(0);
    if constexpr (!ALIGN_EPI) { if (wr == 0) PG8_BAR; }
    PG8_BAR;
#undef PG8_SA
#undef PG8_SB
#undef PG8_STAGE
#undef PG8_STAGE_A
#undef PG8_LDA
#undef PG8_LDB
#undef PG8_MMA
#undef PG8_WAIT_V
#undef PG8_WAIT_L
#undef PG8_BAR
#undef PG8_SCHED
}
}

namespace attn_body {
using bf16=__hip_bfloat16;
using bf16x8=__attribute__((ext_vector_type(8)))short;
using s16x4=__attribute__((ext_vector_type(4)))short;
using f32x16=__attribute__((ext_vector_type(16)))float;
using u32x4=__attribute__((ext_vector_type(4)))unsigned;
constexpr int D=64,QP=1024,KP=256;
constexpr int NW=8,QBLK=32,QB=QBLK*NW,KVBLK=64;
__device__ __forceinline__ int crow(int r,int hi){return (r&3)+8*(r>>2)+4*hi;}
#define SBAR() __builtin_amdgcn_sched_barrier(0)
constexpr int NSLOT=3, SLOTB=8192;
constexpr int LDS_K=0, LDS_V=NSLOT*SLOTB, LDS_WS=2*NSLOT*SLOTB, LDS_OST=LDS_WS+NW*64*4, LDS_BYTES=LDS_OST+NW*4096;
constexpr float C2=0.125f*1.4426950408889634f;
__device__ __forceinline__ void glds16(const void*gsrc,unsigned lds_dst){unsigned keep;
  asm volatile("s_mov_b32 %0, m0\n\ts_mov_b32 m0, %2\n\ts_nop 0\n\tglobal_load_lds_dwordx4 %1, off\n\ts_mov_b32 m0, %0":"=&s"(keep):"v"(gsrc),"s"(lds_dst):"memory");}
__device__ __forceinline__ float max3f(float a,float b,float c){float r;asm("v_max3_f32 %0, %1, %2, %3":"=v"(r):"v"(a),"v"(b),"v"(c));return r;}
__device__ __forceinline__ float max2f(float a,float b){float r;asm("v_max_f32_e32 %0, %1, %2":"=v"(r):"v"(a),"v"(b));return r;}
__device__ __forceinline__ float fadd_s(float a,float b){float r;asm("v_add_f32_e32 %0, %1, %2":"=v"(r):"v"(a),"v"(b));return r;}
__device__ __forceinline__ float fsub_s(float a,float b){float r;asm("v_sub_f32_e32 %0, %1, %2":"=v"(r):"v"(a),"v"(b));return r;}
typedef float f32x2_t __attribute__((ext_vector_type(2))); typedef __bf16 bf16x2_t __attribute__((ext_vector_type(2)));
__device__ __forceinline__ unsigned cvtpk_s(float lo,float hi){f32x2_t v={lo,hi};bf16x2_t b=__builtin_convertvector(v,bf16x2_t);return __builtin_bit_cast(unsigned,b);}
#define WAIT_BAR(N) asm volatile("s_waitcnt vmcnt(" #N ") lgkmcnt(0)\n\ts_barrier":::"memory")

__device__ __forceinline__ void qkt(f32x16&p0,f32x16&p1,const char*Kslot,const bf16x8*qr,const f32x16&negm,int r32,int hi){
  const char*kb=Kslot+hi*1024+r32*16;
  #pragma unroll
  for(int d0=0;d0<4;++d0){
    const bf16x8 b0=*reinterpret_cast<const bf16x8*>(kb+d0*2048);
    const bf16x8 b1=*reinterpret_cast<const bf16x8*>(kb+d0*2048+512);
    if(d0==0){p0=__builtin_amdgcn_mfma_f32_32x32x16_bf16(b0,qr[0],negm,0,0,0);p1=__builtin_amdgcn_mfma_f32_32x32x16_bf16(b1,qr[0],negm,0,0,0);}
    else{p0=__builtin_amdgcn_mfma_f32_32x32x16_bf16(b0,qr[d0],p0,0,0,0);p1=__builtin_amdgcn_mfma_f32_32x32x16_bf16(b1,qr[d0],p1,0,0,0);}}
}
typedef __attribute__((address_space(3))) const char* lds_cptr;
typedef short v4i16_t __attribute__((ext_vector_type(4)));
__device__ __forceinline__ void kload8(bf16x8*kf,lds_cptr kp){
  kf[0]=*(const __attribute__((address_space(3))) bf16x8*)(kp);      kf[1]=*(const __attribute__((address_space(3))) bf16x8*)(kp+512);
  kf[2]=*(const __attribute__((address_space(3))) bf16x8*)(kp+2048); kf[3]=*(const __attribute__((address_space(3))) bf16x8*)(kp+2560);
  kf[4]=*(const __attribute__((address_space(3))) bf16x8*)(kp+4096); kf[5]=*(const __attribute__((address_space(3))) bf16x8*)(kp+4608);
  kf[6]=*(const __attribute__((address_space(3))) bf16x8*)(kp+6144); kf[7]=*(const __attribute__((address_space(3))) bf16x8*)(kp+6656);
}
__device__ __forceinline__ void kload2(bf16x8*kf,lds_cptr kp,int j){ kf[2*j]=*(const __attribute__((address_space(3))) bf16x8*)(kp+j*2048); kf[2*j+1]=*(const __attribute__((address_space(3))) bf16x8*)(kp+j*2048+512); }
__device__ __forceinline__ s16x4 vtr(lds_cptr p){ return __builtin_bit_cast(s16x4,__builtin_amdgcn_ds_read_tr16_b64_v4i16((__attribute__((address_space(3))) v4i16_t*)p)); }
__device__ __forceinline__ float rowmax(const f32x16&p0,const f32x16&p1){
  float a=max3f(p0[0],p0[1],p1[0]),b=max3f(p0[2],p0[3],p1[1]);a=max3f(a,p1[2],p1[3]);
  #pragma unroll
  for(int r=4;r<16;r+=4){a=max3f(a,p0[r],p0[r+1]);b=max3f(b,p0[r+2],p0[r+3]);a=max3f(a,p1[r],p1[r+1]);b=max3f(b,p1[r+2],p1[r+3]);}
  const float m=max2f(a,b);
  auto rr=__builtin_amdgcn_permlane32_swap(__float_as_uint(m),__float_as_uint(m),false,false);
  return max2f(__uint_as_float(rr[0]),__uint_as_float(rr[1]));
}
__device__ __forceinline__ void pv(f32x16*o,int vb,bf16x8 pa0,bf16x8 pa1,bf16x8 pa2,bf16x8 pa3){
  #pragma unroll
  for(int d0=0;d0<2;++d0){s16x4 lo[4],hi[4];
    #pragma unroll
    for(int ks=0;ks<4;++ks){
      asm volatile("ds_read_b64_tr_b16 %0,%1 offset:%c2":"=&v"(lo[ks]):"v"(vb),"i"(d0*4096+ks*1024):"memory");
      asm volatile("ds_read_b64_tr_b16 %0,%1 offset:%c2":"=&v"(hi[ks]):"v"(vb),"i"(d0*4096+ks*1024+512):"memory");}
    asm volatile("s_waitcnt lgkmcnt(0)":::"memory");SBAR();
    #define PK(k) (bf16x8){lo[k][0],lo[k][1],lo[k][2],lo[k][3],hi[k][0],hi[k][1],hi[k][2],hi[k][3]}
    o[d0]=__builtin_amdgcn_mfma_f32_32x32x16_bf16(pa0,PK(0),o[d0],0,0,0);
    o[d0]=__builtin_amdgcn_mfma_f32_32x32x16_bf16(pa1,PK(1),o[d0],0,0,0);
    o[d0]=__builtin_amdgcn_mfma_f32_32x32x16_bf16(pa2,PK(2),o[d0],0,0,0);
    o[d0]=__builtin_amdgcn_mfma_f32_32x32x16_bf16(pa3,PK(3),o[d0],0,0,0);
    #undef PK
  }
}
#define ATTN_STORE16(p,v) (*(u32x4*)(p)=(v))
template<int THRL,int NT> __device__ __forceinline__ void attn_unit(const bf16*Qu,const bf16*__restrict__ Kh,const bf16*__restrict__ Vh,bf16*Ou,char*shm){
  const int tid=threadIdx.x,lane=tid&63,r32=lane&31,hi=lane>>5; const int wid=__builtin_amdgcn_readfirstlane(tid>>6);
  const bf16*Qw=Qu+(long)(wid*QBLK)*QP;
  const unsigned lds0=(unsigned)(uintptr_t)shm;
  float*wsf=(float*)(shm+LDS_WS)+wid*64;
  const bf16*ksrc=Kh+(long)lane*KP+wid*8;
  const bf16*vsrc=Vh+(long)(16*(wid&3)+(lane>>2))*KP+(wid>>2)*32+(lane&3)*8;
  const unsigned kdst=lds0+LDS_K+wid*1024, vdst=lds0+LDS_V+wid*1024;
  #define DMA_K(t,slot) glds16(ksrc+(long)(t)*KVBLK*KP,(unsigned)__builtin_amdgcn_readfirstlane(kdst+(slot)))
  #define DMA_V(t,slot) glds16(vsrc+(long)(t)*KVBLK*KP,(unsigned)__builtin_amdgcn_readfirstlane(vdst+(slot)))
  const int vb0=(int)(lds0+LDS_V)+((lane>>4)&1)*32+(lane&3)*8+(4*hi+((lane&15)>>2))*64;
  const char*Kbase=shm+LDS_K; bf16x8 kf[8];
  const lds_cptr shm3=(lds_cptr)shm; const lds_cptr kp0=shm3+LDS_K+hi*1024+r32*16; const lds_cptr vp0=shm3+LDS_V+((lane>>4)&1)*32+(lane&3)*8+(4*hi+((lane&15)>>2))*64;
  DMA_K(0,0);DMA_V(0,0);DMA_K(1,SLOTB);
  bf16x8 qr[4];
  #pragma unroll
  for(int d0=0;d0<4;++d0)qr[d0]=*reinterpret_cast<const bf16x8*>(&Qw[(long)r32*QP+d0*16+hi*8]);
  float mhat=0.f,l_reg=0.f;f32x16 o[2];o[0]=f32x16{};o[1]=f32x16{};f32x16 negm=f32x16{};asm volatile("":"+v"(negm));
  bool resc=false;
  #define START(P0,P1) do{ const float rm=rowmax(P0,P1); resc=false; \
    { const float dl=rm; mhat=fadd_s(mhat,dl); \
      _Pragma("unroll") for(int r=0;r<16;++r){P0[r]=fsub_s(P0[r],dl);P1[r]=fsub_s(P1[r],dl);} \
      _Pragma("unroll") for(int r=0;r<16;++r)negm[r]=-mhat; asm volatile("":"+v"(negm)); } \
    _Pragma("unroll") for(int r=0;r<16;++r)P0[r]=__builtin_amdgcn_exp2f(P0[r]); }while(0)
  #define RESC() do{ if(resc){ asm volatile("s_waitcnt lgkmcnt(0)":::"memory"); \
      _Pragma("unroll") for(int d_=0;d_<2;++d_) _Pragma("unroll") for(int r=0;r<16;++r)o[d_][r]*=wsf[crow(r,hi)]; } }while(0)
  f32x16 pA0,pA1,pB0,pB1;
  int sl_prev=0,sl_cur=0,sl_next=SLOTB;
  #define ROT() do{sl_prev=sl_cur;sl_cur=sl_next;sl_next=(sl_next==(NSLOT-1)*SLOTB)?0:sl_next+SLOTB;}while(0)
  DMA_K(2,2*SLOTB);
  WAIT_BAR(3);
  qkt(pA0,pA1,Kbase,qr,negm,r32,hi);asm volatile("s_nop 15\n\ts_nop 7":"+v"(pA0),"+v"(pA1));
  START(pA0,pA1);
  _Pragma("unroll") for(int r=0;r<16;++r)pA1[r]=__builtin_amdgcn_exp2f(pA1[r]);
  WAIT_BAR(0);
  DMA_K(3,0);DMA_V(1,SLOTB);
  ROT();
  kload8(kf,kp0+sl_cur);
  WAIT_BAR(2);
  s16x4 vlo[8],vhi[8]; u32x4 pw0,pw1,pw2,pw3;
  #define PKW(P,B) cvtpk_s(P[B],P[B+1])
  #define PAF(k) __builtin_bit_cast(bf16x8,pw##k)
  #define VFR(i) (bf16x8){vlo[i][0],vlo[i][1],vlo[i][2],vlo[i][3],vhi[i][0],vhi[i][1],vhi[i][2],vhi[i][3]}
  #define PIN(x) asm volatile("":"+v"(x))
  #define MX3(a,b,c) __builtin_fmaxf(__builtin_fmaxf((a),(b)),(c))
  #define GAPA(MF,A0,A1,A2,A3,W0,W1,PW) do{ MF; sacc+=A0; sacc+=A1; sacc+=A2; sacc+=A3; PIN(sacc); W0; W1; PIN(PW); SBAR(); }while(0)
  #define EX(v) __builtin_amdgcn_exp2f(v)
  #define GAPB(MF,X,B) do{ MF; X[B]=EX(X[B]); X[B+1]=EX(X[B+1]); X[B+2]=EX(X[B+2]); X[B+3]=EX(X[B+3]); PIN(X); SBAR(); }while(0)
  #define VRD(i) do{ vlo[i]=vtr(vp_+(((i)>>2)*4096+((i)&3)*1024)); vhi[i]=vtr(vp_+(((i)>>2)*4096+((i)&3)*1024+512)); }while(0)
  #define KRD(G,j) do{ if(G){ kload2(kf,kp0+sl_next,j); SBAR(); } }while(0)
  #define STEP(C0,C1,P0,P1,t,GK,GV,GL) do{ SBAR(); \
    const lds_cptr vp_=vp0+sl_prev; \
    VRD(0); SBAR(); float sacc=(P0[0]+P0[1]); \
    GAPA(C0=__builtin_amdgcn_mfma_f32_32x32x16_bf16(kf[0],qr[0],negm,0,0,0), P0[2],P0[3],P0[4],P0[5],     pw0[0]=PKW(P0,0), pw0[1]=PKW(P0,2), pw0); \
    VRD(4); SBAR(); GAPA(C1=__builtin_amdgcn_mfma_f32_32x32x16_bf16(kf[1],qr[0],negm,0,0,0), P0[6],P0[7],P0[8],P0[9],     pw0[2]=PKW(P0,4), pw0[3]=PKW(P0,6), pw0); \
    VRD(1); SBAR(); GAPA(C0=__builtin_amdgcn_mfma_f32_32x32x16_bf16(kf[2],qr[1],C0,0,0,0),   P0[10],P0[11],P0[12],P0[13], pw1[0]=PKW(P0,8), pw1[1]=PKW(P0,10), pw1); \
    VRD(5); SBAR(); GAPA(C1=__builtin_amdgcn_mfma_f32_32x32x16_bf16(kf[3],qr[1],C1,0,0,0),   P0[14],P0[15],P1[0],P1[1],   pw1[2]=PKW(P0,12),pw1[3]=PKW(P0,14), pw1); \
    VRD(2); SBAR(); GAPA(C0=__builtin_amdgcn_mfma_f32_32x32x16_bf16(kf[4],qr[2],C0,0,0,0),   P1[2],P1[3],P1[4],P1[5],     pw2[0]=PKW(P1,0), pw2[1]=PKW(P1,2), pw2); \
    VRD(6); SBAR(); GAPA(C1=__builtin_amdgcn_mfma_f32_32x32x16_bf16(kf[5],qr[2],C1,0,0,0),   P1[6],P1[7],P1[8],P1[9],     pw2[2]=PKW(P1,4), pw2[3]=PKW(P1,6), pw2); \
    VRD(3); SBAR(); GAPA(C0=__builtin_amdgcn_mfma_f32_32x32x16_bf16(kf[6],qr[3],C0,0,0,0),   P1[10],P1[11],P1[12],P1[13], pw3[0]=PKW(P1,8), pw3[1]=PKW(P1,10), pw3); \
    VRD(7); SBAR(); GAPA(C1=__builtin_amdgcn_mfma_f32_32x32x16_bf16(kf[7],qr[3],C1,0,0,0),   P1[14],P1[15],0.f,0.f,       pw3[2]=PKW(P1,12),pw3[3]=PKW(P1,14), pw3); \
    l_reg+=sacc; \
    if(GK){DMA_K((t)+3,sl_cur);} if(GV){DMA_V((t)+1,sl_next);} \
    { float a=MX3(C0[0],C0[1],C1[0]),b=MX3(C0[2],C0[3],C1[1]); a=MX3(a,C1[2],C1[3]); \
      _Pragma("unroll") for(int r=4;r<16;r+=4){a=MX3(a,C0[r],C0[r+1]);b=MX3(b,C0[r+2],C0[r+3]);a=MX3(a,C1[r],C1[r+1]);b=MX3(b,C1[r+2],C1[r+3]);} \
      float rm=__builtin_fmaxf(a,b); { auto rr=__builtin_amdgcn_permlane32_swap(__float_as_uint(rm),__float_as_uint(rm),false,false); rm=__builtin_fmaxf(__uint_as_float(rr[0]),__uint_as_float(rr[1])); } \
      resc=false; \
      if(__builtin_expect(__any(rm>(float)THRL),0)){ const float dl=__builtin_fmaxf(rm,0.f); mhat+=dl; \
        _Pragma("unroll") for(int r=0;r<16;++r){C0[r]-=dl;C1[r]-=dl;} \
        _Pragma("unroll") for(int r=0;r<16;++r)negm[r]=-mhat; asm volatile("":"+v"(negm)); \
        const float f=__builtin_amdgcn_exp2f(-dl); l_reg*=f; if(hi==0)wsf[r32]=f; resc=true; } } \
    SBAR(); \
    GAPB(o[0]=__builtin_amdgcn_mfma_f32_32x32x16_bf16(PAF(0),VFR(0),o[0],0,0,0), C0,0); \
    GAPB(o[1]=__builtin_amdgcn_mfma_f32_32x32x16_bf16(PAF(0),VFR(4),o[1],0,0,0), C0,4); \
    KRD(GL,0); GAPB(o[0]=__builtin_amdgcn_mfma_f32_32x32x16_bf16(PAF(1),VFR(1),o[0],0,0,0), C0,8); \
    KRD(GL,1); GAPB(o[1]=__builtin_amdgcn_mfma_f32_32x32x16_bf16(PAF(1),VFR(5),o[1],0,0,0), C0,12); \
    KRD(GL,2); GAPB(o[0]=__builtin_amdgcn_mfma_f32_32x32x16_bf16(PAF(2),VFR(2),o[0],0,0,0), C1,0); \
    KRD(GL,3); GAPB(o[1]=__builtin_amdgcn_mfma_f32_32x32x16_bf16(PAF(2),VFR(6),o[1],0,0,0), C1,4); \
    GAPB(o[0]=__builtin_amdgcn_mfma_f32_32x32x16_bf16(PAF(3),VFR(3),o[0],0,0,0), C1,8); \
    GAPB(o[1]=__builtin_amdgcn_mfma_f32_32x32x16_bf16(PAF(3),VFR(7),o[1],0,0,0), C1,12); \
    }while(0)
  int t=1;
  for(;t+5<NT;t+=2){
    STEP(pB0,pB1,pA0,pA1,t,true,true,true);     WAIT_BAR(2); RESC(); ROT();
    STEP(pA0,pA1,pB0,pB1,t+1,true,true,true);   WAIT_BAR(2); RESC(); ROT();
  }
  #define ENDW(tt) do{ if((tt)+3<NT){WAIT_BAR(2);} else if((tt)+2<NT){WAIT_BAR(1);} else {WAIT_BAR(0);} }while(0)
  for(;t+1<NT;t+=2){
    STEP(pB0,pB1,pA0,pA1,t,(t+3<NT),(t+1<NT),(t+1<NT));       ENDW(t);   RESC(); ROT();
    STEP(pA0,pA1,pB0,pB1,t+1,(t+4<NT),(t+2<NT),(t+2<NT));     ENDW(t+1); RESC(); ROT();
  }
  STEP(pB0,pB1,pA0,pA1,NT-1,false,false,false); RESC();
  { float sacc=pB0[0]+pB0[1]; _Pragma("unroll") for(int r=2;r<16;++r)sacc+=pB0[r]; _Pragma("unroll") for(int r=0;r<16;++r)sacc+=pB1[r]; l_reg+=sacc;
    pw0=(u32x4){PKW(pB0,0),PKW(pB0,2),PKW(pB0,4),PKW(pB0,6)};pw1=(u32x4){PKW(pB0,8),PKW(pB0,10),PKW(pB0,12),PKW(pB0,14)};pw2=(u32x4){PKW(pB1,0),PKW(pB1,2),PKW(pB1,4),PKW(pB1,6)};pw3=(u32x4){PKW(pB1,8),PKW(pB1,10),PKW(pB1,12),PKW(pB1,14)};
    SBAR(); pv(o,vb0+sl_cur,PAF(0),PAF(1),PAF(2),PAF(3)); }
  #undef PKW
  #undef PAF
  #undef VFR
  #undef PIN
  #undef MX3
  #undef GAPA
  #undef GAPB
  #undef EX
  #undef VRD
  #undef KRD
  #undef STEP
  #undef ENDW
  {auto rr=__builtin_amdgcn_permlane32_swap(__float_as_uint(l_reg),__float_as_uint(l_reg),false,false);l_reg=__uint_as_float(rr[0])+__uint_as_float(rr[1]);}
  if(hi==0)wsf[32+r32]=l_reg;asm volatile("s_waitcnt lgkmcnt(0)":::"memory");
  float rli[16];
  #pragma unroll
  for(int r=0;r<16;++r)rli[r]=__builtin_amdgcn_rcpf(wsf[32+crow(r,hi)]);
  bf16*Ow=Ou+(long)(wid*QBLK)*QP;
  { bf16*stg=(bf16*)(shm+LDS_OST)+wid*2048;
    #pragma unroll
    for(int r=0;r<16;++r){const int orow=crow(r,hi);
      #pragma unroll
      for(int d0=0;d0<2;++d0)stg[orow*64+d0*32+r32]=__float2bfloat16(o[d0][r]*rli[r]);}
    asm volatile("s_waitcnt lgkmcnt(0)":::"memory");
    #pragma unroll
    for(int i=0;i<4;++i){const int row=i*8+(lane>>3),ch=lane&7; const u32x4 v=*(const u32x4*)(stg+row*64+ch*8); ATTN_STORE16(Ow+(long)row*QP+ch*8,v);} }
  asm volatile("s_waitcnt lgkmcnt(0)\n\ts_barrier":::"memory");
  #undef DMA_K
  #undef DMA_V
  #undef START
  #undef RESC
  #undef ROT
}
#undef SBAR
#undef WAIT_BAR
}

constexpr int NWAVES = 8;
constexpr int N_LAUNCHES = MK_N_LAUNCHES;
constexpr int N_PHASES = 17;

constexpr size_t MiB = 1u << 20;
constexpr size_t WS_CTL = 0, CTL_ZERO_BYTES = 1 * MiB;
constexpr size_t WS_MOD = 1 * MiB;
constexpr size_t WS_ROPE = 1 * MiB + 512 * 1024;
constexpr size_t WS_RBIAS = WS_ROPE + 16 * 1024;
constexpr size_t WS_DFTC = 1 * MiB + 768 * 1024;
constexpr size_t WS_RW = 2 * MiB;
constexpr size_t WS_WQKV = 6 * MiB, WS_WO = 9 * MiB, WS_WF = 11 * MiB;
constexpr size_t WS_LIST = 13 * MiB;
constexpr size_t WS_GATE = 17 * MiB;
constexpr size_t WS_W13 = 18 * MiB;
constexpr size_t WS_W2 = 146 * MiB;
constexpr size_t WS_ZT = 210 * MiB;
constexpr size_t WS_X3 = 210 * MiB;
constexpr size_t WS_YP = 342 * MiB;
constexpr size_t WS_XN = 274 * MiB;
constexpr size_t WS_XNC = 338 * MiB;
constexpr size_t WS_QO = 342 * MiB;
constexpr size_t WS_K = 406 * MiB, WS_V = 423 * MiB;
constexpr size_t WS_H1 = 342 * MiB;
constexpr size_t WS_Y = 440 * MiB;
constexpr size_t WS_END = 568 * MiB;
constexpr int CW_TMO = 0, CW_CODE = 1, CW_BAR = 4096, CW_CNT = 16384, CW_CTX = 16384 + 256;

constexpr int RING_OFF = 0, RING_BYTES = 131072;
constexpr int LDSCTL_OFF = RING_BYTES, MISC_OFF = LDSCTL_OFF + 320;
constexpr int TS_OFF = LDSCTL_OFF + 512;
constexpr int HIST_OFF = LDSCTL_OFF + 1024;
constexpr int GTAB_OFF = LDSCTL_OFF + 2048;
constexpr int LDS_BYTES = 147456;

#define GAS __attribute__((address_space(1)))
#define LAS __attribute__((address_space(3)))
typedef unsigned short bf16;
typedef unsigned v4u __attribute__((ext_vector_type(4)));
typedef unsigned v2u __attribute__((ext_vector_type(2)));
typedef float f32x4 __attribute__((ext_vector_type(4)));
typedef short bf16x8 __attribute__((ext_vector_type(8)));
typedef GAS unsigned gu32;
#define RLX_AGENT __ATOMIC_RELAXED, __HIP_MEMORY_SCOPE_AGENT
#define LDS_WAIT() asm volatile("s_waitcnt lgkmcnt(0)" ::: "memory")
#define VM_WAIT() asm volatile("s_waitcnt vmcnt(0)" ::: "memory")
__device__ __forceinline__ unsigned f2bf(float f) { unsigned u = __builtin_bit_cast(unsigned, f); return (u + 0x7fffu + ((u >> 16) & 1u)) >> 16; }
__device__ __forceinline__ unsigned pk2(float lo, float hi) { return f2bf(lo) | (f2bf(hi) << 16); }
__device__ __forceinline__ float bf2f(unsigned h) { return __builtin_bit_cast(float, h << 16); }

#define XB_TMO      128
#define XB_XCNT(j)  (256  + 64 * (j))
#define XB_XSUB(j)  (1280 + 64 * (j))
#define XB_XGEN(j)  (2304 + 64 * (j))
#define XB_TOP      3328
#define XB_TOPGEN   3392
#define XCD_BAR_WORDS 3456
#define XB_SPIN_CAP (1u << 18)
__device__ __forceinline__ unsigned xb_ld(unsigned* p)              { return __hip_atomic_load(p, __ATOMIC_RELAXED, __HIP_MEMORY_SCOPE_AGENT); }
__device__ __forceinline__ unsigned xb_add(unsigned* p, unsigned v) { return __hip_atomic_fetch_add(p, v, __ATOMIC_RELAXED, __HIP_MEMORY_SCOPE_AGENT); }
__device__ __forceinline__ unsigned xb_xcc_id() { return (unsigned)__builtin_amdgcn_s_getreg((3 << 11) | 20) & 0xFu; }
#define XB_SPIN(cond, bar) do { unsigned _sp = 0; while (cond) { __builtin_amdgcn_s_sleep(1); \
    if ((++_sp & 255u) == 0u) { if (xb_ld(&(bar)[XB_TMO])) break; if (_sp > XB_SPIN_CAP) { atomicAdd(&(bar)[XB_TMO], 1u); break; } } } } while (0)
struct XcdBarrier { unsigned* bar; unsigned x; volatile LAS unsigned* st; };
__device__ __forceinline__ XcdBarrier xcd_barrier_post(unsigned* bar, volatile LAS unsigned* st) {
    XcdBarrier b; b.bar = bar; b.x = xb_xcc_id(); b.st = st;
    if (threadIdx.x == 0) (void)xb_add(&bar[XB_XCNT(b.x)], 1u);
    return b;
}
__device__ __forceinline__ void xcd_barrier_complete(unsigned* bar, unsigned x, unsigned& nloc, unsigned& nx) {
    const unsigned G = gridDim.x * gridDim.y * gridDim.z;
    unsigned sum, cnt, mine, sp = 0u;
    for (;;) {
        sum = 0u; cnt = 0u; mine = 0u;
#pragma unroll
        for (unsigned j = 0; j < 16; ++j) { const unsigned c = xb_ld(&bar[XB_XCNT(j)]); sum += c; cnt += (c > 0u) ? 1u : 0u; mine = (j == x) ? c : mine; }
        if (sum == G) break;
        __builtin_amdgcn_s_sleep(1);
        if ((++sp & 255u) == 0u) { if (xb_ld(&bar[XB_TMO])) break; if (sp > XB_SPIN_CAP) { atomicAdd(&bar[XB_TMO], 1u); break; } }
    }
    nloc = mine > 0u ? mine : 1u; nx = cnt > 0u ? cnt : 1u;
}
__device__ __forceinline__ void xcd_barrier(const XcdBarrier& b) {
    asm volatile("s_waitcnt vmcnt(0)" ::: "memory");
    __syncthreads();
    if (threadIdx.x == 0) {
        unsigned* bar = b.bar;
        __builtin_amdgcn_s_waitcnt(0);
        unsigned nloc = b.st[0], nx = b.st[1];
        if (nloc == 0u) { xcd_barrier_complete(bar, b.x, nloc, nx); b.st[0] = nloc; b.st[1] = nx; }
        const unsigned old = xb_add(&bar[XB_XSUB(b.x)], 1u);
        const unsigned gen = old / nloc;
        if (old + 1u == (gen + 1u) * nloc) {
            __builtin_amdgcn_fence(__ATOMIC_RELEASE, "agent");
            asm volatile("s_waitcnt vmcnt(0)" ::: "memory");
            const unsigned og = xb_add(&bar[XB_TOP], 1u);
            const unsigned tg = og / nx;
            if (og + 1u == (tg + 1u) * nx) xb_add(&bar[XB_TOPGEN], 1u);
            else XB_SPIN(xb_ld(&bar[XB_TOPGEN]) == tg, bar);
            __builtin_amdgcn_fence(__ATOMIC_ACQUIRE, "agent");
            xb_add(&bar[XB_XGEN(b.x)], 1u);
            asm volatile("s_waitcnt vmcnt(0)" ::: "memory");
        } else {
            XB_SPIN(xb_ld(&bar[XB_XGEN(b.x)]) == gen, bar);
            __builtin_amdgcn_fence(__ATOMIC_ACQUIRE, "agent");
            asm volatile("s_waitcnt vmcnt(0)" ::: "memory");
        }
    }
    __syncthreads();
}

struct Args { const float* in[21]; float* out; unsigned char* ws; int ph_lo, ph_hi; };
struct Frame {
    LAS unsigned char* lds;
    volatile LAS unsigned* MISC;
    gu32* ctl;
    int tid, lane, wave;
    int vcu, G;
    unsigned char* ws;
    float* out;
};
enum { I_X = 0, I_C, I_CTX, I_CCTX, I_WMOD, I_BMOD, I_NMIX, I_NFFN, I_WQKV, I_QN, I_KN, I_WO, I_WF, I_WRG, I_BRG, I_WRE, I_BRE, I_W1, I_W3, I_W2, I_FN };

__device__ __forceinline__ float wave_sum(float v) {
#pragma unroll
    for (int o = 1; o < 64; o <<= 1) v += __shfl_xor(v, o);
    return v;
}

__device__ __forceinline__ void p0_transpose_item(const float* W, int N, bf16* WT, int ldk, int row_off, LAS float* scr, int kb, int nb, int lane) {
    const int k0 = 64 * kb, n0 = 32 * nb;
    f32x4 v[8];
#pragma unroll
    for (int i = 0; i < 8; ++i) v[i] = *(const GAS f32x4*)(W + (size_t)(k0 + (lane >> 3) + 8 * i) * N + n0 + 4 * (lane & 7));
#pragma unroll
    for (int i = 0; i < 8; ++i) { LAS float* d = scr + ((lane >> 3) + 8 * i) * 33 + 4 * (lane & 7); d[0] = v[i].x; d[1] = v[i].y; d[2] = v[i].z; d[3] = v[i].w; }
    LDS_WAIT(); asm volatile("" ::: "memory");
    const int c = lane & 7;
#pragma unroll
    for (int j = 0; j < 4; ++j) { const int n = (lane >> 3) + 8 * j; const LAS float* s = scr + (8 * c) * 33 + n;
        v4u o; o.x = pk2(s[0 * 33], s[1 * 33]); o.y = pk2(s[2 * 33], s[3 * 33]); o.z = pk2(s[4 * 33], s[5 * 33]); o.w = pk2(s[6 * 33], s[7 * 33]);
        *(GAS v4u*)(WT + (size_t)(row_off + n0 + n) * ldk + k0 + 8 * c) = o; }
    LDS_WAIT(); asm volatile("" ::: "memory");
}

__device__ __forceinline__ void p0_prologue(const Args& A, Frame& F) {
    LAS float* L = (LAS float*)(F.lds);
    if (F.vcu < 192) {
        const int l = F.vcu / 96, cg = F.vcu % 96;
        LAS float* sc = L;
        LAS float* part = L + 10240;
        for (int i = F.tid; i < 9 * 1024; i += NWAVES * 64) { const int r = i >> 10, k = i & 1023; const float c = (r < 8) ? A.in[I_C][r * 1024 + k] : A.in[I_CCTX][k]; sc[i] = c / (1.f + __expf(-c)); }
        __syncthreads();
        float acc[9];
#pragma unroll
        for (int r = 0; r < 9; ++r) acc[r] = 0.f;
        const float* wp = A.in[I_WMOD] + (size_t)l * 1024 * 6144 + cg * 64 + F.lane;
        const int kb = F.wave * 128;
#pragma unroll 4
        for (int k = 0; k < 128; ++k) { const float w = wp[(size_t)(kb + k) * 6144];
#pragma unroll
            for (int r = 0; r < 9; ++r) acc[r] += sc[r * 1024 + kb + k] * w; }
#pragma unroll
        for (int r = 0; r < 9; ++r) part[(F.wave * 9 + r) * 64 + F.lane] = acc[r];
        __syncthreads();
        for (int i = F.tid; i < 9 * 64; i += NWAVES * 64) { const int r = i >> 6, c = i & 63; float s = 0.f;
#pragma unroll
            for (int w = 0; w < 8; ++w) s += part[(w * 9 + r) * 64 + c];
            ((float*)(F.ws + WS_MOD))[(l * 9 + r) * 6144 + cg * 64 + c] = s + A.in[I_BMOD][l * 6144 + cg * 64 + c]; }
        __syncthreads();
    }
    LAS float* tab = L + 16384;
    for (int i = F.tid; i < 4096; i += NWAVES * 64) tab[i] = cospif((float)i * (1.0f / 2048.0f));
    __syncthreads();
    const int gw = F.vcu * NWAVES + F.wave, NGW = F.G * NWAVES;
    {
      bf16* DC = (bf16*)(F.ws + WS_DFTC);
      for (int m = gw; m < 256; m += NGW) { const int c0 = 8 * F.lane; float v[8];
#pragma unroll
          for (int i = 0; i < 8; ++i) { const int c = c0 + i; const int cc = c & 255; const int idx = (m * cc * 16) & 4095; v[i] = (c < 256) ? tab[idx] * (1.0f / 16.0f) : -tab[(idx - 1024) & 4095] * (1.0f / 16.0f); }
          v4u o; o.x = pk2(v[0], v[1]); o.y = pk2(v[2], v[3]); o.z = pk2(v[4], v[5]); o.w = pk2(v[6], v[7]);
          *(GAS v4u*)(DC + (size_t)m * 512 + c0) = o; }
      if (F.vcu == F.G - 1) { float* R = (float*)(F.ws + WS_ROPE);
          for (int i = F.tid; i < 1024; i += NWAVES * 64) { const int pos = i >> 4, j = i & 15; const float inv = powf(10000.0f, -(float)j / 16.0f); const float ang = (float)pos * inv; R[i] = cosf(ang); R[1024 + i] = sinf(ang); } }
    }
    __syncthreads();
    LAS float* scr = (LAS float*)(F.lds + F.wave * 16384);
    constexpr int I_QKV = 16 * 48, I_SQ = 16 * 32, I_MOE = 768 * 64;
    constexpr int NITEMS = I_QKV + 2 * I_SQ + I_MOE;
    for (int it = gw; it < NITEMS; it += NGW) {
        int r = it;
        if (r < I_QKV) { p0_transpose_item(A.in[I_WQKV], QKVN, (bf16*)(F.ws + WS_WQKV), 1024, 0, scr, r / 48, r % 48, F.lane); continue; } r -= I_QKV;
        if (r < I_SQ) { p0_transpose_item(A.in[I_WO], 1024, (bf16*)(F.ws + WS_WO), 1024, 0, scr, r / 32, r % 32, F.lane); continue; } r -= I_SQ;
        if (r < I_SQ) { p0_transpose_item(A.in[I_WF], 1024, (bf16*)(F.ws + WS_WF), 1024, 0, scr, r / 32, r % 32, F.lane); continue; } r -= I_SQ;
        const int le = r / 768, q = r % 768;
        if (q < 256) p0_transpose_item(A.in[I_W1] + (size_t)le * 1024 * 512, 512, (bf16*)(F.ws + WS_W13) + (size_t)le * 1024 * 1024, 1024, 0, scr, q / 16, q % 16, F.lane);
        else if (q < 512) p0_transpose_item(A.in[I_W3] + (size_t)le * 1024 * 512, 512, (bf16*)(F.ws + WS_W13) + (size_t)le * 1024 * 1024, 1024, 512, scr, (q - 256) / 16, (q - 256) % 16, F.lane);
        else p0_transpose_item(A.in[I_W2] + (size_t)le * 512 * 1024, 1024, (bf16*)(F.ws + WS_W2) + (size_t)le * 1024 * 512, 512, 0, scr, (q - 512) / 32, (q - 512) % 32, F.lane);
    }
}

struct RowVec { f32x4 v[4]; };
__device__ __forceinline__ RowVec ld_row(const float* p, int lane) { RowVec r; const GAS f32x4* q = (const GAS f32x4*)p + lane;
#pragma unroll
    for (int j = 0; j < 4; ++j) r.v[j] = q[64 * j]; return r; }
__device__ __forceinline__ void st_row(float* p, int lane, const RowVec& r) { GAS f32x4* q = (GAS f32x4*)p + lane;
#pragma unroll
    for (int j = 0; j < 4; ++j) q[64 * j] = r.v[j]; }
__device__ __forceinline__ RowVec ld_row_bf16(const bf16* p, int lane) { RowVec r; const GAS v2u* q = (const GAS v2u*)p + lane;
#pragma unroll
    for (int j = 0; j < 4; ++j) { const v2u w = q[64 * j]; r.v[j] = (f32x4){bf2f(w.x & 0xffffu), bf2f(w.x >> 16), bf2f(w.y & 0xffffu), bf2f(w.y >> 16)}; } return r; }
__device__ __forceinline__ void st_row_bf16(bf16* p, int lane, const RowVec& r) { GAS v2u* q = (GAS v2u*)p + lane;
#pragma unroll
    for (int j = 0; j < 4; ++j) { v2u w; w.x = pk2(r.v[j].x, r.v[j].y); w.y = pk2(r.v[j].z, r.v[j].w); q[64 * j] = w; } }
__device__ __forceinline__ float row_ss(const RowVec& r) { float s = 0.f;
#pragma unroll
    for (int j = 0; j < 4; ++j) s += (r.v[j].x * r.v[j].x + r.v[j].y * r.v[j].y) + (r.v[j].z * r.v[j].z + r.v[j].w * r.v[j].w);
    return wave_sum(s); }
__device__ __forceinline__ void ld_mod(const float* gain, const float* scale, const float* shift, int lane, RowVec& gm, RowVec& sh) {
    const RowVec g = ld_row(gain, lane), s = ld_row(scale, lane); sh = ld_row(shift, lane);
#pragma unroll
    for (int j = 0; j < 4; ++j) gm.v[j] = g.v[j] * (s.v[j] + 1.0f);
}
__device__ __forceinline__ bf16* xres(Frame& F, int which) { return which == 1 ? (bf16*)((unsigned char*)F.out + 64 * MiB) : which == 2 ? (bf16*)F.out : (bf16*)(F.ws + WS_X3); }
__device__ __forceinline__ const float* modp(Frame& F, int l, int r, int chunk) { return (const float*)(F.ws + WS_MOD) + (size_t)(l * 9 + r) * 6144 + chunk * 1024; }

__device__ __forceinline__ void p1_phase(const Args& A, Frame& F) {
    const int gw = F.vcu * NWAVES + F.wave, NGW = F.G * NWAVES;
    const int NLB = F.G - 16;
    { const int row = 8 * F.vcu + F.wave; RowVec gm, sh; ld_mod(A.in[I_NMIX], modp(F, 0, 8, 1), modp(F, 0, 8, 0), F.lane, gm, sh);
      RowVec x = ld_row(A.in[I_CTX] + (size_t)row * DM, F.lane); const float rstd = rsqrtf(row_ss(x) * (1.0f / DM) + EPS);
#pragma unroll
      for (int j = 0; j < 4; ++j) x.v[j] = x.v[j] * rstd * gm.v[j] + sh.v[j];
      st_row_bf16((bf16*)(F.ws + WS_XNC) + (size_t)row * DM, F.lane, x);
      VM_WAIT(); __syncthreads();
      if (F.tid == 0) { __builtin_amdgcn_fence(__ATOMIC_RELEASE, "agent"); VM_WAIT(); __hip_atomic_fetch_add((unsigned*)(F.ctl + CW_CTX) + 64 * (F.vcu >> 5), 1u, RLX_AGENT); } }
    if (F.vcu < NLB) for (int it = gw; it < NT_TOK / 16; it += NLB * NWAVES) { const int t0 = it * 16, b = t0 / SEQ; RowVec gm, sh; ld_mod(A.in[I_NMIX], modp(F, 0, b, 1), modp(F, 0, b, 0), F.lane, gm, sh);
        for (int r = 0; r < 16; ++r) { RowVec x = ld_row(A.in[I_X] + (size_t)(t0 + r) * DM, F.lane); const float rstd = rsqrtf(row_ss(x) * (1.0f / DM) + EPS);
#pragma unroll
            for (int j = 0; j < 4; ++j) x.v[j] = x.v[j] * rstd * gm.v[j] + sh.v[j];
            st_row_bf16((bf16*)(F.ws + WS_XN) + (size_t)(t0 + r) * DM, F.lane, x); } }
    for (int it = gw; it < 2 * 8 * 48; it += NGW) { const int l = it / 384, b = (it / 48) % 8, c = it % 48;
        bf16* hi = (bf16*)(F.ws + WS_RW) + ((size_t)((l * 8 + b) * 2 + 0) * 48 + c) * 1024; bf16* lo = hi + 48 * 1024;
        const float* gain = A.in[I_NFFN] + l * 1024; const float* sc2 = modp(F, l, b, 4); const float* sh2 = modp(F, l, b, 3);
        float bs = 0.f;
        for (int j = 0; j < 16; ++j) { const int k = F.lane + 64 * j; float w = 0.f;
            if (c < 4) w = A.in[I_WRG][(size_t)l * 1024 * 4 + k * 4 + c]; else if (c < 36) w = A.in[I_WRE][(size_t)l * 1024 * 32 + k * 32 + (c - 4)];
            const float wp = gain[k] * (1.0f + sc2[k]) * w; const unsigned h = f2bf(wp); hi[k] = (bf16)h; lo[k] = (bf16)f2bf(wp - bf2f(h)); bs += sh2[k] * w; }
        bs = wave_sum(bs);
        if (F.lane == 0) { float br = 0.f; if (c < 4) br = A.in[I_BRG][l * 4 + c]; else if (c < 36) br = A.in[I_BRE][l * 32 + (c - 4)]; ((float*)(F.ws + WS_RBIAS))[(l * 8 + b) * 48 + c] = bs + br; } }
}


using pg8::Unit; using pg8::perm32;
template <bool PERM> struct ProbStd {
    static constexpr bool GATHER = false; static constexpr int tab_off = 0;
    int nt; const char* A; const char* B; int lda2, ldb2;
    __device__ __forceinline__ const char* a_unit(const Unit& u) const { return A + (size_t)u.pm * 256 * lda2; }
    __device__ __forceinline__ size_t a_hstep() const { return (size_t)128 * lda2; }
    __device__ __forceinline__ size_t a_kt(int t) const { return (size_t)t * 128; }
    __device__ __forceinline__ unsigned a_voff(int R, int C) const { return (unsigned)(R * lda2 + C * 2); }
    __device__ __forceinline__ const char* b_unit(const Unit& u) const { return B + (size_t)u.pn * 256 * ldb2; }
    __device__ __forceinline__ size_t b_hstep() const { return (size_t)128 * ldb2; }
    __device__ __forceinline__ size_t b_kt(int t) const { return (size_t)t * 128; }
    __device__ __forceinline__ unsigned b_voff(int R, int C) const { const int Rb = PERM ? ((R & ~31) + perm32(R & 31)) : R; return (unsigned)(Rb * ldb2 + C * 2); }
};
struct ProbQKV {
    static constexpr bool GATHER = false; static constexpr int tab_off = 0;
    int nt; const char* XN; const char* XNC; const char* W;
    __device__ __forceinline__ const char* a_unit(const Unit& u) const { return XN + (size_t)u.e * (size_t)(WS_XNC - WS_XN) + (size_t)u.pm * 256 * 2048; }
    __device__ __forceinline__ size_t a_hstep() const { return (size_t)128 * 2048; }
    __device__ __forceinline__ size_t a_kt(int t) const { return (size_t)t * 128; }
    __device__ __forceinline__ unsigned a_voff(int R, int C) const { return (unsigned)(R * 2048 + C * 2); }
    __device__ __forceinline__ const char* b_unit(const Unit& u) const { return W + (size_t)u.pn * 256 * 2048; }
    __device__ __forceinline__ size_t b_hstep() const { return (size_t)32 * 2048; }
    __device__ __forceinline__ size_t b_kt(int t) const { return (size_t)t * 128; }
    __device__ __forceinline__ unsigned b_voff(int R, int C) const { return (unsigned)((64 * (R >> 5) + (R & 31)) * 2048 + C * 2); }
};
struct ProbUp {
    static constexpr bool GATHER = true; static constexpr int tab_off = GTAB_OFF;
    int nt; const char* XN; const char* W;
    __device__ __forceinline__ const char* a_unit(const Unit&) const { return XN; }
    __device__ __forceinline__ size_t a_hstep() const { return 0; }
    __device__ __forceinline__ size_t a_kt(int t) const { return (size_t)t * 128; }
    __device__ __forceinline__ unsigned a_voff(int, int) const { return 0u; }
    __device__ __forceinline__ const char* b_unit(const Unit& u) const { return W + ((size_t)u.e * 1024 + 128 * u.pn) * 2048; }
    __device__ __forceinline__ size_t b_hstep() const { return (size_t)512 * 2048; }
    __device__ __forceinline__ size_t b_kt(int t) const { return (size_t)t * 128; }
    __device__ __forceinline__ unsigned b_voff(int R, int C) const { const int Rb = (R & ~31) + perm32(R & 31); return (unsigned)(Rb * 2048 + C * 2); }
};
struct ProbDown {
    static constexpr bool GATHER = false; static constexpr int tab_off = 0;
    int nt; const char* H1; const char* W;
    __device__ __forceinline__ const char* a_unit(const Unit& u) const { return H1 + (size_t)u.rb * 1024; }
    __device__ __forceinline__ size_t a_hstep() const { return (size_t)128 * 1024; }
    __device__ __forceinline__ size_t a_kt(int t) const { return (size_t)t * 128; }
    __device__ __forceinline__ unsigned a_voff(int R, int C) const { return (unsigned)(R * 1024 + C * 2); }
    __device__ __forceinline__ const char* b_unit(const Unit& u) const { return W + ((size_t)u.e * 1024 + 256 * u.pn) * 1024; }
    __device__ __forceinline__ size_t b_hstep() const { return (size_t)128 * 1024; }
    __device__ __forceinline__ size_t b_kt(int t) const { return (size_t)t * 128; }
    __device__ __forceinline__ unsigned b_voff(int R, int C) const { const int Rb = (R & ~31) + perm32(R & 31); return (unsigned)(Rb * 1024 + C * 2); }
};
struct ProbC {
    static constexpr bool GATHER = false; static constexpr int tab_off = 0;
    int nt; const char* ZT; const char* DC;
    __device__ __forceinline__ const char* a_unit(const Unit& u) const { return ZT + (((size_t)(u.pm >> 4) * 8192 + (u.pm & 15) * 256) * 1024 + 256 * u.pn) * 2; }
    __device__ __forceinline__ size_t a_hstep() const { return (size_t)128 * 2048; }
    __device__ __forceinline__ size_t a_kt(int t) const { return (size_t)(t & 3) * 128 + (size_t)(t >> 2) * ((size_t)4096 * 2048); }
    __device__ __forceinline__ unsigned a_voff(int R, int C) const { return (unsigned)(R * 2048 + C * 2); }
    __device__ __forceinline__ const char* b_unit(const Unit&) const { return DC; }
    __device__ __forceinline__ size_t b_hstep() const { return (size_t)128 * 1024; }
    __device__ __forceinline__ size_t b_kt(int t) const { return (size_t)t * 128; }
    __device__ __forceinline__ unsigned b_voff(int R, int C) const { const int Rb = (R & ~31) + perm32(R & 31); return (unsigned)(Rb * 1024 + C * 2); }
};

struct SchedOne {
    Unit u0;
    __device__ __forceinline__ bool next(int i, Unit& u) const { if (i != 0) return false; u = u0; return true; }
};
struct GroupedOrder {
    const LAS int* ts; int G, c, layer;
    __device__ __forceinline__ bool next(int i, Unit& u) const {
        const int nrt = ts[32], nwg = nrt * 4; const int L = i * G + c; if (L >= nwg) return false;
        const int wgid = pg8::xcd_remap(L, nwg); const int rt = wgid >> 2;
        int e = 0;
#pragma unroll 1
        for (int j = 1; j < 32; ++j) if (ts[j] <= rt) e = j;
        e = __builtin_amdgcn_readfirstlane(e);
        u.pm = __builtin_amdgcn_readfirstlane(rt); u.pn = __builtin_amdgcn_readfirstlane(wgid & 3); u.e = layer * 32 + e;
        u.r0 = __builtin_amdgcn_readfirstlane((rt - ts[e]) * 256); u.cnt = __builtin_amdgcn_readfirstlane(ts[33 + e]); u.rb = u.pm * 256; u.ui = i; return true;
    }
};

typedef pg8::f32x4 (AccT)[2][2][4][2];
struct EpiQKV {
    bf16* Q; bf16* K; bf16* V; const float* qn; const float* kn; const LAS float* rope;
    __device__ __forceinline__ void operator()(const AccT& acc, const Unit& u, int wr, int wc, int fr, int fq) const {
        const int pn = u.pn; const bool ctx = u.e != 0;
        f32x4 gv[2][2];
        if (pn != 5) { const float* g = (pn == 4) ? kn : qn;
#pragma unroll
            for (int bj = 0; bj < 2; ++bj)
#pragma unroll
                for (int n = 0; n < 2; ++n) gv[bj][n] = *(const f32x4*)(g + 32 * bj + 16 * n + 4 * fq); }
#pragma unroll
        for (int ai = 0; ai < 2; ++ai)
#pragma unroll
            for (int m = 0; m < 4; ++m) {
                const int row = 128 * ai + 64 * wr + 16 * m + fr; const int tok = u.pm * 256 + row; const int pos = tok & (SEQ - 1);
                const size_t krow = ctx ? ((size_t)u.pm * LK + SEQ + row) : ((size_t)(tok >> 12) * LK + pos);
                f32x4 y[2][2];
#pragma unroll
                for (int bj = 0; bj < 2; ++bj)
#pragma unroll
                    for (int n = 0; n < 2; ++n) y[bj][n] = acc[ai][bj][m][n];
                if (pn != 5) {
                    float ss = 0.f;
#pragma unroll
                    for (int bj = 0; bj < 2; ++bj)
#pragma unroll
                        for (int n = 0; n < 2; ++n) ss += (y[bj][n].x * y[bj][n].x + y[bj][n].y * y[bj][n].y) + (y[bj][n].z * y[bj][n].z + y[bj][n].w * y[bj][n].w);
                    ss += __shfl_xor(ss, 16); ss += __shfl_xor(ss, 32);
                    const float rstd = rsqrtf(ss * (1.0f / 64.0f) + EPS);
#pragma unroll
                    for (int bj = 0; bj < 2; ++bj)
#pragma unroll
                        for (int n = 0; n < 2; ++n) y[bj][n] = y[bj][n] * rstd * gv[bj][n];
                    if (!ctx) {
                        const int pr[2] = {pos >> 6, pos & 63};
#pragma unroll
                        for (int bj = 0; bj < 2; ++bj) { const f32x4 cs = *(const LAS f32x4*)(rope + pr[bj] * 16 + 4 * fq), sn = *(const LAS f32x4*)(rope + 1024 + pr[bj] * 16 + 4 * fq);
                            const f32x4 a = y[bj][0], b2 = y[bj][1]; y[bj][0] = a * cs - b2 * sn; y[bj][1] = b2 * cs + a * sn; }
                    }
                }
                bf16* dst;
                if (pn < 4) { dst = Q + (size_t)tok * 1024 + (4 * pn + wc) * 64;
#pragma unroll
                    for (int bj = 0; bj < 2; ++bj)
#pragma unroll
                        for (int n = 0; n < 2; ++n) y[bj][n] = y[bj][n] * attn_body::C2; }
                else dst = ((pn == 4) ? K : V) + krow * KVP + wc * 64;
#pragma unroll
                for (int bj = 0; bj < 2; ++bj)
#pragma unroll
                    for (int n = 0; n < 2; ++n) { v2u w; w.x = pg8::cvt_pk_bf16(y[bj][n].x, y[bj][n].y); w.y = pg8::cvt_pk_bf16(y[bj][n].z, y[bj][n].w); *(v2u*)(dst + 32 * bj + 16 * n + 4 * fq) = w; }
                asm volatile("" ::: "memory");
            }
    }
};
__device__ __forceinline__ v4u pack8(const f32x4& a, const f32x4& b) { v4u w; w.x = pg8::cvt_pk_bf16(a.x, a.y); w.y = pg8::cvt_pk_bf16(a.z, a.w); w.z = pg8::cvt_pk_bf16(b.x, b.y); w.w = pg8::cvt_pk_bf16(b.z, b.w); return w; }
template <bool BASE_F32> struct EpiResid {
    const void* base; bf16* out; const float* gate;
    __device__ __forceinline__ void operator()(const AccT& acc, const Unit& u, int wr, int wc, int fr, int fq) const {
        const int b = (u.pm * 256) >> 12; const int col0 = u.pn * 256 + wc * 32 + 8 * fq; const float* g = gate + b * 6144 + col0;
        f32x4 gv[2][2];
#pragma unroll
        for (int bj = 0; bj < 2; ++bj)
#pragma unroll
            for (int n = 0; n < 2; ++n) gv[bj][n] = *(const f32x4*)(g + bj * 128 + n * 4);
#pragma unroll
        for (int ai = 0; ai < 2; ++ai)
#pragma unroll
            for (int m = 0; m < 4; ++m) { const size_t off = (size_t)(u.pm * 256 + ai * 128 + wr * 64 + m * 16 + fr) * 1024 + col0;
#pragma unroll
                for (int bj = 0; bj < 2; ++bj) { f32x4 b0, b1;
                    if constexpr (BASE_F32) { b0 = *(const f32x4*)((const float*)base + off + bj * 128); b1 = *(const f32x4*)((const float*)base + off + bj * 128 + 4); }
                    else { const v4u w = *(const v4u*)((const bf16*)base + off + bj * 128); b0 = (f32x4){bf2f(w.x & 0xffffu), bf2f(w.x >> 16), bf2f(w.y & 0xffffu), bf2f(w.y >> 16)}; b1 = (f32x4){bf2f(w.z & 0xffffu), bf2f(w.z >> 16), bf2f(w.w & 0xffffu), bf2f(w.w >> 16)}; }
                    *(v4u*)(out + off + bj * 128) = pack8(b0 + gv[bj][0] * acc[ai][bj][m][0], b1 + gv[bj][1] * acc[ai][bj][m][1]); } }
    }
};
struct EpiUp {
    bf16* H1;
    __device__ __forceinline__ void operator()(const AccT& acc, const Unit& u, int wr, int wc, int fr, int fq) const {
#pragma unroll
        for (int ai = 0; ai < 2; ++ai)
#pragma unroll
            for (int m = 0; m < 4; ++m) { f32x4 h[2];
#pragma unroll
                for (int n = 0; n < 2; ++n) { const f32x4 a = acc[ai][0][m][n], b = acc[ai][1][m][n];
#pragma unroll
                    for (int i = 0; i < 4; ++i) h[n][i] = a[i] * __builtin_amdgcn_rcpf(1.0f + __builtin_amdgcn_exp2f(-1.4426950408889634f * a[i])) * b[i]; }
                *(v4u*)(H1 + (size_t)(u.rb + 128 * ai + 64 * wr + 16 * m + fr) * 512 + 128 * u.pn + 32 * wc + 8 * fq) = pack8(h[0], h[1]); }
    }
};
struct EpiDown {
    bf16* Y; const int* list; const float* gate;
    __device__ __forceinline__ void operator()(const AccT& acc, const Unit& u, int wr, int wc, int fr, int fq) const {
        const int* le = list + (size_t)(u.e & 31) * NT_TOK;
        int a[8]; float g[8];
#pragma unroll
        for (int q = 0; q < 8; ++q) { const int ridx = u.r0 + 128 * (q >> 2) + 64 * wr + 16 * (q & 3) + fr; a[q] = le[ridx < u.cnt ? ridx : 0]; if (ridx >= u.cnt) a[q] = -1; }
#pragma unroll
        for (int q = 0; q < 8; ++q) g[q] = gate[a[q] < 0 ? 0 : a[q]];
#pragma unroll
        for (int q = 0; q < 8; ++q) if (a[q] >= 0) { bf16* dst = Y + (size_t)a[q] * 1024 + 256 * u.pn + 32 * wc + 8 * fq;
#pragma unroll
            for (int bj = 0; bj < 2; ++bj) *(v4u*)(dst + 128 * bj) = pack8(acc[q >> 2][bj][q & 3][0] * g[q], acc[q >> 2][bj][q & 3][1] * g[q]); }
    }
};
struct EpiS {
    bf16* ZT;
    __device__ __forceinline__ void operator()(const AccT& acc, const Unit& u, int wr, int wc, int fr, int fq) const {
#pragma unroll
        for (int ai = 0; ai < 2; ++ai)
#pragma unroll
            for (int m = 0; m < 4; ++m) { const int kp = u.pm * 256 + 128 * ai + 64 * wr + 16 * m + fr;
#pragma unroll
                for (int bj = 0; bj < 2; ++bj) { const int col = u.pn * 256 + 128 * bj + 32 * wc + 8 * fq; const int b = col >> 10, c = col & 1023;
                    *(v4u*)(ZT + ((size_t)b * 8192 + kp) * 1024 + c) = pack8(acc[ai][bj][m][0], acc[ai][bj][m][1]); } }
    }
};
struct EpiC {
    bf16* Fm;
    __device__ __forceinline__ void operator()(const AccT& acc, const Unit& u, int wr, int wc, int fr, int fq) const {
#pragma unroll
        for (int ai = 0; ai < 2; ++ai)
#pragma unroll
            for (int m = 0; m < 4; ++m) { bf16* dst = Fm + (size_t)(u.pm * 256 + 128 * ai + 64 * wr + 16 * m + fr) * 1024 + u.pn * 256 + 32 * wc + 8 * fq;
#pragma unroll
                for (int bj = 0; bj < 2; ++bj) *(v4u*)(dst + 128 * bj) = pack8(acc[ai][bj][m][0], acc[ai][bj][m][1]); }
    }
};

__device__ __forceinline__ void moe_in_phase(const Args& A, Frame& F, int l) {
    const bf16* X = xres(F, l == 0 ? 1 : 3);
    LAS unsigned* hist = (LAS unsigned*)(F.lds + HIST_OFF); LAS unsigned* hbase = hist + 32;
    unsigned* cnt = (unsigned*)(F.ctl + CW_CNT) + l * 32;
    int* list = (int*)(F.ws + WS_LIST); float* gate = (float*)(F.ws + WS_GATE);
    for (int blk = F.vcu; blk < NT_TOK / 128; blk += F.G) {
        const int tokb = blk * 128, tok0 = tokb + F.wave * 16, b = tokb / SEQ;
        if (F.tid < 32) hist[F.tid] = 0u;
        __syncthreads();
        const int ti = F.lane & 15, kq = F.lane >> 4;
        const bf16* xr = X + (size_t)(tok0 + ti) * DM + 8 * kq;
        const bf16* wh = (const bf16*)(F.ws + WS_RW) + (size_t)((l * 8 + b) * 2) * 48 * 1024 + (size_t)ti * 1024 + 8 * kq;
        const bf16* wl = wh + 48 * 1024;
        f32x4 acc[3]; acc[0] = (f32x4){0.f, 0.f, 0.f, 0.f}; acc[1] = acc[0]; acc[2] = acc[0];
        float ss = 0.f;
#pragma unroll 2
        for (int s = 0; s < 32; ++s) {
            const v4u h = *(const GAS v4u*)(xr + 32 * s);
            { const float a0 = bf2f(h.x & 0xffffu), a1 = bf2f(h.x >> 16), a2 = bf2f(h.y & 0xffffu), a3 = bf2f(h.y >> 16), a4 = bf2f(h.z & 0xffffu), a5 = bf2f(h.z >> 16), a6 = bf2f(h.w & 0xffffu), a7 = bf2f(h.w >> 16);
              ss += (a0 * a0 + a1 * a1) + (a2 * a2 + a3 * a3) + (a4 * a4 + a5 * a5) + (a6 * a6 + a7 * a7); }
            const bf16x8 ah = __builtin_bit_cast(bf16x8, h);
#pragma unroll
            for (int cb = 0; cb < 3; ++cb) { const bf16x8 bh = *(const GAS bf16x8*)(wh + cb * 16 * 1024 + 32 * s), bl = *(const GAS bf16x8*)(wl + cb * 16 * 1024 + 32 * s);
                acc[cb] = __builtin_amdgcn_mfma_f32_16x16x32_bf16(ah, bh, acc[cb], 0, 0, 0);
                acc[cb] = __builtin_amdgcn_mfma_f32_16x16x32_bf16(ah, bl, acc[cb], 0, 0, 0); }
        }
        ss += __shfl_xor(ss, 16); ss += __shfl_xor(ss, 32);
        LAS float* scr = (LAS float*)(F.lds + F.wave * 16384);
#pragma unroll
        for (int cb = 0; cb < 3; ++cb)
#pragma unroll
            for (int r = 0; r < 4; ++r) scr[(4 * kq + r) * 49 + 16 * cb + ti] = acc[cb][r];
        if (kq == 0) scr[16 * 49 + ti] = rsqrtf(ss * (1.0f / DM) + EPS);
        LDS_WAIT(); asm volatile("" ::: "memory");
        int e0 = 0, e1 = 0; unsigned rk0 = 0, rk1 = 0; float w0 = 0.f, w1 = 0.f;
        if (F.lane < 16) {
            const float rstd = scr[16 * 49 + F.lane]; const float* bias = (const float*)(F.ws + WS_RBIAS) + (l * 8 + b) * 48; const LAS float* raw = scr + F.lane * 49;
            float lg[4];
#pragma unroll
            for (int g = 0; g < 4; ++g) lg[g] = rstd * raw[g] + bias[g];
            int gs = 0; float mx = lg[0];
#pragma unroll
            for (int g = 1; g < 4; ++g) if (lg[g] > mx) { mx = lg[g]; gs = g; }
            float den = 0.f;
#pragma unroll
            for (int g = 0; g < 4; ++g) den += __expf(lg[g] - mx);
            const float pgrp = 1.0f / den;
            float le[8];
#pragma unroll
            for (int j = 0; j < 8; ++j) le[j] = rstd * raw[4 + gs * 8 + j] + bias[4 + gs * 8 + j];
            int i0 = 0; float m0 = le[0];
#pragma unroll
            for (int j = 1; j < 8; ++j) if (le[j] > m0) { m0 = le[j]; i0 = j; }
            int i1 = -1; float m1 = -INFINITY;
#pragma unroll
            for (int j = 0; j < 8; ++j) if (j != i0 && le[j] > m1) { m1 = le[j]; i1 = j; }
            const float d = __expf(m1 - m0); w0 = pgrp / (1.0f + d); w1 = pgrp * d / (1.0f + d);
            e0 = gs * 8 + i0; e1 = gs * 8 + i1;
            rk0 = __hip_atomic_fetch_add(hist + e0, 1u, __ATOMIC_RELAXED, __HIP_MEMORY_SCOPE_WORKGROUP);
            rk1 = __hip_atomic_fetch_add(hist + e1, 1u, __ATOMIC_RELAXED, __HIP_MEMORY_SCOPE_WORKGROUP);
        }
        __syncthreads();
        if (F.tid < 32) hbase[F.tid] = __hip_atomic_fetch_add(cnt + F.tid, hist[F.tid], __ATOMIC_RELAXED, __HIP_MEMORY_SCOPE_AGENT);
        __syncthreads();
        if (F.lane < 16) { const int t = tok0 + F.lane;
            list[(size_t)e0 * NT_TOK + hbase[e0] + rk0] = 2 * t; list[(size_t)e1 * NT_TOK + hbase[e1] + rk1] = 2 * t + 1;
            gate[2 * t] = w0; gate[2 * t + 1] = w1; }
        RowVec gm, sh; ld_mod(A.in[I_NFFN] + l * 1024, modp(F, l, b, 4), modp(F, l, b, 3), F.lane, gm, sh);
        for (int r = 0; r < 16; ++r) { RowVec x = ld_row_bf16(X + (size_t)(tok0 + r) * DM, F.lane); const float rstd = scr[16 * 49 + r];
#pragma unroll
            for (int j = 0; j < 4; ++j) x.v[j] = x.v[j] * rstd * gm.v[j] + sh.v[j];
            st_row_bf16((bf16*)(F.ws + WS_XN) + (size_t)(tok0 + r) * DM, F.lane, x); }
        __syncthreads();
    }
}

__device__ __forceinline__ void grouped_setup(Frame& F, int l, bool with_tab) {
    LAS int* ts = (LAS int*)(F.lds + TS_OFF);
    const unsigned* cnt = (const unsigned*)(F.ctl + CW_CNT) + l * 32;
    if (F.tid < 32) ts[33 + F.tid] = (int)__hip_atomic_load(cnt + F.tid, __ATOMIC_RELAXED, __HIP_MEMORY_SCOPE_AGENT);
    __syncthreads();
    if (F.tid == 0) { int s = 0; for (int e = 0; e < 32; ++e) { ts[e] = s; s += (ts[33 + e] + 255) >> 8; } ts[32] = s; }
    __syncthreads();
    {
        GroupedOrder S{(const LAS int*)ts, F.G, (int)blockIdx.x, l}; Unit u;
        const int* list = (const int*)(F.ws + WS_LIST); const float* gate = (const float*)(F.ws + WS_GATE);
        for (int i = 0; i < 5; ++i) { if (!S.next(i, u)) break;
            if (F.tid < 256) { const int ridx = u.r0 + F.tid; int a = -1; if (ridx < u.cnt) a = list[(size_t)(u.e & 31) * NT_TOK + ridx];
                if (with_tab) ((LAS unsigned*)(F.lds + GTAB_OFF))[i * 256 + F.tid] = (unsigned)((a < 0 ? 0 : a) >> 1) * 2048u;
                else { v2u ag; ag.x = (unsigned)a; ag.y = (a < 0) ? 0u : __builtin_bit_cast(unsigned, gate[a]); ((LAS v2u*)(F.lds + GTAB_OFF))[i * 256 + F.tid] = ag; } } }
        __syncthreads();
    }
}

__device__ __forceinline__ void p8_phase(const Args& A, Frame& F) {
    LAS unsigned char* tile = F.lds;
    const bf16* Y = (const bf16*)(F.ws + WS_Y); bf16* hT = (bf16*)(F.ws + WS_XN);
    for (int it = F.vcu; it < NT_TOK / 32; it += F.G) {
        const int b = it >> 7, rr = (it >> 1) & 63, qh = it & 1;
        const RowVec g2 = ld_row(modp(F, 0, b, 5), F.lane); RowVec gm, sh; ld_mod(A.in[I_NMIX] + 1024, modp(F, 1, b, 1), modp(F, 1, b, 0), F.lane, gm, sh);
        for (int q = 0; q < 4; ++q) { const int r = F.wave * 4 + q; const size_t t = (size_t)b * SEQ + 64 * (32 * qh + r) + rr;
            RowVec x = ld_row_bf16(xres(F, 1) + t * DM, F.lane); const RowVec y0 = ld_row_bf16(Y + (2 * t) * DM, F.lane), y1 = ld_row_bf16(Y + (2 * t + 1) * DM, F.lane);
#pragma unroll
            for (int j = 0; j < 4; ++j) x.v[j] = x.v[j] + g2.v[j] * (y0.v[j] + y1.v[j]);
            st_row_bf16(xres(F, 2) + t * DM, F.lane, x);
            const float rstd = rsqrtf(row_ss(x) * (1.0f / DM) + EPS);
#pragma unroll
            for (int j = 0; j < 4; ++j) { const f32x4 h = x.v[j] * rstd * gm.v[j] + sh.v[j]; v2u w; w.x = pk2(h.x, h.y); w.y = pk2(h.z, h.w); *(LAS v2u*)(tile + r * 2056 + 8 * F.lane + 512 * j) = w; } }
        __syncthreads();
        const int tg = F.lane & 3;
        for (int ic = 0; ic < 8; ++ic) { const int c = 128 * F.wave + 16 * ic + (F.lane >> 2); unsigned e[8];
#pragma unroll
            for (int i = 0; i < 8; ++i) e[i] = *(const LAS unsigned short*)(tile + (8 * tg + i) * 2056 + 2 * c);
            v4u o; o.x = e[0] | (e[1] << 16); o.y = e[2] | (e[3] << 16); o.z = e[4] | (e[5] << 16); o.w = e[6] | (e[7] << 16);
            *(GAS v4u*)(hT + ((size_t)(b * 1024 + c) * 4096 + rr * 64 + 32 * qh + 8 * tg)) = o; }
        __syncthreads();
    }
}

__device__ __forceinline__ void final_phase(const Args& A, Frame& F) {
    const int gw = F.vcu * NWAVES + F.wave, NGW = F.G * NWAVES; const bf16* Y = (const bf16*)(F.ws + WS_Y);
    const RowVec fn = ld_row(A.in[I_FN], F.lane);
    for (int it = gw; it < NT_TOK / 16; it += NGW) { const int t0 = it * 16, b = t0 / SEQ; const RowVec g2 = ld_row(modp(F, 1, b, 5), F.lane);
        for (int r = 0; r < 16; ++r) { const size_t t = (size_t)t0 + r; RowVec x = ld_row_bf16(xres(F, 3) + t * DM, F.lane); const RowVec y0 = ld_row_bf16(Y + (2 * t) * DM, F.lane), y1 = ld_row_bf16(Y + (2 * t + 1) * DM, F.lane);
#pragma unroll
            for (int j = 0; j < 4; ++j) x.v[j] = x.v[j] + g2.v[j] * (y0.v[j] + y1.v[j]);
            const float rstd = rsqrtf(row_ss(x) * (1.0f / DM) + EPS);
#pragma unroll
            for (int j = 0; j < 4; ++j) x.v[j] = x.v[j] * rstd * fn.v[j];
            st_row(F.out + t * DM, F.lane, x); } }
}

typedef float f32x16 __attribute__((ext_vector_type(16)));
__device__ __forceinline__ void fft_cos_table(Frame& F, LAS float* tab) {
    for (int i = F.tid; i < 4096; i += NWAVES * 64) tab[i] = cospif((float)i * (1.0f / 2048.0f));
    __syncthreads();
}
__device__ __forceinline__ void fft_pass_a(Frame& F) {
    constexpr int TP = 272, TILE = 32 * TP, T0 = 8 * TILE;
    LAS float* tab = (LAS float*)F.lds; LAS float* twc = (LAS float*)(F.lds + T0); LAS float* tws = twc + 4096; LAS v4u* bfl = (LAS v4u*)(F.lds + T0 + 32768);
    fft_cos_table(F, tab);
    for (int i = F.tid; i < 4096; i += NWAVES * 64) { const int r = i >> 6, k1 = i & 63; twc[i] = tab[r * k1]; tws[i] = tab[(r * k1 - 1024) & 4095]; }
    for (int i = F.tid; i < 16 * 64; i += NWAVES * 64) { const int ln = i & 63, cb = (i >> 6) & 3, s = i >> 8, r32 = ln & 31, h = ln >> 5; float v[8];
        const int col = 32 * cb + r32, k1 = col & 63, cs = col >> 6;
#pragma unroll
        for (int jj = 0; jj < 8; ++jj) { const int k = 16 * s + 8 * h + jj; const int idx = (k * k1 * 64) & 4095; v[jj] = (cs ? -tab[(idx - 1024) & 4095] : tab[idx]) * 0.125f; }
        v4u o; o.x = pk2(v[0], v[1]); o.y = pk2(v[2], v[3]); o.z = pk2(v[4], v[5]); o.w = pk2(v[6], v[7]); bfl[i] = o; }
    __syncthreads();
    const int gw = F.vcu * NWAVES + F.wave, NGW = F.G * NWAVES, r32 = F.lane & 31, h = F.lane >> 5;
    const bf16* hP = (const bf16*)(F.ws + WS_XN); bf16* YP = (bf16*)(F.ws + WS_YP);
    LAS unsigned char* tile = F.lds + F.wave * TILE;
    for (int bc = gw; bc < NB * 1024; bc += NGW) { const int b = bc >> 10, c = bc & 1023;
        const bf16* arow = hP + (size_t)bc * 4096 + r32 * 64 + 8 * h;
        bf16x8 a[2][4];
#pragma unroll
        for (int rb = 0; rb < 2; ++rb)
#pragma unroll
            for (int s = 0; s < 4; ++s) a[rb][s] = *(const GAS bf16x8*)(arow + rb * 2048 + 16 * s);
#pragma unroll 1
        for (int kb = 0; kb < 2; ++kb) { const int k1 = r32 + 32 * kb;
#pragma unroll
            for (int rb = 0; rb < 2; ++rb) { f32x16 ar = (f32x16){}, ai = (f32x16){};
#pragma unroll
                for (int s = 0; s < 4; ++s) { ar = __builtin_amdgcn_mfma_f32_32x32x16_bf16(a[rb][s], __builtin_bit_cast(bf16x8, bfl[(s * 4 + kb) * 64 + F.lane]), ar, 0, 0, 0);
                                              ai = __builtin_amdgcn_mfma_f32_32x32x16_bf16(a[rb][s], __builtin_bit_cast(bf16x8, bfl[(s * 4 + 2 + kb) * 64 + F.lane]), ai, 0, 0, 0); }
#pragma unroll
                for (int g = 0; g < 4; ++g) { float yr[4], yi[4];
#pragma unroll
                    for (int i = 0; i < 4; ++i) { const int r = 32 * rb + i + 8 * g + 4 * h; const float cc = twc[r * 64 + k1], ss = tws[r * 64 + k1]; const float xr = ar[4 * g + i], xi = ai[4 * g + i];
                        yr[i] = xr * cc + xi * ss; yi[i] = xi * cc - xr * ss; }
                    v2u w; w.x = pk2(yr[0], yr[1]); w.y = pk2(yr[2], yr[3]); *(LAS v2u*)(tile + r32 * TP + (32 * rb + 8 * g + 4 * h) * 2) = w;
                    w.x = pk2(yi[0], yi[1]); w.y = pk2(yi[2], yi[3]); *(LAS v2u*)(tile + r32 * TP + 128 + (32 * rb + 8 * g + 4 * h) * 2) = w; } }
            LDS_WAIT(); asm volatile("" ::: "memory");
#pragma unroll
            for (int p = 0; p < 8; ++p) { const int row = 4 * p + (F.lane >> 4), ch = F.lane & 15; const v4u v = *(const LAS v4u*)(tile + row * TP + ch * 16);
                *(GAS v4u*)(YP + (((size_t)(b * 64 + 32 * kb + row) * 1024 + c) * 128) + ch * 8) = v; }
            LDS_WAIT(); asm volatile("" ::: "memory");
        }
    }
}
__device__ __forceinline__ void fft_pass_c(Frame& F) {
    constexpr int TP = 144, TILE = 64 * TP, T0 = 8 * TILE;
    LAS float* tab = (LAS float*)F.lds; LAS v4u* bfl = (LAS v4u*)(F.lds + T0);
    fft_cos_table(F, tab);
    for (int i = F.tid; i < 32 * 64; i += NWAVES * 64) { const int ln = i & 63, cb = (i >> 6) & 3, s = i >> 8, r32 = ln & 31, h = ln >> 5; float v[8];
        const int col = 32 * cb + r32, k2 = col & 63, cso = col >> 6;
#pragma unroll
        for (int jj = 0; jj < 8; ++jj) { const int k = 16 * s + 8 * h + jj, csi = k >> 6, r = k & 63; const int idx = (r * k2 * 64) & 4095; const float cv = tab[idx], sv = tab[(idx - 1024) & 4095];
            v[jj] = ((csi == cso) ? (csi ? -cv : cv) : sv) * 0.125f; }
        v4u o; o.x = pk2(v[0], v[1]); o.y = pk2(v[2], v[3]); o.z = pk2(v[4], v[5]); o.w = pk2(v[6], v[7]); bfl[i] = o; }
    __syncthreads();
    const int gw = F.vcu * NWAVES + F.wave, NGW = F.G * NWAVES, r32 = F.lane & 31, h = F.lane >> 5;
    const bf16* YP = (const bf16*)(F.ws + WS_YP); bf16* ZT = (bf16*)(F.ws + WS_ZT);
    LAS unsigned char* tile = F.lds + F.wave * TILE;
    for (int it = gw; it < NB * 64 * 16; it += NGW) { const int b = it >> 10, k1 = (it >> 4) & 63, g64 = it & 15;
        const bf16* arow = YP + (((size_t)(b * 64 + k1) * 1024 + 64 * g64 + r32) * 128) + 8 * h;
        bf16x8 a[2][8];
#pragma unroll
        for (int rb = 0; rb < 2; ++rb)
#pragma unroll
            for (int s = 0; s < 8; ++s) a[rb][s] = *(const GAS bf16x8*)(arow + rb * 4096 + 16 * s);
#pragma unroll 1
        for (int cso = 0; cso < 2; ++cso) {
#pragma unroll
            for (int cbl = 0; cbl < 2; ++cbl)
#pragma unroll
                for (int rb = 0; rb < 2; ++rb) { f32x16 acc = (f32x16){};
#pragma unroll
                    for (int s = 0; s < 8; ++s) acc = __builtin_amdgcn_mfma_f32_32x32x16_bf16(a[rb][s], __builtin_bit_cast(bf16x8, bfl[(s * 4 + 2 * cso + cbl) * 64 + F.lane]), acc, 0, 0, 0);
#pragma unroll
                    for (int g = 0; g < 4; ++g) { v2u w; w.x = pk2(acc[4 * g], acc[4 * g + 1]); w.y = pk2(acc[4 * g + 2], acc[4 * g + 3]); *(LAS v2u*)(tile + (32 * cbl + r32) * TP + (32 * rb + 8 * g + 4 * h) * 2) = w; } }
            LDS_WAIT(); asm volatile("" ::: "memory");
#pragma unroll
            for (int p = 0; p < 8; ++p) { const int row = 8 * p + (F.lane >> 3), ch = F.lane & 7; const v4u v = *(const LAS v4u*)(tile + row * TP + ch * 16);
                *(GAS v4u*)(ZT + ((size_t)b * 8192 + k1 + 64 * row + 4096 * cso) * 1024 + 64 * g64 + 8 * ch) = v; }
            LDS_WAIT(); asm volatile("" ::: "memory");
        }
    }
}

#ifndef PROBE_REP
#define PROBE_REP -1
#endif
template <int K> __device__ __forceinline__ void run_phase(const Args& A, Frame& F, unsigned char* lds, unsigned char* obuf) {
    unsigned char* ws = F.ws;
    constexpr int l = (K >= 13) ? 1 : 0;
    { int ln = threadIdx.x & 63; asm volatile("" : "+v"(ln)); F.lane = ln; }
    if constexpr (K == 0) p0_prologue(A, F);
    else if constexpr (K == 1) { p1_phase(A, F);
        if (F.vcu >= F.G - 16) { const int j = F.vcu - (F.G - 16);
            if (F.tid < 64) { unsigned* cw = (unsigned*)(F.ctl + CW_CTX) + 64 * (j >> 1); unsigned sp = 0;
                while ((unsigned)__builtin_amdgcn_readfirstlane(__hip_atomic_load(cw, RLX_AGENT)) < 32u) { __builtin_amdgcn_s_sleep(2); if (++sp > (1u << 22)) break; }
                __builtin_amdgcn_fence(__ATOMIC_ACQUIRE, "agent"); VM_WAIT(); }
            __syncthreads();
            ProbQKV P{16, (const char*)(ws + WS_XN), (const char*)(ws + WS_XNC), (const char*)(ws + WS_WQKV)};
            SchedOne S; S.u0.pm = j >> 1; S.u0.pn = 4 + (j & 1); S.u0.e = 1; S.u0.r0 = 0; S.u0.cnt = 0; S.u0.rb = 0; S.u0.ui = 0;
            EpiQKV E{(bf16*)(ws + WS_QO), (bf16*)(ws + WS_K), (bf16*)(ws + WS_V), A.in[I_QN], A.in[I_KN], (const LAS float*)(F.lds + GTAB_OFF)};
            pg8::gemm_phase<ProbQKV, EpiQKV, SchedOne, true>(F.lds + RING_OFF, P, S, E); } }
    else if constexpr (K == 2) { ProbQKV P{16, (const char*)(ws + WS_XN), (const char*)(ws + WS_XNC), (const char*)(ws + WS_WQKV)};
        pg8::StaticOrder S; S.init(NT_TOK / 256, QKVN / 256, F.G, (int)blockIdx.x);
        { LAS float* lr = (LAS float*)(F.lds + GTAB_OFF); const float* gr = (const float*)(ws + WS_ROPE); for (int i = F.tid; i < 2048; i += NWAVES * 64) lr[i] = gr[i]; __syncthreads(); }
        EpiQKV E{(bf16*)(ws + WS_QO), (bf16*)(ws + WS_K), (bf16*)(ws + WS_V), A.in[I_QN], A.in[I_KN], (const LAS float*)(F.lds + GTAB_OFF)};
        pg8::gemm_phase<ProbQKV, EpiQKV, pg8::StaticOrder, true>(F.lds + RING_OFF, P, S, E); }
    else if constexpr (K == 3) { const int x = F.vcu >> 5, j = F.vcu & 31;
        for (int i = 0; i < 8; ++i) { const int pair = 4 * x + (i >> 1), b = pair >> 2, kvh = pair & 3, un = (i & 1) * 32 + j, h = kvh * 4 + (un >> 4), qb = un & 15;
            const attn_body::bf16* Qu = (const attn_body::bf16*)(ws + WS_QO) + ((size_t)b * SEQ + qb * 256) * 1024 + h * 64;
            attn_body::attn_unit<8, LK / 64>(Qu, (const attn_body::bf16*)(ws + WS_K) + (size_t)b * LK * KVP + kvh * 64, (const attn_body::bf16*)(ws + WS_V) + (size_t)b * LK * KVP + kvh * 64,
                                              (attn_body::bf16*)(obuf) + ((size_t)b * SEQ + qb * 256) * 1024 + h * 64, (char*)lds + RING_OFF); } }
    else if constexpr (K == 4) { ProbStd<true> P{16, (const char*)(ws + WS_QO), (const char*)(ws + WS_WO), 2048, 2048};
        pg8::StaticOrder S; S.init(NT_TOK / 256, 4, F.G, (int)blockIdx.x);
        EpiResid<true> E{A.in[I_X], xres(F, 1), modp(F, 0, 0, 2)};
        pg8::gemm_phase<ProbStd<true>, EpiResid<true>, pg8::StaticOrder, true>(F.lds + RING_OFF, P, S, E); }
    else if constexpr (K == 5 || K == 13) moe_in_phase(A, F, l);
    else if constexpr (K == 6 || K == 14) { grouped_setup(F, l, true);
        ProbUp P{16, (const char*)(ws + WS_XN), (const char*)(ws + WS_W13)};
        GroupedOrder S{(const LAS int*)(F.lds + TS_OFF), F.G, (int)blockIdx.x, l};
        EpiUp E{(bf16*)(ws + WS_H1)};
        pg8::gemm_phase<ProbUp, EpiUp, GroupedOrder, true>(F.lds + RING_OFF, P, S, E); }
    else if constexpr (K == 7 || K == 15) { grouped_setup(F, l, false);
        ProbDown P{8, (const char*)(ws + WS_H1), (const char*)(ws + WS_W2)};
        GroupedOrder S{(const LAS int*)(F.lds + TS_OFF), F.G, (int)blockIdx.x, l};
        EpiDown E{(bf16*)(ws + WS_Y), (const int*)(ws + WS_LIST), (const float*)(ws + WS_GATE)};
        pg8::gemm_phase<ProbDown, EpiDown, GroupedOrder, true>(F.lds + RING_OFF, P, S, E); }
    else if constexpr (K == 8) p8_phase(A, F);
    else if constexpr (K == 9) fft_pass_a(F);
    else if constexpr (K == 10) fft_pass_c(F);
    else if constexpr (K == 11) { ProbC P{8, (const char*)(ws + WS_ZT), (const char*)(ws + WS_DFTC)};
        pg8::StaticOrder S; S.init(NT_TOK / 256, 4, F.G, (int)blockIdx.x);
        EpiC E{(bf16*)(ws + WS_QO)};
        pg8::gemm_phase<ProbC, EpiC, pg8::StaticOrder, true>(F.lds + RING_OFF, P, S, E); }
    else if constexpr (K == 12) { ProbStd<true> P{16, (const char*)(ws + WS_QO), (const char*)(ws + WS_WF), 2048, 2048};
        pg8::StaticOrder S; S.init(NT_TOK / 256, 4, F.G, (int)blockIdx.x);
        EpiResid<false> E{xres(F, 2), xres(F, 3), modp(F, 1, 0, 2)};
        pg8::gemm_phase<ProbStd<true>, EpiResid<false>, pg8::StaticOrder, true>(F.lds + RING_OFF, P, S, E); }
    else if constexpr (K == 16) final_phase(A, F);
}

__global__ void __launch_bounds__(NWAVES * 64, 2) fwd_megakernel(Args args) {
    extern __shared__ __attribute__((aligned(16))) unsigned char lds[];
    Frame F;
    F.lds = (LAS unsigned char*)lds;
    F.MISC = (volatile LAS unsigned*)(F.lds + MISC_OFF);
    F.tid = threadIdx.x; F.lane = F.tid & 63; F.wave = __builtin_amdgcn_readfirstlane(F.tid >> 6);
    F.G = gridDim.x; { const int bx = blockIdx.x; F.vcu = (F.G % 8 == 0) ? (bx % 8) * (F.G / 8) + bx / 8 : bx; }
    F.ws = args.ws; F.out = args.out; F.ctl = (gu32*)(args.ws + WS_CTL);
    for (int u = F.tid; u < (LDS_BYTES - LDSCTL_OFF) / 4; u += NWAVES * 64) ((LAS unsigned*)(F.lds + LDSCTL_OFF))[u] = 0u;
    __syncthreads();
    XcdBarrier bar; bar.bar = (unsigned*)(F.ctl + CW_BAR); bar.x = 0; bar.st = nullptr;
    if (N_LAUNCHES == 1) bar = xcd_barrier_post((unsigned*)(F.ctl + CW_BAR), F.MISC + 8);
    const Args& A = args;
    const int lo = args.ph_lo, hi = args.ph_hi;
#define PH(k) do { if (PH_EN(k) && lo <= (k) && (k) < hi) { \
        if constexpr (PROBE_REP == (k)) { run_phase<k>(A, F, lds, args.ws + WS_XN); xcd_barrier(bar); } \
        run_phase<k>(A, F, lds, args.ws + WS_QO); } \
        if (lo <= (k) && (k) + 1 < hi) xcd_barrier(bar); } while (0)
    PH(0); PH(1); PH(2); PH(3); PH(4); PH(5); PH(6); PH(7); PH(8); PH(9); PH(10); PH(11); PH(12); PH(13); PH(14); PH(15); PH(16);
#undef PH
}

extern "C" void kernel_launch(void* const* d_in, const int* in_sizes, int n_in, void* d_out, int out_size, void* d_ws, size_t ws_size, hipStream_t stream) {
    static int grid = 0;
    if (grid == 0) {
        if (n_in != 21 || out_size != NT_TOK * DM || ws_size < WS_END) { fprintf(stderr, "kernel_launch: unexpected problem (n_in %d, out %d, ws %zu < %zu)\n", n_in, out_size, ws_size, (size_t)WS_END); grid = -1; return; }
        int dev = 0, cus = 0;
        if (hipGetDevice(&dev) != hipSuccess || hipDeviceGetAttribute(&cus, hipDeviceAttributeMultiprocessorCount, dev) != hipSuccess) { grid = -1; return; }
        if (hipFuncSetAttribute((const void*)fwd_megakernel, hipFuncAttributeMaxDynamicSharedMemorySize, LDS_BYTES) != hipSuccess) { fprintf(stderr, "kernel_launch: hipFuncSetAttribute failed\n"); grid = -1; return; }
        int per_cu = 0;
        if (hipOccupancyMaxActiveBlocksPerMultiprocessor(&per_cu, (const void*)fwd_megakernel, NWAVES * 64, LDS_BYTES) != hipSuccess || per_cu < 1) fprintf(stderr, "kernel_launch: occupancy query says %d\n", per_cu);
        (void)hipGetLastError();
        grid = 256;
        if (cus != 256) fprintf(stderr, "kernel_launch: device has %d CUs, kernel built for 256\n", cus);
    }
    if (grid < 0) return;
    (void)hipMemsetAsync((char*)d_ws + WS_CTL, 0, CTL_ZERO_BYTES, stream);
    Args a{};
    for (int i = 0; i < 21; ++i) a.in[i] = (const float*)d_in[i];
    a.out = (float*)d_out; a.ws = (unsigned char*)d_ws;
    if (N_LAUNCHES == 1) { a.ph_lo = 0; a.ph_hi = N_PHASES; hipLaunchKernelGGL(fwd_megakernel, dim3(grid), dim3(NWAVES * 64), LDS_BYTES, stream, a); }
    else for (int p = 0; p < N_PHASES; ++p) { a.ph_lo = p; a.ph_hi = p + 1; hipLaunchKernelGGL(fwd_megakernel, dim3(grid), dim3(NWAVES * 64), LDS_BYTES, stream, a); }
}
```

```cpp
#include <hip/hip_runtime.h>
#include <hip/hip_bf16.h>
#include <cstdio>
#include <cstdint>
#include <cmath>

#ifndef PHMASK
#define PHMASK 0x1FFFF
#endif
#define PH_EN(k) (((PHMASK) >> (k)) & 1)
#ifndef MK_N_LAUNCHES
#define MK_N_LAUNCHES 1
#endif

constexpr int NB = 8, SEQ = 4096, DM = 1024, NT_TOK = NB * SEQ, CTXL = 256, NCTX = NB * CTXL, LK = SEQ + CTXL;
constexpr int NHEAD = 16, NKVH = 4, HD = 64, QKVN = 1536, KVP = 256;
constexpr int NEXP = 32, DEXP = 512, NGRP = 4, EPG = 8;
constexpr float EPS = 1e-6f;

namespace pg8 {
#define PG8_LAS __attribute__((address_space(3)))
typedef unsigned short bf16_t;
typedef short bf16x8 __attribute__((ext_vector_type(8)));
typedef float f32x4 __attribute__((ext_vector_type(4)));
typedef unsigned u32x4 __attribute__((ext_vector_type(4)));
typedef unsigned u32x2 __attribute__((ext_vector_type(2)));
constexpr int BM = 256, BK = 64, HALF = 128, HTB = HALF * BK * 2, STAGE_BYTES = 8 * HTB, NXCD = 8, WGM = 8;

__host__ __device__ __forceinline__ int lds_byte(int r, int c) { const int st = (r >> 4) * 2 + (c >> 5), rr = r & 15, cc = c & 31, ob = rr * 64 + cc * 2; return st * 1024 + (ob ^ (((ob >> 9) & 1) << 5)); }
__host__ __device__ __forceinline__ void stage_rc(int b, int& R, int& C) { const int st = b / 1024, sb = b % 1024, swz = sb ^ (((sb >> 9) & 1) << 5); R = (st >> 1) * 16 + swz / 64; C = (st & 1) * 32 + (swz % 64) / 2; }
__host__ __device__ __forceinline__ int perm32(int rho) { const int n = rho >> 4, i = rho & 15; return 8 * (i >> 2) + 4 * n + (i & 3); }

struct Unit { int pm, pn, e, r0, cnt, rb, ui; };

__device__ __forceinline__ int xcd_remap(int wgid, int nwg) { const int q = nwg / NXCD, r = nwg % NXCD, xcd = wgid % NXCD, off = wgid / NXCD; return (xcd < r ? xcd * (q + 1) : r * (q + 1) + (xcd - r) * q) + off; }

struct StaticOrder {
    int nM, nN, nwg, G, c;
    __device__ void init(int nM_, int nN_, int G_, int c_) { nM = nM_; nN = nN_; nwg = nM * nN; G = G_; c = c_; }
    __device__ bool next(int i, Unit& u) const {
        const long L = (long)i * G + c; if (L >= nwg) return false;
        const int wgid = xcd_remap((int)L, nwg);
        const int nig = WGM * nN, gid = wgid / nig, fm = gid * WGM, gsz = (nM - fm) < WGM ? (nM - fm) : WGM;
        u.pm = fm + ((wgid % nig) % gsz); u.pn = (wgid % nig) / gsz; u.e = 0; u.r0 = 0; u.cnt = 0; u.rb = 0; u.ui = i; return true;
    }
};

__device__ __forceinline__ unsigned cvt_pk_bf16(float lo, float hi) { unsigned r; asm volatile("v_cvt_pk_bf16_f32 %0, %1, %2" : "=v"(r) : "v"(lo), "v"(hi)); return r; }

template <class Prob, class Epi, class Sched, bool ALIGN_EPI>
__device__ __forceinline__ void gemm_phase(PG8_LAS unsigned char* lds, const Prob& P, const Sched& S, const Epi& E) {
    const int tid = threadIdx.x, wid = __builtin_amdgcn_readfirstlane(tid >> 6), lane = tid & 63, wr = wid >> 2, wc = wid & 3, fr = lane & 15, fq = lane >> 4;
    const int nt = P.nt;
    int Rr[2], Cc[2];
    unsigned voffA[2], voffB[2];
#pragma unroll
    for (int i = 0; i < 2; ++i) { stage_rc(tid * 16 + i * 8192, Rr[i], Cc[i]); voffA[i] = P.a_voff(Rr[i], Cc[i]); voffB[i] = P.b_voff(Rr[i], Cc[i]); }
    const size_t hstepA = P.a_hstep(), hstepB = P.b_hstep();
    const unsigned ldsw = (unsigned)wid * 1024u;
    const int aoff = lds_byte(wr * 64 + fr, fq * 8), boff = lds_byte(wc * 32 + fr, fq * 8);
    unsigned cva0[2] = {0, 0}, cva1[2] = {0, 0}, nva0[2] = {0, 0}, nva1[2] = {0, 0};
    const PG8_LAS unsigned* tab = (const PG8_LAS unsigned*)(lds + Prob::tab_off);
#define PG8_SA(b, h) (((b) * 2 + (h)) * HTB)
#define PG8_SB(b, h) ((4 + (b) * 2 + (h)) * HTB)
#define PG8_STAGE(bufoff, gbase, voff) do { _Pragma("unroll") for (int _i = 0; _i < 2; ++_i) \
        __builtin_amdgcn_global_load_lds((const unsigned*)((const char*)(gbase) + (voff)[_i]), (PG8_LAS unsigned*)(lds + (bufoff) + ldsw + _i * 8192), 16, 0, 0); } while (0)
#define PG8_LDA(dst, b, h) do { _Pragma("unroll") for (int m = 0; m < 4; ++m) _Pragma("unroll") for (int k = 0; k < 2; ++k) dst[m][k] = *(const PG8_LAS bf16x8*)(lds + PG8_SA(b, h) + aoff + m * 2048 + k * 1024); } while (0)
#define PG8_LDB(dst, b, h) do { _Pragma("unroll") for (int n = 0; n < 2; ++n) _Pragma("unroll") for (int k = 0; k < 2; ++k) dst[n][k] = *(const PG8_LAS bf16x8*)(lds + PG8_SB(b, h) + boff + n * 2048 + k * 1024); } while (0)
#define PG8_MMA(ai, bj, At, Bt) do { __builtin_amdgcn_s_setprio(1); _Pragma("unroll") for (int m = 0; m < 4; ++m) _Pragma("unroll") for (int n = 0; n < 2; ++n) _Pragma("unroll") for (int k = 0; k < 2; ++k) \
        acc[ai][bj][m][n] = __builtin_amdgcn_mfma_f32_16x16x32_bf16(Bt[n][k], At[m][k], acc[ai][bj][m][n], 0, 0, 0); __builtin_amdgcn_s_setprio(0); } while (0)
#define PG8_WAIT_V(n) asm volatile("s_waitcnt vmcnt(" #n ")" ::: "memory")
#define PG8_WAIT_L(n) asm volatile("s_waitcnt lgkmcnt(" #n ")" ::: "memory")
#define PG8_BAR __builtin_amdgcn_s_barrier()
#define PG8_SCHED __builtin_amdgcn_sched_barrier(0)
#define PG8_STAGE_A(bufoff, gb, h, VO0, VO1) do { if constexpr (Prob::GATHER) { if ((h) == 0) PG8_STAGE(bufoff, gb, VO0); else PG8_STAGE(bufoff, gb, VO1); } else { PG8_STAGE(bufoff, (gb) + (h) * hstepA, voffA); } } while (0)
    Unit cur, nxt; int ui = 0;
    if (!S.next(0, cur)) return;
    f32x4 acc[2][2][4][2];
#pragma unroll
    for (int a = 0; a < 2; ++a)
#pragma unroll
        for (int b = 0; b < 2; ++b)
#pragma unroll
            for (int m = 0; m < 4; ++m)
#pragma unroll
                for (int n = 0; n < 2; ++n) acc[a][b][m][n] = (f32x4){0.f, 0.f, 0.f, 0.f};
    bf16x8 At[4][2], B0[2][2], B1[2][2];
    const char* cA = P.a_unit(cur); const char* cB = P.b_unit(cur);
    if constexpr (Prob::GATHER) {
#pragma unroll
        for (int i = 0; i < 2; ++i) { cva0[i] = tab[cur.ui * 256 + Rr[i]] + (unsigned)Cc[i] * 2u; cva1[i] = tab[cur.ui * 256 + 128 + Rr[i]] + (unsigned)Cc[i] * 2u; }
    }
    PG8_STAGE(PG8_SB(0, 0), cB + P.b_kt(0), voffB); PG8_STAGE(PG8_SB(0, 1), cB + P.b_kt(0) + hstepB, voffB); PG8_STAGE_A(PG8_SA(0, 0), cA + P.a_kt(0), 0, cva0, cva1); PG8_STAGE_A(PG8_SA(0, 1), cA + P.a_kt(0), 1, cva0, cva1);
    if (wr == 1) PG8_BAR;
    PG8_WAIT_V(2); PG8_BAR;
    PG8_STAGE(PG8_SB(1, 0), cB + P.b_kt(1), voffB); PG8_STAGE_A(PG8_SA(1, 0), cA + P.a_kt(1), 0, cva0, cva1); PG8_STAGE(PG8_SB(1, 1), cB + P.b_kt(1) + hstepB, voffB);
    PG8_WAIT_V(6); PG8_BAR;
    for (;;) {
        const bool has_next = S.next(ui + 1, nxt);
        const char* nA = has_next ? P.a_unit(nxt) : cA; const char* nB = has_next ? P.b_unit(nxt) : cB;
        if constexpr (Prob::GATHER) {
            const int nu = has_next ? nxt.ui : cur.ui;
#pragma unroll
            for (int i = 0; i < 2; ++i) { nva0[i] = tab[nu * 256 + Rr[i]] + (unsigned)Cc[i] * 2u; nva1[i] = tab[nu * 256 + 128 + Rr[i]] + (unsigned)Cc[i] * 2u; }
        }
        for (int t = 0; t < nt; t += 2) {
            const bool last = (t == nt - 2);
            const char* a1 = cA + P.a_kt(t + 1);
            const char* a2 = last ? nA + P.a_kt(0) : cA + P.a_kt(t + 2); const char* b2 = last ? nB + P.b_kt(0) : cB + P.b_kt(t + 2);
            const char* a3 = last ? nA + P.a_kt(1) : cA + P.a_kt(t + 3); const char* b3 = last ? nB + P.b_kt(1) : cB + P.b_kt(t + 3);
            unsigned sv0[2] = {0, 0}, sv1[2] = {0, 0};
            if constexpr (Prob::GATHER) {
#pragma unroll
                for (int i = 0; i < 2; ++i) { sv0[i] = last ? nva0[i] : cva0[i]; sv1[i] = last ? nva1[i] : cva1[i]; }
            }
            PG8_LDB(B0, 0, 0); PG8_LDB(B1, 0, 1); PG8_SCHED; PG8_LDA(At, 0, 0); PG8_STAGE_A(PG8_SA(1, 1), a1, 1, cva0, cva1);
            PG8_WAIT_V(8); PG8_WAIT_L(0); PG8_BAR; PG8_MMA(0, 0, At, B0); PG8_MMA(0, 1, At, B1); PG8_BAR; PG8_SCHED;
            PG8_LDA(At, 0, 1); PG8_STAGE(PG8_SB(0, 0), b2, voffB); PG8_STAGE(PG8_SB(0, 1), b2 + hstepB, voffB); PG8_STAGE_A(PG8_SA(0, 0), a2, 0, sv0, sv1);
            PG8_WAIT_V(8); PG8_WAIT_L(0); PG8_BAR; PG8_MMA(1, 0, At, B0); PG8_MMA(1, 1, At, B1); PG8_BAR; PG8_SCHED;
            PG8_LDB(B0, 1, 0); PG8_LDB(B1, 1, 1); PG8_SCHED; PG8_LDA(At, 1, 0); PG8_STAGE_A(PG8_SA(0, 1), a2, 1, sv0, sv1);
            PG8_WAIT_V(8); PG8_WAIT_L(0); PG8_BAR; PG8_MMA(0, 0, At, B0); PG8_MMA(0, 1, At, B1); PG8_BAR; PG8_SCHED;
            PG8_LDA(At, 1, 1); PG8_STAGE(PG8_SB(1, 0), b3, voffB); PG8_STAGE(PG8_SB(1, 1), b3 + hstepB, voffB); PG8_STAGE_A(PG8_SA(1, 0), a3, 0, sv0, sv1);
            PG8_WAIT_V(8); PG8_WAIT_L(0); PG8_BAR; PG8_MMA(1, 0, At, B0); PG8_MMA(1, 1, At, B1); PG8_BAR; PG8_SCHED;
        }
        if constexpr (ALIGN_EPI) { if (wr == 0) PG8_BAR; }
        E(acc, cur, wr, wc, fr, fq);
        if (!has_next) break;
#pragma unroll
        for (int a = 0; a < 2; ++a)
#pragma unroll
            for (int b = 0; b < 2; ++b)
#pragma unroll
                for (int m = 0; m < 4; ++m)
#pragma unroll
                    for (int n = 0; n < 2; ++n) acc[a][b][m][n] = (f32x4){0.f, 0.f, 0.f, 0.f};
        cur = nxt; cA = nA; cB = nB; ++ui;
        if constexpr (Prob::GATHER) {
#pragma unroll
            for (int i = 0; i < 2; ++i) { cva0[i] = nva0[i]; cva1[i] = nva1[i]; }
        }
        if constexpr (ALIGN_EPI) { if (wr == 1) PG8_BAR; }
    }
    PG8_WAIT_V(0);
    if constexpr (!ALIGN_EPI) { if (wr == 0) PG8_BAR; }
    PG8_BAR;
#undef PG8_SA
#undef PG8_SB
#undef PG8_STAGE
#undef PG8_STAGE_A
#undef PG8_LDA
#undef PG8_LDB
#undef PG8_MMA
#undef PG8_WAIT_V
#undef PG8_WAIT_L
#undef PG8_BAR
#undef PG8_SCHED
}
}

namespace attn_body {
using bf16=__hip_bfloat16;
using bf16x8=__attribute__((ext_vector_type(8)))short;
using s16x4=__attribute__((ext_vector_type(4)))short;
using f32x16=__attribute__((ext_vector_type(16)))float;
using u32x4=__attribute__((ext_vector_type(4)))unsigned;
constexpr int D=64,QP=1024,KP=256;
constexpr int NW=8,QBLK=32,QB=QBLK*NW,KVBLK=64;
__device__ __forceinline__ int crow(int r,int hi){return (r&3)+8*(r>>2)+4*hi;}
#define SBAR() __builtin_amdgcn_sched_barrier(0)
constexpr int NSLOT=3, SLOTB=8192;
constexpr int LDS_K=0, LDS_V=NSLOT*SLOTB, LDS_WS=2*NSLOT*SLOTB, LDS_OST=LDS_WS+NW*64*4, LDS_BYTES=LDS_OST+NW*4096;
constexpr float C2=0.125f*1.4426950408889634f;
__device__ __forceinline__ void glds16(const void*gsrc,unsigned lds_dst){unsigned keep;
  asm volatile("s_mov_b32 %0, m0\n\ts_mov_b32 m0, %2\n\ts_nop 0\n\tglobal_load_lds_dwordx4 %1, off\n\ts_mov_b32 m0, %0":"=&s"(keep):"v"(gsrc),"s"(lds_dst):"memory");}
__device__ __forceinline__ float max3f(float a,float b,float c){float r;asm("v_max3_f32 %0, %1, %2, %3":"=v"(r):"v"(a),"v"(b),"v"(c));return r;}
__device__ __forceinline__ float max2f(float a,float b){float r;asm("v_max_f32_e32 %0, %1, %2":"=v"(r):"v"(a),"v"(b));return r;}
__device__ __forceinline__ float fadd_s(float a,float b){float r;asm("v_add_f32_e32 %0, %1, %2":"=v"(r):"v"(a),"v"(b));return r;}
__device__ __forceinline__ float fsub_s(float a,float b){float r;asm("v_sub_f32_e32 %0, %1, %2":"=v"(r):"v"(a),"v"(b));return r;}
typedef float f32x2_t __attribute__((ext_vector_type(2))); typedef __bf16 bf16x2_t __attribute__((ext_vector_type(2)));
__device__ __forceinline__ unsigned cvtpk_s(float lo,float hi){f32x2_t v={lo,hi};bf16x2_t b=__builtin_convertvector(v,bf16x2_t);return __builtin_bit_cast(unsigned,b);}
#define WAIT_BAR(N) asm volatile("s_waitcnt vmcnt(" #N ") lgkmcnt(0)\n\ts_barrier":::"memory")

__device__ __forceinline__ void qkt(f32x16&p0,f32x16&p1,const char*Kslot,const bf16x8*qr,const f32x16&negm,int r32,int hi){
  const char*kb=Kslot+hi*1024+r32*16;
  #pragma unroll
  for(int d0=0;d0<4;++d0){
    const bf16x8 b0=*reinterpret_cast<const bf16x8*>(kb+d0*2048);
    const bf16x8 b1=*reinterpret_cast<const bf16x8*>(kb+d0*2048+512);
    if(d0==0){p0=__builtin_amdgcn_mfma_f32_32x32x16_bf16(b0,qr[0],negm,0,0,0);p1=__builtin_amdgcn_mfma_f32_32x32x16_bf16(b1,qr[0],negm,0,0,0);}
    else{p0=__builtin_amdgcn_mfma_f32_32x32x16_bf16(b0,qr[d0],p0,0,0,0);p1=__builtin_amdgcn_mfma_f32_32x32x16_bf16(b1,qr[d0],p1,0,0,0);}}
}
typedef __attribute__((address_space(3))) const char* lds_cptr;
typedef short v4i16_t __attribute__((ext_vector_type(4)));
__device__ __forceinline__ void kload8(bf16x8*kf,lds_cptr kp){
  kf[0]=*(const __attribute__((address_space(3))) bf16x8*)(kp);      kf[1]=*(const __attribute__((address_space(3))) bf16x8*)(kp+512);
  kf[2]=*(const __attribute__((address_space(3))) bf16x8*)(kp+2048); kf[3]=*(const __attribute__((address_space(3))) bf16x8*)(kp+2560);
  kf[4]=*(const __attribute__((address_space(3))) bf16x8*)(kp+4096); kf[5]=*(const __attribute__((address_space(3))) bf16x8*)(kp+4608);
  kf[6]=*(const __attribute__((address_space(3))) bf16x8*)(kp+6144); kf[7]=*(const __attribute__((address_space(3))) bf16x8*)(kp+6656);
}
__device__ __forceinline__ void kload2(bf16x8*kf,lds_cptr kp,int j){ kf[2*j]=*(const __attribute__((address_space(3))) bf16x8*)(kp+j*2048); kf[2*j+1]=*(const __attribute__((address_space(3))) bf16x8*)(kp+j*2048+512); }
__device__ __forceinline__ s16x4 vtr(lds_cptr p){ return __builtin_bit_cast(s16x4,__builtin_amdgcn_ds_read_tr16_b64_v4i16((__attribute__((address_space(3))) v4i16_t*)p)); }
__device__ __forceinline__ float rowmax(const f32x16&p0,const f32x16&p1){
  float a=max3f(p0[0],p0[1],p1[0]),b=max3f(p0[2],p0[3],p1[1]);a=max3f(a,p1[2],p1[3]);
  #pragma unroll
  for(int r=4;r<16;r+=4){a=max3f(a,p0[r],p0[r+1]);b=max3f(b,p0[r+2],p0[r+3]);a=max3f(a,p1[r],p1[r+1]);b=max3f(b,p1[r+2],p1[r+3]);}
  const float m=max2f(a,b);
  auto rr=__builtin_amdgcn_permlane32_swap(__float_as_uint(m),__float_as_uint(m),false,false);
  return max2f(__uint_as_float(rr[0]),__uint_as_float(rr[1]));
}
__device__ __forceinline__ void pv(f32x16*o,int vb,bf16x8 pa0,bf16x8 pa1,bf16x8 pa2,bf16x8 pa3){
  #pragma unroll
  for(int d0=0;d0<2;++d0){s16x4 lo[4],hi[4];
    #pragma unroll
    for(int ks=0;ks<4;++ks){
      asm volatile("ds_read_b64_tr_b16 %0,%1 offset:%c2":"=&v"(lo[ks]):"v"(vb),"i"(d0*4096+ks*1024):"memory");
      asm volatile("ds_read_b64_tr_b16 %0,%1 offset:%c2":"=&v"(hi[ks]):"v"(vb),"i"(d0*4096+ks*1024+512):"memory");}
    asm volatile("s_waitcnt lgkmcnt(0)":::"memory");SBAR();
    #define PK(k) (bf16x8){lo[k][0],lo[k][1],lo[k][2],lo[k][3],hi[k][0],hi[k][1],hi[k][2],hi[k][3]}
    o[d0]=__builtin_amdgcn_mfma_f32_32x32x16_bf16(pa0,PK(0),o[d0],0,0,0);
    o[d0]=__builtin_amdgcn_mfma_f32_32x32x16_bf16(pa1,PK(1),o[d0],0,0,0);
    o[d0]=__builtin_amdgcn_mfma_f32_32x32x16_bf16(pa2,PK(2),o[d0],0,0,0);
    o[d0]=__builtin_amdgcn_mfma_f32_32x32x16_bf16(pa3,PK(3),o[d0],0,0,0);
    #undef PK
  }
}
#define ATTN_STORE16(p,v) (*(u32x4*)(p)=(v))
template<int NT> __device__ __forceinline__ void attn_unit(const bf16*Qu,const bf16*__restrict__ Kh,const bf16*__restrict__ Vh,bf16*Ou,char*shm,float mref){
  const int tid=threadIdx.x,lane=tid&63,r32=lane&31,hi=lane>>5; const int wid=__builtin_amdgcn_readfirstlane(tid>>6);
  const bf16*Qw=Qu+(long)(wid*QBLK)*QP;
  const unsigned lds0=(unsigned)(uintptr_t)shm;
  float*wsf=(float*)(shm+LDS_WS)+wid*64;
  const bf16*ksrc=Kh+(long)lane*KP+wid*8;
  const bf16*vsrc=Vh+(long)(16*(wid&3)+(lane>>2))*KP+(wid>>2)*32+(lane&3)*8;
  const unsigned kdst=lds0+LDS_K+wid*1024, vdst=lds0+LDS_V+wid*1024;
  #define DMA_K(t,slot) glds16(ksrc+(long)(t)*KVBLK*KP,(unsigned)__builtin_amdgcn_readfirstlane(kdst+(slot)))
  #define DMA_V(t,slot) glds16(vsrc+(long)(t)*KVBLK*KP,(unsigned)__builtin_amdgcn_readfirstlane(vdst+(slot)))
  const int vb0=(int)(lds0+LDS_V)+((lane>>4)&1)*32+(lane&3)*8+(4*hi+((lane&15)>>2))*64;
  const char*Kbase=shm+LDS_K; bf16x8 kf[8];
  const lds_cptr shm3=(lds_cptr)shm; const lds_cptr kp0=shm3+LDS_K+hi*1024+r32*16; const lds_cptr vp0=shm3+LDS_V+((lane>>4)&1)*32+(lane&3)*8+(4*hi+((lane&15)>>2))*64;
  DMA_K(0,0);DMA_V(0,0);DMA_K(1,SLOTB);
  bf16x8 qr[4];
  #pragma unroll
  for(int d0=0;d0<4;++d0)qr[d0]=*reinterpret_cast<const bf16x8*>(&Qw[(long)r32*QP+d0*16+hi*8]);
  float l_reg=0.f;f32x16 o[2];o[0]=f32x16{};o[1]=f32x16{};f32x16 negm;
  _Pragma("unroll") for(int r=0;r<16;++r)negm[r]=-mref; asm volatile("":"+v"(negm));
  f32x16 pA0,pA1,pB0,pB1;
  int sl_prev=0,sl_cur=0,sl_next=SLOTB;
  #define ROT() do{sl_prev=sl_cur;sl_cur=sl_next;sl_next=(sl_next==(NSLOT-1)*SLOTB)?0:sl_next+SLOTB;}while(0)
  DMA_K(2,2*SLOTB);
  WAIT_BAR(3);
  qkt(pA0,pA1,Kbase,qr,negm,r32,hi);asm volatile("s_nop 15\n\ts_nop 7":"+v"(pA0),"+v"(pA1));
  _Pragma("unroll") for(int r=0;r<16;++r)pA0[r]=__builtin_amdgcn_exp2f(pA0[r]);
  _Pragma("unroll") for(int r=0;r<16;++r)pA1[r]=__builtin_amdgcn_exp2f(pA1[r]);
  WAIT_BAR(0);
  DMA_K(3,0);DMA_V(1,SLOTB);
  ROT();
  kload8(kf,kp0+sl_cur);
  WAIT_BAR(2);
  s16x4 vlo[8],vhi[8]; u32x4 pw0,pw1,pw2,pw3;
  #define PKW(P,B) cvtpk_s(P[B],P[B+1])
  #define PAF(k) __builtin_bit_cast(bf16x8,pw##k)
  #define VFR(i) (bf16x8){vlo[i][0],vlo[i][1],vlo[i][2],vlo[i][3],vhi[i][0],vhi[i][1],vhi[i][2],vhi[i][3]}
  #define PIN(x) asm volatile("":"+v"(x))
  #define MX3(a,b,c) __builtin_fmaxf(__builtin_fmaxf((a),(b)),(c))
  #define GAPA(MF,A0,A1,A2,A3,W0,W1,PW) do{ MF; sacc+=A0; sacc+=A1; sacc+=A2; sacc+=A3; PIN(sacc); W0; W1; PIN(PW); SBAR(); }while(0)
  #define EX(v) __builtin_amdgcn_exp2f(v)
  #define GAPB(MF,X,B) do{ MF; X[B]=EX(X[B]); X[B+1]=EX(X[B+1]); X[B+2]=EX(X[B+2]); X[B+3]=EX(X[B+3]); PIN(X); SBAR(); }while(0)
  #define VRD(i) do{ vlo[i]=vtr(vp_+(((i)>>2)*4096+((i)&3)*1024)); vhi[i]=vtr(vp_+(((i)>>2)*4096+((i)&3)*1024+512)); }while(0)
  #define KRD(G,j) do{ if(G){ kload2(kf,kp0+sl_next,j); SBAR(); } }while(0)
  #define STEP(C0,C1,P0,P1,t,GK,GV,GL) do{ SBAR(); \
    const lds_cptr vp_=vp0+sl_prev; \
    VRD(0); SBAR(); float sacc=(P0[0]+P0[1]); \
    GAPA(C0=__builtin_amdgcn_mfma_f32_32x32x16_bf16(kf[0],qr[0],negm,0,0,0), P0[2],P0[3],P0[4],P0[5],     pw0[0]=PKW(P0,0), pw0[1]=PKW(P0,2), pw0); \
    VRD(4); SBAR(); GAPA(C1=__builtin_amdgcn_mfma_f32_32x32x16_bf16(kf[1],qr[0],negm,0,0,0), P0[6],P0[7],P0[8],P0[9],     pw0[2]=PKW(P0,4), pw0[3]=PKW(P0,6), pw0); \
    VRD(1); SBAR(); GAPA(C0=__builtin_amdgcn_mfma_f32_32x32x16_bf16(kf[2],qr[1],C0,0,0,0),   P0[10],P0[11],P0[12],P0[13], pw1[0]=PKW(P0,8), pw1[1]=PKW(P0,10), pw1); \
    VRD(5); SBAR(); GAPA(C1=__builtin_amdgcn_mfma_f32_32x32x16_bf16(kf[3],qr[1],C1,0,0,0),   P0[14],P0[15],P1[0],P1[1],   pw1[2]=PKW(P0,12),pw1[3]=PKW(P0,14), pw1); \
    VRD(2); SBAR(); GAPA(C0=__builtin_amdgcn_mfma_f32_32x32x16_bf16(kf[4],qr[2],C0,0,0,0),   P1[2],P1[3],P1[4],P1[5],     pw2[0]=PKW(P1,0), pw2[1]=PKW(P1,2), pw2); \
    VRD(6); SBAR(); GAPA(C1=__builtin_amdgcn_mfma_f32_32x32x16_bf16(kf[5],qr[2],C1,0,0,0),   P1[6],P1[7],P1[8],P1[9],     pw2[2]=PKW(P1,4), pw2[3]=PKW(P1,6), pw2); \
    VRD(3); SBAR(); GAPA(C0=__builtin_amdgcn_mfma_f32_32x32x16_bf16(kf[6],qr[3],C0,0,0,0),   P1[10],P1[11],P1[12],P1[13], pw3[0]=PKW(P1,8), pw3[1]=PKW(P1,10), pw3); \
    VRD(7); SBAR(); GAPA(C1=__builtin_amdgcn_mfma_f32_32x32x16_bf16(kf[7],qr[3],C1,0,0,0),   P1[14],P1[15],0.f,0.f,       pw3[2]=PKW(P1,12),pw3[3]=PKW(P1,14), pw3); \
    l_reg+=sacc; \
    if(GK){DMA_K((t)+3,sl_cur);} if(GV){DMA_V((t)+1,sl_next);} \
    SBAR(); \
    GAPB(o[0]=__builtin_amdgcn_mfma_f32_32x32x16_bf16(PAF(0),VFR(0),o[0],0,0,0), C0,0); \
    GAPB(o[1]=__builtin_amdgcn_mfma_f32_32x32x16_bf16(PAF(0),VFR(4),o[1],0,0,0), C0,4); \
    KRD(GL,0); GAPB(o[0]=__builtin_amdgcn_mfma_f32_32x32x16_bf16(PAF(1),VFR(1),o[0],0,0,0), C0,8); \
    KRD(GL,1); GAPB(o[1]=__builtin_amdgcn_mfma_f32_32x32x16_bf16(PAF(1),VFR(5),o[1],0,0,0), C0,12); \
    KRD(GL,2); GAPB(o[0]=__builtin_amdgcn_mfma_f32_32x32x16_bf16(PAF(2),VFR(2),o[0],0,0,0), C1,0); \
    KRD(GL,3); GAPB(o[1]=__builtin_amdgcn_mfma_f32_32x32x16_bf16(PAF(2),VFR(6),o[1],0,0,0), C1,4); \
    GAPB(o[0]=__builtin_amdgcn_mfma_f32_32x32x16_bf16(PAF(3),VFR(3),o[0],0,0,0), C1,8); \
    GAPB(o[1]=__builtin_amdgcn_mfma_f32_32x32x16_bf16(PAF(3),VFR(7),o[1],0,0,0), C1,12); \
    }while(0)
  int t=1;
  for(;t+5<NT;t+=2){
    STEP(pB0,pB1,pA0,pA1,t,true,true,true);     WAIT_BAR(2); ROT();
    STEP(pA0,pA1,pB0,pB1,t+1,true,true,true);   WAIT_BAR(2); ROT();
  }
  #define ENDW(tt) do{ if((tt)+3<NT){WAIT_BAR(2);} else if((tt)+2<NT){WAIT_BAR(1);} else {WAIT_BAR(0);} }while(0)
  for(;t+1<NT;t+=2){
    STEP(pB0,pB1,pA0,pA1,t,(t+3<NT),(t+1<NT),(t+1<NT));       ENDW(t);   ROT();
    STEP(pA0,pA1,pB0,pB1,t+1,(t+4<NT),(t+2<NT),(t+2<NT));     ENDW(t+1); ROT();
  }
  STEP(pB0,pB1,pA0,pA1,NT-1,false,false,false);
  { float sacc=pB0[0]+pB0[1]; _Pragma("unroll") for(int r=2;r<16;++r)sacc+=pB0[r]; _Pragma("unroll") for(int r=0;r<16;++r)sacc+=pB1[r]; l_reg+=sacc;
    pw0=(u32x4){PKW(pB0,0),PKW(pB0,2),PKW(pB0,4),PKW(pB0,6)};pw1=(u32x4){PKW(pB0,8),PKW(pB0,10),PKW(pB0,12),PKW(pB0,14)};pw2=(u32x4){PKW(pB1,0),PKW(pB1,2),PKW(pB1,4),PKW(pB1,6)};pw3=(u32x4){PKW(pB1,8),PKW(pB1,10),PKW(pB1,12),PKW(pB1,14)};
    SBAR(); pv(o,vb0+sl_cur,PAF(0),PAF(1),PAF(2),PAF(3)); }
  #undef PKW
  #undef PAF
  #undef VFR
  #undef PIN
  #undef MX3
  #undef GAPA
  #undef GAPB
  #undef EX
  #undef VRD
  #undef KRD
  #undef STEP
  #undef ENDW
  {auto rr=__builtin_amdgcn_permlane32_swap(__float_as_uint(l_reg),__float_as_uint(l_reg),false,false);l_reg=__uint_as_float(rr[0])+__uint_as_float(rr[1]);}
  if(hi==0)wsf[32+r32]=l_reg;asm volatile("s_waitcnt lgkmcnt(0)":::"memory");
  float rli[16];
  #pragma unroll
  for(int r=0;r<16;++r)rli[r]=__builtin_amdgcn_rcpf(wsf[32+crow(r,hi)]);
  bf16*Ow=Ou+(long)(wid*QBLK)*QP;
  { bf16*stg=(bf16*)(shm+LDS_OST)+wid*2048;
    #pragma unroll
    for(int r=0;r<16;++r){const int orow=crow(r,hi);
      #pragma unroll
      for(int d0=0;d0<2;++d0)stg[orow*64+d0*32+r32]=__float2bfloat16(o[d0][r]*rli[r]);}
    asm volatile("s_waitcnt lgkmcnt(0)":::"memory");
    #pragma unroll
    for(int i=0;i<4;++i){const int row=i*8+(lane>>3),ch=lane&7; const u32x4 v=*(const u32x4*)(stg+row*64+ch*8); ATTN_STORE16(Ow+(long)row*QP+ch*8,v);} }
  asm volatile("s_waitcnt lgkmcnt(0)\n\ts_barrier":::"memory");
  #undef DMA_K
  #undef DMA_V
  #undef ROT
}
#undef SBAR
#undef WAIT_BAR
}

constexpr int NWAVES = 8;
constexpr int N_LAUNCHES = MK_N_LAUNCHES;
constexpr int N_PHASES = 17;

constexpr size_t MiB = 1u << 20;
constexpr size_t WS_CTL = 0, CTL_ZERO_BYTES = 1 * MiB;
constexpr size_t WS_MOD = 1 * MiB;
constexpr size_t WS_ROPE = 1 * MiB + 512 * 1024;
constexpr size_t WS_RBIAS = WS_ROPE + 16 * 1024;
constexpr size_t WS_DFTC = 1 * MiB + 768 * 1024;
constexpr size_t WS_RW = 2 * MiB;
constexpr size_t WS_WQKV = 6 * MiB, WS_WO = 9 * MiB, WS_WF = 11 * MiB;
constexpr size_t WS_LIST = 13 * MiB;
constexpr size_t WS_GATE = 17 * MiB;
constexpr size_t WS_W13 = 18 * MiB;
constexpr size_t WS_W2 = 146 * MiB;
constexpr size_t WS_ZT = 210 * MiB;
constexpr size_t WS_X3 = 210 * MiB;
constexpr size_t WS_YP = 342 * MiB;
constexpr size_t WS_XN = 274 * MiB;
constexpr size_t WS_XNC = 338 * MiB;
constexpr size_t WS_QO = 342 * MiB;
constexpr size_t WS_K = 406 * MiB, WS_V = 423 * MiB;
constexpr size_t WS_H1 = 342 * MiB;
constexpr size_t WS_Y = 440 * MiB;
constexpr size_t WS_END = 568 * MiB;
constexpr int CW_TMO = 0, CW_CODE = 1, CW_BAR = 4096, CW_CNT = 16384, CW_CTX = 16384 + 256;

constexpr int RING_OFF = 0, RING_BYTES = 131072;
constexpr int LDSCTL_OFF = RING_BYTES, MISC_OFF = LDSCTL_OFF + 320;
constexpr int TS_OFF = LDSCTL_OFF + 512;
constexpr int HIST_OFF = LDSCTL_OFF + 1024;
constexpr int GTAB_OFF = LDSCTL_OFF + 2048;
constexpr int LDS_BYTES = 147456;

#define GAS __attribute__((address_space(1)))
#define LAS __attribute__((address_space(3)))
typedef unsigned short bf16;
typedef unsigned v4u __attribute__((ext_vector_type(4)));
typedef unsigned v2u __attribute__((ext_vector_type(2)));
typedef float f32x4 __attribute__((ext_vector_type(4)));
typedef short bf16x8 __attribute__((ext_vector_type(8)));
typedef GAS unsigned gu32;
#define RLX_AGENT __ATOMIC_RELAXED, __HIP_MEMORY_SCOPE_AGENT
#define LDS_WAIT() asm volatile("s_waitcnt lgkmcnt(0)" ::: "memory")
#define VM_WAIT() asm volatile("s_waitcnt vmcnt(0)" ::: "memory")
__device__ __forceinline__ unsigned f2bf(float f) { unsigned u = __builtin_bit_cast(unsigned, f); return (u + 0x7fffu + ((u >> 16) & 1u)) >> 16; }
__device__ __forceinline__ unsigned pk2(float lo, float hi) { return f2bf(lo) | (f2bf(hi) << 16); }
__device__ __forceinline__ float bf2f(unsigned h) { return __builtin_bit_cast(float, h << 16); }

#define XB_TMO      128
#define XB_XCNT(j)  (256  + 64 * (j))
#define XB_XSUB(j)  (1280 + 64 * (j))
#define XB_XGEN(j)  (2304 + 64 * (j))
#define XB_TOP      3328
#define XB_TOPGEN   3392
#define XCD_BAR_WORDS 3456
#define XB_SPIN_CAP (1u << 18)
__device__ __forceinline__ unsigned xb_ld(unsigned* p)              { return __hip_atomic_load(p, __ATOMIC_RELAXED, __HIP_MEMORY_SCOPE_AGENT); }
__device__ __forceinline__ unsigned xb_add(unsigned* p, unsigned v) { return __hip_atomic_fetch_add(p, v, __ATOMIC_RELAXED, __HIP_MEMORY_SCOPE_AGENT); }
__device__ __forceinline__ unsigned xb_xcc_id() { return (unsigned)__builtin_amdgcn_s_getreg((3 << 11) | 20) & 0xFu; }
#define XB_SPIN(cond, bar) do { unsigned _sp = 0; while (cond) { __builtin_amdgcn_s_sleep(1); \
    if ((++_sp & 255u) == 0u) { if (xb_ld(&(bar)[XB_TMO])) break; if (_sp > XB_SPIN_CAP) { atomicAdd(&(bar)[XB_TMO], 1u); break; } } } } while (0)
struct XcdBarrier { unsigned* bar; unsigned x; volatile LAS unsigned* st; };
__device__ __forceinline__ XcdBarrier xcd_barrier_post(unsigned* bar, volatile LAS unsigned* st) {
    XcdBarrier b; b.bar = bar; b.x = xb_xcc_id(); b.st = st;
    if (threadIdx.x == 0) (void)xb_add(&bar[XB_XCNT(b.x)], 1u);
    return b;
}
__device__ __forceinline__ void xcd_barrier_complete(unsigned* bar, unsigned x, unsigned& nloc, unsigned& nx) {
    const unsigned G = gridDim.x * gridDim.y * gridDim.z;
    unsigned sum, cnt, mine, sp = 0u;
    for (;;) {
        sum = 0u; cnt = 0u; mine = 0u;
#pragma unroll
        for (unsigned j = 0; j < 16; ++j) { const unsigned c = xb_ld(&bar[XB_XCNT(j)]); sum += c; cnt += (c > 0u) ? 1u : 0u; mine = (j == x) ? c : mine; }
        if (sum == G) break;
        __builtin_amdgcn_s_sleep(1);
        if ((++sp & 255u) == 0u) { if (xb_ld(&bar[XB_TMO])) break; if (sp > XB_SPIN_CAP) { atomicAdd(&bar[XB_TMO], 1u); break; } }
    }
    nloc = mine > 0u ? mine : 1u; nx = cnt > 0u ? cnt : 1u;
}
__device__ __forceinline__ void xcd_barrier(const XcdBarrier& b) {
    asm volatile("s_waitcnt vmcnt(0)" ::: "memory");
    __syncthreads();
    if (threadIdx.x == 0) {
        unsigned* bar = b.bar;
        __builtin_amdgcn_s_waitcnt(0);
        unsigned nloc = b.st[0], nx = b.st[1];
        if (nloc == 0u) { xcd_barrier_complete(bar, b.x, nloc, nx); b.st[0] = nloc; b.st[1] = nx; }
        const unsigned old = xb_add(&bar[XB_XSUB(b.x)], 1u);
        const unsigned gen = old / nloc;
        if (old + 1u == (gen + 1u) * nloc) {
            __builtin_amdgcn_fence(__ATOMIC_RELEASE, "agent");
            asm volatile("s_waitcnt vmcnt(0)" ::: "memory");
            const unsigned og = xb_add(&bar[XB_TOP], 1u);
            const unsigned tg = og / nx;
            if (og + 1u == (tg + 1u) * nx) xb_add(&bar[XB_TOPGEN], 1u);
            else XB_SPIN(xb_ld(&bar[XB_TOPGEN]) == tg, bar);
            __builtin_amdgcn_fence(__ATOMIC_ACQUIRE, "agent");
            xb_add(&bar[XB_XGEN(b.x)], 1u);
            asm volatile("s_waitcnt vmcnt(0)" ::: "memory");
        } else {
            XB_SPIN(xb_ld(&bar[XB_XGEN(b.x)]) == gen, bar);
            __builtin_amdgcn_fence(__ATOMIC_ACQUIRE, "agent");
            asm volatile("s_waitcnt vmcnt(0)" ::: "memory");
        }
    }
    __syncthreads();
}

struct Args { const float* in[21]; float* out; unsigned char* ws; int ph_lo, ph_hi; };
struct Frame {
    LAS unsigned char* lds;
    volatile LAS unsigned* MISC;
    gu32* ctl;
    int tid, lane, wave;
    int vcu, G;
    unsigned char* ws;
    float* out;
};
enum { I_X = 0, I_C, I_CTX, I_CCTX, I_WMOD, I_BMOD, I_NMIX, I_NFFN, I_WQKV, I_QN, I_KN, I_WO, I_WF, I_WRG, I_BRG, I_WRE, I_BRE, I_W1, I_W3, I_W2, I_FN };

__device__ __forceinline__ float wave_sum(float v) {
#pragma unroll
    for (int o = 1; o < 64; o <<= 1) v += __shfl_xor(v, o);
    return v;
}

struct TItem { const float* src; bf16* dst; int N, ldk; };
__device__ __forceinline__ void p0_item_load(const TItem& t, int lane, f32x4 (&v)[8]) {
#pragma unroll
    for (int i = 0; i < 8; ++i) v[i] = *(const GAS f32x4*)(t.src + (size_t)((lane >> 3) + 8 * i) * t.N + 4 * (lane & 7));
}
__device__ __forceinline__ void p0_item_store(const TItem& t, int lane, const f32x4 (&v)[8], LAS float* scr) {
#pragma unroll
    for (int i = 0; i < 8; ++i) { LAS float* d = scr + ((lane >> 3) + 8 * i) * 33 + 4 * (lane & 7); d[0] = v[i].x; d[1] = v[i].y; d[2] = v[i].z; d[3] = v[i].w; }
    LDS_WAIT(); asm volatile("" ::: "memory");
    const int c = lane & 7;
#pragma unroll
    for (int j = 0; j < 4; ++j) { const int n = (lane >> 3) + 8 * j; const LAS float* s = scr + (8 * c) * 33 + n;
        v4u o; o.x = pk2(s[0 * 33], s[1 * 33]); o.y = pk2(s[2 * 33], s[3 * 33]); o.z = pk2(s[4 * 33], s[5 * 33]); o.w = pk2(s[6 * 33], s[7 * 33]);
        *(GAS v4u*)(t.dst + (size_t)n * t.ldk + 8 * c) = o; }
    LDS_WAIT(); asm volatile("" ::: "memory");
}
__device__ __forceinline__ void p0_prologue(const Args& A, Frame& F) {
    LAS float* L = (LAS float*)(F.lds);
    if (F.vcu < 192) {
        const int l = F.vcu / 96, cg = F.vcu % 96;
        LAS float* sc = L;
        LAS float* part = L + 10240;
        for (int i = F.tid; i < 9 * 1024; i += NWAVES * 64) { const int r = i >> 10, k = i & 1023; const float c = (r < 8) ? A.in[I_C][r * 1024 + k] : A.in[I_CCTX][k]; sc[i] = c / (1.f + __expf(-c)); }
        __syncthreads();
        f32x4 acc[9];
#pragma unroll
        for (int r = 0; r < 9; ++r) acc[r] = (f32x4){0.f, 0.f, 0.f, 0.f};
        const int c4 = F.lane & 15, kg = F.lane >> 4;
        const float* wp = A.in[I_WMOD] + (size_t)l * 1024 * 6144 + cg * 64 + 4 * c4;
        const int kb = F.wave * 128;
        for (int i0 = 0; i0 < 32; i0 += 8) { f32x4 w[8];
#pragma unroll
            for (int i = 0; i < 8; ++i) w[i] = *(const GAS f32x4*)(wp + (size_t)(kb + 4 * (i0 + i) + kg) * 6144);
#pragma unroll
            for (int i = 0; i < 8; ++i) { const int k = kb + 4 * (i0 + i) + kg;
#pragma unroll
                for (int r = 0; r < 9; ++r) acc[r] += w[i] * sc[r * 1024 + k]; } }
#pragma unroll
        for (int r = 0; r < 9; ++r) {
#pragma unroll
            for (int j = 0; j < 4; ++j) { float v = acc[r][j]; v += __shfl_xor(v, 16); v += __shfl_xor(v, 32); acc[r][j] = v; }
            if (kg == 0) *(LAS f32x4*)(part + (F.wave * 9 + r) * 64 + 4 * c4) = acc[r]; }
        __syncthreads();
        for (int i = F.tid; i < 9 * 64; i += NWAVES * 64) { const int r = i >> 6, c = i & 63; float s = 0.f;
#pragma unroll
            for (int w = 0; w < 8; ++w) s += part[(w * 9 + r) * 64 + c];
            ((float*)(F.ws + WS_MOD))[(l * 9 + r) * 6144 + cg * 64 + c] = s + A.in[I_BMOD][l * 6144 + cg * 64 + c]; }
        __syncthreads();
    }
    LAS float* tab = L + 16384;
    for (int i = F.tid; i < 4096; i += NWAVES * 64) tab[i] = cospif((float)i * (1.0f / 2048.0f));
    __syncthreads();
    const int gw = F.vcu * NWAVES + F.wave, NGW = F.G * NWAVES;
    {
      bf16* DC = (bf16*)(F.ws + WS_DFTC);
      for (int m = gw; m < 256; m += NGW) { const int c0 = 8 * F.lane; float v[8];
#pragma unroll
          for (int i = 0; i < 8; ++i) { const int c = c0 + i; const int cc = c & 255; const int idx = (m * cc * 16) & 4095; v[i] = (c < 256) ? tab[idx] * (1.0f / 16.0f) : -tab[(idx - 1024) & 4095] * (1.0f / 16.0f); }
          v4u o; o.x = pk2(v[0], v[1]); o.y = pk2(v[2], v[3]); o.z = pk2(v[4], v[5]); o.w = pk2(v[6], v[7]);
          *(GAS v4u*)(DC + (size_t)m * 512 + c0) = o; }
      if (F.vcu == F.G - 1) { float* R = (float*)(F.ws + WS_ROPE);
          for (int i = F.tid; i < 1024; i += NWAVES * 64) { const int pos = i >> 4, j = i & 15; const float inv = powf(10000.0f, -(float)j / 16.0f); const float ang = (float)pos * inv; R[i] = cosf(ang); R[1024 + i] = sinf(ang); } }
    }
    __syncthreads();
    LAS float* scr = (LAS float*)(F.lds + F.wave * 16384);
    constexpr int I_QKV = 16 * 48, I_SQ = 16 * 32, I_MOE = 768 * 64;
    constexpr int NITEMS = I_QKV + 2 * I_SQ + I_MOE;
    auto item_of = [&](int it) -> TItem {
        int r = it; TItem t;
        auto mk = [&](const float* W, int N, bf16* WT, int ldk, int row_off, int kb, int nb) { t.src = W + (size_t)(64 * kb) * N + 32 * nb; t.dst = WT + (size_t)(row_off + 32 * nb) * ldk + 64 * kb; t.N = N; t.ldk = ldk; };
        if (r < I_QKV) { mk(A.in[I_WQKV], QKVN, (bf16*)(F.ws + WS_WQKV), 1024, 0, r / 48, r % 48); return t; } r -= I_QKV;
        if (r < I_SQ) { mk(A.in[I_WO], 1024, (bf16*)(F.ws + WS_WO), 1024, 0, r / 32, r % 32); return t; } r -= I_SQ;
        if (r < I_SQ) { mk(A.in[I_WF], 1024, (bf16*)(F.ws + WS_WF), 1024, 0, r / 32, r % 32); return t; } r -= I_SQ;
        const int le = r / 768, q = r % 768;
        if (q < 256) mk(A.in[I_W1] + (size_t)le * 1024 * 512, 512, (bf16*)(F.ws + WS_W13) + (size_t)le * 1024 * 1024, 1024, 0, q / 16, q % 16);
        else if (q < 512) mk(A.in[I_W3] + (size_t)le * 1024 * 512, 512, (bf16*)(F.ws + WS_W13) + (size_t)le * 1024 * 1024, 1024, 512, (q - 256) / 16, (q - 256) % 16);
        else mk(A.in[I_W2] + (size_t)le * 512 * 1024, 1024, (bf16*)(F.ws + WS_W2) + (size_t)le * 1024 * 512, 512, 0, (q - 512) / 32, (q - 512) % 32);
        return t; };
    if (gw < NITEMS) {
        TItem cur = item_of(gw); f32x4 va[8], vb[8];
        p0_item_load(cur, F.lane, va);
        for (int it = gw; it < NITEMS; it += 2 * NGW) {
            const bool h1 = it + NGW < NITEMS; TItem n1 = cur; if (h1) { n1 = item_of(it + NGW); p0_item_load(n1, F.lane, vb); }
            p0_item_store(cur, F.lane, va, scr);
            if (!h1) break;
            const bool h2 = it + 2 * NGW < NITEMS; if (h2) { cur = item_of(it + 2 * NGW); p0_item_load(cur, F.lane, va); }
            p0_item_store(n1, F.lane, vb, scr);
            if (!h2) break;
        }
    }
}

struct RowVec { f32x4 v[4]; };
__device__ __forceinline__ RowVec ld_row(const float* p, int lane) { RowVec r; const GAS f32x4* q = (const GAS f32x4*)p + lane;
#pragma unroll
    for (int j = 0; j < 4; ++j) r.v[j] = q[64 * j]; return r; }
__device__ __forceinline__ void st_row(float* p, int lane, const RowVec& r) { GAS f32x4* q = (GAS f32x4*)p + lane;
#pragma unroll
    for (int j = 0; j < 4; ++j) q[64 * j] = r.v[j]; }
__device__ __forceinline__ RowVec ld_row_bf16(const bf16* p, int lane) { RowVec r; const GAS v2u* q = (const GAS v2u*)p + lane;
#pragma unroll
    for (int j = 0; j < 4; ++j) { const v2u w = q[64 * j]; r.v[j] = (f32x4){bf2f(w.x & 0xffffu), bf2f(w.x >> 16), bf2f(w.y & 0xffffu), bf2f(w.y >> 16)}; } return r; }
struct RawRow { v2u w[4]; };
__device__ __forceinline__ RawRow ld_raw(const bf16* p, int lane) { RawRow r; const GAS v2u* q = (const GAS v2u*)p + lane;
#pragma unroll
    for (int j = 0; j < 4; ++j) r.w[j] = q[64 * j]; return r; }
__device__ __forceinline__ RowVec cvt_raw(const RawRow& a) { RowVec r;
#pragma unroll
    for (int j = 0; j < 4; ++j) r.v[j] = (f32x4){bf2f(a.w[j].x & 0xffffu), bf2f(a.w[j].x >> 16), bf2f(a.w[j].y & 0xffffu), bf2f(a.w[j].y >> 16)}; return r; }
__device__ __forceinline__ void st_row_bf16(bf16* p, int lane, const RowVec& r) { GAS v2u* q = (GAS v2u*)p + lane;
#pragma unroll
    for (int j = 0; j < 4; ++j) { v2u w; w.x = pk2(r.v[j].x, r.v[j].y); w.y = pk2(r.v[j].z, r.v[j].w); q[64 * j] = w; } }
__device__ __forceinline__ float row_ss(const RowVec& r) { float s = 0.f;
#pragma unroll
    for (int j = 0; j < 4; ++j) s += (r.v[j].x * r.v[j].x + r.v[j].y * r.v[j].y) + (r.v[j].z * r.v[j].z + r.v[j].w * r.v[j].w);
    return wave_sum(s); }
__device__ __forceinline__ void ld_mod(const float* gain, const float* scale, const float* shift, int lane, RowVec& gm, RowVec& sh) {
    const RowVec g = ld_row(gain, lane), s = ld_row(scale, lane); sh = ld_row(shift, lane);
#pragma unroll
    for (int j = 0; j < 4; ++j) gm.v[j] = g.v[j] * (s.v[j] + 1.0f);
}
__device__ __forceinline__ bf16* xres(Frame& F, int which) { return which == 1 ? (bf16*)((unsigned char*)F.out + 64 * MiB) : which == 2 ? (bf16*)F.out : (bf16*)(F.ws + WS_X3); }
__device__ __forceinline__ const float* modp(Frame& F, int l, int r, int chunk) { return (const float*)(F.ws + WS_MOD) + (size_t)(l * 9 + r) * 6144 + chunk * 1024; }

__device__ __forceinline__ void p1_phase(const Args& A, Frame& F) {
    const int gw = F.vcu * NWAVES + F.wave, NGW = F.G * NWAVES;
    const int NLB = F.G - 16;
    { const int row = 8 * F.vcu + F.wave; RowVec gm, sh; ld_mod(A.in[I_NMIX], modp(F, 0, 8, 1), modp(F, 0, 8, 0), F.lane, gm, sh);
      RowVec x = ld_row(A.in[I_CTX] + (size_t)row * DM, F.lane); const float rstd = rsqrtf(row_ss(x) * (1.0f / DM) + EPS);
#pragma unroll
      for (int j = 0; j < 4; ++j) x.v[j] = x.v[j] * rstd * gm.v[j] + sh.v[j];
      st_row_bf16((bf16*)(F.ws + WS_XNC) + (size_t)row * DM, F.lane, x);
      VM_WAIT(); __syncthreads();
      if (F.tid == 0) { __builtin_amdgcn_fence(__ATOMIC_RELEASE, "agent"); VM_WAIT(); __hip_atomic_fetch_add((unsigned*)(F.ctl + CW_CTX) + 64 * (F.vcu >> 5), 1u, RLX_AGENT); } }
    if (F.vcu < NLB) for (int it = gw; it < NT_TOK / 16; it += NLB * NWAVES) { const int t0 = it * 16, b = t0 / SEQ; RowVec gm, sh; ld_mod(A.in[I_NMIX], modp(F, 0, b, 1), modp(F, 0, b, 0), F.lane, gm, sh);
        for (int r = 0; r < 16; r += 4) { RowVec x[4];
#pragma unroll
            for (int q = 0; q < 4; ++q) x[q] = ld_row(A.in[I_X] + (size_t)(t0 + r + q) * DM, F.lane);
#pragma unroll
            for (int q = 0; q < 4; ++q) { const float rstd = rsqrtf(row_ss(x[q]) * (1.0f / DM) + EPS);
#pragma unroll
                for (int j = 0; j < 4; ++j) x[q].v[j] = x[q].v[j] * rstd * gm.v[j] + sh.v[j];
                st_row_bf16((bf16*)(F.ws + WS_XN) + (size_t)(t0 + r + q) * DM, F.lane, x[q]); } } }
    for (int it = gw; it < 2 * 8 * 48; it += NGW) { const int l = it / 384, b = (it / 48) % 8, c = it % 48;
        bf16* hi = (bf16*)(F.ws + WS_RW) + ((size_t)((l * 8 + b) * 2 + 0) * 48 + c) * 1024; bf16* lo = hi + 48 * 1024;
        const float* gain = A.in[I_NFFN] + l * 1024; const float* sc2 = modp(F, l, b, 4); const float* sh2 = modp(F, l, b, 3);
        float bs = 0.f;
        for (int j = 0; j < 16; ++j) { const int k = F.lane + 64 * j; float w = 0.f;
            if (c < 4) w = A.in[I_WRG][(size_t)l * 1024 * 4 + k * 4 + c]; else if (c < 36) w = A.in[I_WRE][(size_t)l * 1024 * 32 + k * 32 + (c - 4)];
            const float wp = gain[k] * (1.0f + sc2[k]) * w; const unsigned h = f2bf(wp); hi[k] = (bf16)h; lo[k] = (bf16)f2bf(wp - bf2f(h)); bs += sh2[k] * w; }
        bs = wave_sum(bs);
        if (F.lane == 0) { float br = 0.f; if (c < 4) br = A.in[I_BRG][l * 4 + c]; else if (c < 36) br = A.in[I_BRE][l * 32 + (c - 4)]; ((float*)(F.ws + WS_RBIAS))[(l * 8 + b) * 48 + c] = bs + br; } }
}


using pg8::Unit; using pg8::perm32;
template <bool PERM> struct ProbStd {
    static constexpr bool GATHER = false; static constexpr int tab_off = 0;
    int nt; const char* A; const char* B; int lda2, ldb2;
    __device__ __forceinline__ const char* a_unit(const Unit& u) const { return A + (size_t)u.pm * 256 * lda2; }
    __device__ __forceinline__ size_t a_hstep() const { return (size_t)128 * lda2; }
    __device__ __forceinline__ size_t a_kt(int t) const { return (size_t)t * 128; }
    __device__ __forceinline__ unsigned a_voff(int R, int C) const { return (unsigned)(R * lda2 + C * 2); }
    __device__ __forceinline__ const char* b_unit(const Unit& u) const { return B + (size_t)u.pn * 256 * ldb2; }
    __device__ __forceinline__ size_t b_hstep() const { return (size_t)128 * ldb2; }
    __device__ __forceinline__ size_t b_kt(int t) const { return (size_t)t * 128; }
    __device__ __forceinline__ unsigned b_voff(int R, int C) const { const int Rb = PERM ? ((R & ~31) + perm32(R & 31)) : R; return (unsigned)(Rb * ldb2 + C * 2); }
};
struct ProbQKV {
    static constexpr bool GATHER = false; static constexpr int tab_off = 0;
    int nt; const char* XN; const char* XNC; const char* W;
    __device__ __forceinline__ const char* a_unit(const Unit& u) const { return XN + (size_t)u.e * (size_t)(WS_XNC - WS_XN) + (size_t)u.pm * 256 * 2048; }
    __device__ __forceinline__ size_t a_hstep() const { return (size_t)128 * 2048; }
    __device__ __forceinline__ size_t a_kt(int t) const { return (size_t)t * 128; }
    __device__ __forceinline__ unsigned a_voff(int R, int C) const { return (unsigned)(R * 2048 + C * 2); }
    __device__ __forceinline__ const char* b_unit(const Unit& u) const { return W + (size_t)u.pn * 256 * 2048; }
    __device__ __forceinline__ size_t b_hstep() const { return (size_t)32 * 2048; }
    __device__ __forceinline__ size_t b_kt(int t) const { return (size_t)t * 128; }
    __device__ __forceinline__ unsigned b_voff(int R, int C) const { return (unsigned)((64 * (R >> 5) + (R & 31)) * 2048 + C * 2); }
};
struct ProbUp {
    static constexpr bool GATHER = true; static constexpr int tab_off = GTAB_OFF;
    int nt; const char* XN; const char* W;
    __device__ __forceinline__ const char* a_unit(const Unit&) const { return XN; }
    __device__ __forceinline__ size_t a_hstep() const { return 0; }
    __device__ __forceinline__ size_t a_kt(int t) const { return (size_t)t * 128; }
    __device__ __forceinline__ unsigned a_voff(int, int) const { return 0u; }
    __device__ __forceinline__ const char* b_unit(const Unit& u) const { return W + ((size_t)u.e * 1024 + 128 * u.pn) * 2048; }
    __device__ __forceinline__ size_t b_hstep() const { return (size_t)512 * 2048; }
    __device__ __forceinline__ size_t b_kt(int t) const { return (size_t)t * 128; }
    __device__ __forceinline__ unsigned b_voff(int R, int C) const { const int Rb = (R & ~31) + perm32(R & 31); return (unsigned)(Rb * 2048 + C * 2); }
};
struct ProbDown {
    static constexpr bool GATHER = false; static constexpr int tab_off = 0;
    int nt; const char* H1; const char* W;
    __device__ __forceinline__ const char* a_unit(const Unit& u) const { return H1 + (size_t)u.rb * 1024; }
    __device__ __forceinline__ size_t a_hstep() const { return (size_t)128 * 1024; }
    __device__ __forceinline__ size_t a_kt(int t) const { return (size_t)t * 128; }
    __device__ __forceinline__ unsigned a_voff(int R, int C) const { return (unsigned)(R * 1024 + C * 2); }
    __device__ __forceinline__ const char* b_unit(const Unit& u) const { return W + ((size_t)u.e * 1024 + 256 * u.pn) * 1024; }
    __device__ __forceinline__ size_t b_hstep() const { return (size_t)128 * 1024; }
    __device__ __forceinline__ size_t b_kt(int t) const { return (size_t)t * 128; }
    __device__ __forceinline__ unsigned b_voff(int R, int C) const { const int Rb = (R & ~31) + perm32(R & 31); return (unsigned)(Rb * 1024 + C * 2); }
};
struct ProbC {
    static constexpr bool GATHER = false; static constexpr int tab_off = 0;
    int nt; const char* ZT; const char* DC;
    __device__ __forceinline__ const char* a_unit(const Unit& u) const { return ZT + (((size_t)(u.pm >> 4) * 8192 + (u.pm & 15) * 256) * 1024 + 256 * u.pn) * 2; }
    __device__ __forceinline__ size_t a_hstep() const { return (size_t)128 * 2048; }
    __device__ __forceinline__ size_t a_kt(int t) const { return (size_t)(t & 3) * 128 + (size_t)(t >> 2) * ((size_t)4096 * 2048); }
    __device__ __forceinline__ unsigned a_voff(int R, int C) const { return (unsigned)(R * 2048 + C * 2); }
    __device__ __forceinline__ const char* b_unit(const Unit&) const { return DC; }
    __device__ __forceinline__ size_t b_hstep() const { return (size_t)128 * 1024; }
    __device__ __forceinline__ size_t b_kt(int t) const { return (size_t)t * 128; }
    __device__ __forceinline__ unsigned b_voff(int R, int C) const { const int Rb = (R & ~31) + perm32(R & 31); return (unsigned)(Rb * 1024 + C * 2); }
};

struct SchedOne {
    Unit u0;
    __device__ __forceinline__ bool next(int i, Unit& u) const { if (i != 0) return false; u = u0; return true; }
};
struct GroupedOrder {
    const LAS int* ts; int G, c, layer;
    __device__ __forceinline__ bool next(int i, Unit& u) const {
        const int nrt = ts[32], nwg = nrt * 4; const int L = i * G + c; if (L >= nwg) return false;
        const int wgid = pg8::xcd_remap(L, nwg); const int rt = wgid >> 2;
        int e = 0;
#pragma unroll 1
        for (int j = 1; j < 32; ++j) if (ts[j] <= rt) e = j;
        e = __builtin_amdgcn_readfirstlane(e);
        u.pm = __builtin_amdgcn_readfirstlane(rt); u.pn = __builtin_amdgcn_readfirstlane(wgid & 3); u.e = layer * 32 + e;
        u.r0 = __builtin_amdgcn_readfirstlane((rt - ts[e]) * 256); u.cnt = __builtin_amdgcn_readfirstlane(ts[33 + e]); u.rb = u.pm * 256; u.ui = i; return true;
    }
};

typedef pg8::f32x4 (AccT)[2][2][4][2];
struct EpiQKV {
    bf16* Q; bf16* K; bf16* V; const float* qn; const float* kn; const LAS float* rope;
    __device__ __forceinline__ void operator()(const AccT& acc, const Unit& u, int wr, int wc, int fr, int fq) const {
        const int pn = u.pn; const bool ctx = u.e != 0;
        f32x4 gv[2][2];
        if (pn != 5) { const float* g = (pn == 4) ? kn : qn;
#pragma unroll
            for (int bj = 0; bj < 2; ++bj)
#pragma unroll
                for (int n = 0; n < 2; ++n) gv[bj][n] = *(const f32x4*)(g + 32 * bj + 16 * n + 4 * fq); }
#pragma unroll
        for (int ai = 0; ai < 2; ++ai)
#pragma unroll
            for (int m = 0; m < 4; ++m) {
                const int row = 128 * ai + 64 * wr + 16 * m + fr; const int tok = u.pm * 256 + row; const int pos = tok & (SEQ - 1);
                const size_t krow = ctx ? ((size_t)u.pm * LK + SEQ + row) : ((size_t)(tok >> 12) * LK + pos);
                f32x4 y[2][2];
#pragma unroll
                for (int bj = 0; bj < 2; ++bj)
#pragma unroll
                    for (int n = 0; n < 2; ++n) y[bj][n] = acc[ai][bj][m][n];
                if (pn != 5) {
                    float ss = 0.f;
#pragma unroll
                    for (int bj = 0; bj < 2; ++bj)
#pragma unroll
                        for (int n = 0; n < 2; ++n) ss += (y[bj][n].x * y[bj][n].x + y[bj][n].y * y[bj][n].y) + (y[bj][n].z * y[bj][n].z + y[bj][n].w * y[bj][n].w);
                    ss += __shfl_xor(ss, 16); ss += __shfl_xor(ss, 32);
                    const float rstd = rsqrtf(ss * (1.0f / 64.0f) + EPS);
#pragma unroll
                    for (int bj = 0; bj < 2; ++bj)
#pragma unroll
                        for (int n = 0; n < 2; ++n) y[bj][n] = y[bj][n] * rstd * gv[bj][n];
                    if (!ctx) {
                        const int pr[2] = {pos >> 6, pos & 63};
#pragma unroll
                        for (int bj = 0; bj < 2; ++bj) { const f32x4 cs = *(const LAS f32x4*)(rope + pr[bj] * 16 + 4 * fq), sn = *(const LAS f32x4*)(rope + 1024 + pr[bj] * 16 + 4 * fq);
                            const f32x4 a = y[bj][0], b2 = y[bj][1]; y[bj][0] = a * cs - b2 * sn; y[bj][1] = b2 * cs + a * sn; }
                    }
                }
                bf16* dst;
                if (pn < 4) { dst = Q + (size_t)tok * 1024 + (4 * pn + wc) * 64;
#pragma unroll
                    for (int bj = 0; bj < 2; ++bj)
#pragma unroll
                        for (int n = 0; n < 2; ++n) y[bj][n] = y[bj][n] * attn_body::C2; }
                else dst = ((pn == 4) ? K : V) + krow * KVP + wc * 64;
#pragma unroll
                for (int bj = 0; bj < 2; ++bj)
#pragma unroll
                    for (int n = 0; n < 2; ++n) { v2u w; w.x = pg8::cvt_pk_bf16(y[bj][n].x, y[bj][n].y); w.y = pg8::cvt_pk_bf16(y[bj][n].z, y[bj][n].w); *(v2u*)(dst + 32 * bj + 16 * n + 4 * fq) = w; }
                asm volatile("" ::: "memory");
            }
    }
};
__device__ __forceinline__ v4u pack8(const f32x4& a, const f32x4& b) { v4u w; w.x = pg8::cvt_pk_bf16(a.x, a.y); w.y = pg8::cvt_pk_bf16(a.z, a.w); w.z = pg8::cvt_pk_bf16(b.x, b.y); w.w = pg8::cvt_pk_bf16(b.z, b.w); return w; }
template <bool BASE_F32> struct EpiResid {
    const void* base; bf16* out; const float* gate;
    __device__ __forceinline__ void operator()(const AccT& acc, const Unit& u, int wr, int wc, int fr, int fq) const {
        const int b = (u.pm * 256) >> 12; const int col0 = u.pn * 256 + wc * 32 + 8 * fq; const float* g = gate + b * 6144 + col0;
        f32x4 gv[2][2];
#pragma unroll
        for (int bj = 0; bj < 2; ++bj)
#pragma unroll
            for (int n = 0; n < 2; ++n) gv[bj][n] = *(const f32x4*)(g + bj * 128 + n * 4);
#pragma unroll
        for (int ai = 0; ai < 2; ++ai)
#pragma unroll
            for (int m = 0; m < 4; ++m) { const size_t off = (size_t)(u.pm * 256 + ai * 128 + wr * 64 + m * 16 + fr) * 1024 + col0;
#pragma unroll
                for (int bj = 0; bj < 2; ++bj) { f32x4 b0, b1;
                    if constexpr (BASE_F32) { b0 = *(const f32x4*)((const float*)base + off + bj * 128); b1 = *(const f32x4*)((const float*)base + off + bj * 128 + 4); }
                    else { const v4u w = *(const v4u*)((const bf16*)base + off + bj * 128); b0 = (f32x4){bf2f(w.x & 0xffffu), bf2f(w.x >> 16), bf2f(w.y & 0xffffu), bf2f(w.y >> 16)}; b1 = (f32x4){bf2f(w.z & 0xffffu), bf2f(w.z >> 16), bf2f(w.w & 0xffffu), bf2f(w.w >> 16)}; }
                    *(v4u*)(out + off + bj * 128) = pack8(b0 + gv[bj][0] * acc[ai][bj][m][0], b1 + gv[bj][1] * acc[ai][bj][m][1]); } }
    }
};
struct EpiUp {
    bf16* H1;
    __device__ __forceinline__ void operator()(const AccT& acc, const Unit& u, int wr, int wc, int fr, int fq) const {
#pragma unroll
        for (int ai = 0; ai < 2; ++ai)
#pragma unroll
            for (int m = 0; m < 4; ++m) { f32x4 h[2];
#pragma unroll
                for (int n = 0; n < 2; ++n) { const f32x4 a = acc[ai][0][m][n], b = acc[ai][1][m][n];
#pragma unroll
                    for (int i = 0; i < 4; ++i) h[n][i] = a[i] * __builtin_amdgcn_rcpf(1.0f + __builtin_amdgcn_exp2f(-1.4426950408889634f * a[i])) * b[i]; }
                *(v4u*)(H1 + (size_t)(u.rb + 128 * ai + 64 * wr + 16 * m + fr) * 512 + 128 * u.pn + 32 * wc + 8 * fq) = pack8(h[0], h[1]); }
    }
};
struct EpiDown {
    bf16* Y; const int* list; const float* gate;
    __device__ __forceinline__ void operator()(const AccT& acc, const Unit& u, int wr, int wc, int fr, int fq) const {
        const int* le = list + (size_t)(u.e & 31) * NT_TOK;
        int a[8]; float g[8];
#pragma unroll
        for (int q = 0; q < 8; ++q) { const int ridx = u.r0 + 128 * (q >> 2) + 64 * wr + 16 * (q & 3) + fr; a[q] = le[ridx < u.cnt ? ridx : 0]; if (ridx >= u.cnt) a[q] = -1; }
#pragma unroll
        for (int q = 0; q < 8; ++q) g[q] = gate[a[q] < 0 ? 0 : a[q]];
#pragma unroll
        for (int q = 0; q < 8; ++q) if (a[q] >= 0) { bf16* dst = Y + (size_t)a[q] * 1024 + 256 * u.pn + 32 * wc + 8 * fq;
#pragma unroll
            for (int bj = 0; bj < 2; ++bj) *(v4u*)(dst + 128 * bj) = pack8(acc[q >> 2][bj][q & 3][0] * g[q], acc[q >> 2][bj][q & 3][1] * g[q]); }
    }
};
struct EpiS {
    bf16* ZT;
    __device__ __forceinline__ void operator()(const AccT& acc, const Unit& u, int wr, int wc, int fr, int fq) const {
#pragma unroll
        for (int ai = 0; ai < 2; ++ai)
#pragma unroll
            for (int m = 0; m < 4; ++m) { const int kp = u.pm * 256 + 128 * ai + 64 * wr + 16 * m + fr;
#pragma unroll
                for (int bj = 0; bj < 2; ++bj) { const int col = u.pn * 256 + 128 * bj + 32 * wc + 8 * fq; const int b = col >> 10, c = col & 1023;
                    *(v4u*)(ZT + ((size_t)b * 8192 + kp) * 1024 + c) = pack8(acc[ai][bj][m][0], acc[ai][bj][m][1]); } }
    }
};
struct EpiC {
    bf16* Fm;
    __device__ __forceinline__ void operator()(const AccT& acc, const Unit& u, int wr, int wc, int fr, int fq) const {
#pragma unroll
        for (int ai = 0; ai < 2; ++ai)
#pragma unroll
            for (int m = 0; m < 4; ++m) { bf16* dst = Fm + (size_t)(u.pm * 256 + 128 * ai + 64 * wr + 16 * m + fr) * 1024 + u.pn * 256 + 32 * wc + 8 * fq;
#pragma unroll
                for (int bj = 0; bj < 2; ++bj) *(v4u*)(dst + 128 * bj) = pack8(acc[ai][bj][m][0], acc[ai][bj][m][1]); }
    }
};

__device__ __forceinline__ void moe_in_phase(const Args& A, Frame& F, int l) {
    const bf16* X = xres(F, l == 0 ? 1 : 3);
    LAS unsigned* hist = (LAS unsigned*)(F.lds + HIST_OFF); LAS unsigned* hbase = hist + 32;
    unsigned* cnt = (unsigned*)(F.ctl + CW_CNT) + l * 32;
    int* list = (int*)(F.ws + WS_LIST); float* gate = (float*)(F.ws + WS_GATE);
    for (int blk = F.vcu; blk < NT_TOK / 128; blk += F.G) {
        const int tokb = blk * 128, tok0 = tokb + F.wave * 16, b = tokb / SEQ;
        if (F.tid < 32) hist[F.tid] = 0u;
        __syncthreads();
        const int ti = F.lane & 15, kq = F.lane >> 4;
        const bf16* xr = X + (size_t)(tok0 + ti) * DM + 8 * kq;
        const bf16* wh = (const bf16*)(F.ws + WS_RW) + (size_t)((l * 8 + b) * 2) * 48 * 1024 + (size_t)ti * 1024 + 8 * kq;
        const bf16* wl = wh + 48 * 1024;
        f32x4 acc[3]; acc[0] = (f32x4){0.f, 0.f, 0.f, 0.f}; acc[1] = acc[0]; acc[2] = acc[0];
        float ss = 0.f;
#pragma unroll 2
        for (int s = 0; s < 32; ++s) {
            const v4u h = *(const GAS v4u*)(xr + 32 * s);
            { const float a0 = bf2f(h.x & 0xffffu), a1 = bf2f(h.x >> 16), a2 = bf2f(h.y & 0xffffu), a3 = bf2f(h.y >> 16), a4 = bf2f(h.z & 0xffffu), a5 = bf2f(h.z >> 16), a6 = bf2f(h.w & 0xffffu), a7 = bf2f(h.w >> 16);
              ss += (a0 * a0 + a1 * a1) + (a2 * a2 + a3 * a3) + (a4 * a4 + a5 * a5) + (a6 * a6 + a7 * a7); }
            const bf16x8 ah = __builtin_bit_cast(bf16x8, h);
#pragma unroll
            for (int cb = 0; cb < 3; ++cb) { const bf16x8 bh = *(const GAS bf16x8*)(wh + cb * 16 * 1024 + 32 * s), bl = *(const GAS bf16x8*)(wl + cb * 16 * 1024 + 32 * s);
                acc[cb] = __builtin_amdgcn_mfma_f32_16x16x32_bf16(ah, bh, acc[cb], 0, 0, 0);
                acc[cb] = __builtin_amdgcn_mfma_f32_16x16x32_bf16(ah, bl, acc[cb], 0, 0, 0); }
        }
        ss += __shfl_xor(ss, 16); ss += __shfl_xor(ss, 32);
        LAS float* scr = (LAS float*)(F.lds + F.wave * 16384);
#pragma unroll
        for (int cb = 0; cb < 3; ++cb)
#pragma unroll
            for (int r = 0; r < 4; ++r) scr[(4 * kq + r) * 49 + 16 * cb + ti] = acc[cb][r];
        if (kq == 0) scr[16 * 49 + ti] = rsqrtf(ss * (1.0f / DM) + EPS);
        LDS_WAIT(); asm volatile("" ::: "memory");
        int e0 = 0, e1 = 0; unsigned rk0 = 0, rk1 = 0; float w0 = 0.f, w1 = 0.f;
        if (F.lane < 16) {
            const float rstd = scr[16 * 49 + F.lane]; const float* bias = (const float*)(F.ws + WS_RBIAS) + (l * 8 + b) * 48; const LAS float* raw = scr + F.lane * 49;
            float lg[4];
#pragma unroll
            for (int g = 0; g < 4; ++g) lg[g] = rstd * raw[g] + bias[g];
            int gs = 0; float mx = lg[0];
#pragma unroll
            for (int g = 1; g < 4; ++g) if (lg[g] > mx) { mx = lg[g]; gs = g; }
            float den = 0.f;
#pragma unroll
            for (int g = 0; g < 4; ++g) den += __expf(lg[g] - mx);
            const float pgrp = 1.0f / den;
            float le[8];
#pragma unroll
            for (int j = 0; j < 8; ++j) le[j] = rstd * raw[4 + gs * 8 + j] + bias[4 + gs * 8 + j];
            int i0 = 0; float m0 = le[0];
#pragma unroll
            for (int j = 1; j < 8; ++j) if (le[j] > m0) { m0 = le[j]; i0 = j; }
            int i1 = -1; float m1 = -INFINITY;
#pragma unroll
            for (int j = 0; j < 8; ++j) if (j != i0 && le[j] > m1) { m1 = le[j]; i1 = j; }
            const float d = __expf(m1 - m0); w0 = pgrp / (1.0f + d); w1 = pgrp * d / (1.0f + d);
            e0 = gs * 8 + i0; e1 = gs * 8 + i1;
            rk0 = __hip_atomic_fetch_add(hist + e0, 1u, __ATOMIC_RELAXED, __HIP_MEMORY_SCOPE_WORKGROUP);
            rk1 = __hip_atomic_fetch_add(hist + e1, 1u, __ATOMIC_RELAXED, __HIP_MEMORY_SCOPE_WORKGROUP);
        }
        __syncthreads();
        if (F.tid < 32) hbase[F.tid] = __hip_atomic_fetch_add(cnt + F.tid, hist[F.tid], __ATOMIC_RELAXED, __HIP_MEMORY_SCOPE_AGENT);
        __syncthreads();
        if (F.lane < 16) { const int t = tok0 + F.lane;
            list[(size_t)e0 * NT_TOK + hbase[e0] + rk0] = 2 * t; list[(size_t)e1 * NT_TOK + hbase[e1] + rk1] = 2 * t + 1;
            gate[2 * t] = w0; gate[2 * t + 1] = w1; }
        RowVec gm, sh; ld_mod(A.in[I_NFFN] + l * 1024, modp(F, l, b, 4), modp(F, l, b, 3), F.lane, gm, sh);
        for (int r = 0; r < 16; r += 4) { RawRow xr4[4];
#pragma unroll
            for (int q = 0; q < 4; ++q) xr4[q] = ld_raw(X + (size_t)(tok0 + r + q) * DM, F.lane);
#pragma unroll
            for (int q = 0; q < 4; ++q) { RowVec x = cvt_raw(xr4[q]); const float rstd = scr[16 * 49 + r + q];
#pragma unroll
                for (int j = 0; j < 4; ++j) x.v[j] = x.v[j] * rstd * gm.v[j] + sh.v[j];
                st_row_bf16((bf16*)(F.ws + WS_XN) + (size_t)(tok0 + r + q) * DM, F.lane, x); } }
        __syncthreads();
    }
}

__device__ __forceinline__ void grouped_setup(Frame& F, int l, bool with_tab) {
    LAS int* ts = (LAS int*)(F.lds + TS_OFF);
    const unsigned* cnt = (const unsigned*)(F.ctl + CW_CNT) + l * 32;
    if (F.tid < 32) ts[33 + F.tid] = (int)__hip_atomic_load(cnt + F.tid, __ATOMIC_RELAXED, __HIP_MEMORY_SCOPE_AGENT);
    __syncthreads();
    if (F.tid == 0) { int s = 0; for (int e = 0; e < 32; ++e) { ts[e] = s; s += (ts[33 + e] + 255) >> 8; } ts[32] = s; }
    __syncthreads();
    {
        GroupedOrder S{(const LAS int*)ts, F.G, (int)blockIdx.x, l}; Unit u;
        const int* list = (const int*)(F.ws + WS_LIST); const float* gate = (const float*)(F.ws + WS_GATE);
        for (int i = 0; i < 5; ++i) { if (!S.next(i, u)) break;
            if (F.tid < 256) { const int ridx = u.r0 + F.tid; int a = -1; if (ridx < u.cnt) a = list[(size_t)(u.e & 31) * NT_TOK + ridx];
                if (with_tab) ((LAS unsigned*)(F.lds + GTAB_OFF))[i * 256 + F.tid] = (unsigned)((a < 0 ? 0 : a) >> 1) * 2048u;
                else { v2u ag; ag.x = (unsigned)a; ag.y = (a < 0) ? 0u : __builtin_bit_cast(unsigned, gate[a]); ((LAS v2u*)(F.lds + GTAB_OFF))[i * 256 + F.tid] = ag; } } }
        __syncthreads();
    }
}

__device__ __forceinline__ void p8_phase(const Args& A, Frame& F) {
    LAS unsigned char* tile = F.lds;
    const bf16* Y = (const bf16*)(F.ws + WS_Y); bf16* hT = (bf16*)(F.ws + WS_XN);
    for (int it = F.vcu; it < NT_TOK / 32; it += F.G) {
        const int b = it >> 7, rr = (it >> 1) & 63, qh = it & 1;
        const RowVec g2 = ld_row(modp(F, 0, b, 5), F.lane); RowVec gm, sh; ld_mod(A.in[I_NMIX] + 1024, modp(F, 1, b, 1), modp(F, 1, b, 0), F.lane, gm, sh);
        RawRow xr4[4], ya[4], yb[4];
#pragma unroll
        for (int q = 0; q < 4; ++q) { const int r = F.wave * 4 + q; const size_t t = (size_t)b * SEQ + 64 * (32 * qh + r) + rr; xr4[q] = ld_raw(xres(F, 1) + t * DM, F.lane); ya[q] = ld_raw(Y + (2 * t) * DM, F.lane); yb[q] = ld_raw(Y + (2 * t + 1) * DM, F.lane); }
#pragma unroll
        for (int q = 0; q < 4; ++q) { const int r = F.wave * 4 + q; const size_t t = (size_t)b * SEQ + 64 * (32 * qh + r) + rr;
            RowVec x = cvt_raw(xr4[q]); const RowVec y0 = cvt_raw(ya[q]), y1 = cvt_raw(yb[q]);
#pragma unroll
            for (int j = 0; j < 4; ++j) x.v[j] = x.v[j] + g2.v[j] * (y0.v[j] + y1.v[j]);
            st_row_bf16(xres(F, 2) + t * DM, F.lane, x);
            const float rstd = rsqrtf(row_ss(x) * (1.0f / DM) + EPS);
#pragma unroll
            for (int j = 0; j < 4; ++j) { const f32x4 h = x.v[j] * rstd * gm.v[j] + sh.v[j]; v2u w; w.x = pk2(h.x, h.y); w.y = pk2(h.z, h.w); *(LAS v2u*)(tile + r * 2056 + 8 * F.lane + 512 * j) = w; } }
        __syncthreads();
        const int tg = F.lane & 3;
        for (int ic = 0; ic < 8; ++ic) { const int c = 128 * F.wave + 16 * ic + (F.lane >> 2); unsigned e[8];
#pragma unroll
            for (int i = 0; i < 8; ++i) e[i] = *(const LAS unsigned short*)(tile + (8 * tg + i) * 2056 + 2 * c);
            v4u o; o.x = e[0] | (e[1] << 16); o.y = e[2] | (e[3] << 16); o.z = e[4] | (e[5] << 16); o.w = e[6] | (e[7] << 16);
            *(GAS v4u*)(hT + ((size_t)(b * 1024 + c) * 4096 + rr * 64 + 32 * qh + 8 * tg)) = o; }
        __syncthreads();
    }
}

__device__ __forceinline__ void final_phase(const Args& A, Frame& F) {
    const int gw = F.vcu * NWAVES + F.wave, NGW = F.G * NWAVES; const bf16* Y = (const bf16*)(F.ws + WS_Y);
    const RowVec fn = ld_row(A.in[I_FN], F.lane);
    for (int it = gw; it < NT_TOK / 16; it += NGW) { const int t0 = it * 16, b = t0 / SEQ; const RowVec g2 = ld_row(modp(F, 1, b, 5), F.lane);
        for (int r = 0; r < 16; r += 4) { RawRow xr4[4], ya[4], yb[4];
#pragma unroll
            for (int q = 0; q < 4; ++q) { const size_t t = (size_t)t0 + r + q; xr4[q] = ld_raw(xres(F, 3) + t * DM, F.lane); ya[q] = ld_raw(Y + (2 * t) * DM, F.lane); yb[q] = ld_raw(Y + (2 * t + 1) * DM, F.lane); }
#pragma unroll
            for (int q = 0; q < 4; ++q) { const size_t t = (size_t)t0 + r + q; RowVec x = cvt_raw(xr4[q]); const RowVec y0 = cvt_raw(ya[q]), y1 = cvt_raw(yb[q]);
#pragma unroll
                for (int j = 0; j < 4; ++j) x.v[j] = x.v[j] + g2.v[j] * (y0.v[j] + y1.v[j]);
                const float rstd = rsqrtf(row_ss(x) * (1.0f / DM) + EPS);
#pragma unroll
                for (int j = 0; j < 4; ++j) x.v[j] = x.v[j] * rstd * fn.v[j];
                st_row(F.out + t * DM, F.lane, x); } } }
}

typedef float f32x16 __attribute__((ext_vector_type(16)));
__device__ __forceinline__ void fft_cos_table(Frame& F, LAS float* tab) {
    for (int i = F.tid; i < 4096; i += NWAVES * 64) tab[i] = cospif((float)i * (1.0f / 2048.0f));
    __syncthreads();
}
__device__ __forceinline__ void fft_pass_a(Frame& F) {
    constexpr int TP = 272, TILE = 32 * TP, T0 = 8 * TILE;
    LAS float* tab = (LAS float*)F.lds; LAS float* twc = (LAS float*)(F.lds + T0); LAS float* tws = twc + 4096; LAS v4u* bfl = (LAS v4u*)(F.lds + T0 + 32768);
    fft_cos_table(F, tab);
    for (int i = F.tid; i < 4096; i += NWAVES * 64) { const int r = i >> 6, k1 = i & 63; twc[i] = tab[r * k1]; tws[i] = tab[(r * k1 - 1024) & 4095]; }
    for (int i = F.tid; i < 16 * 64; i += NWAVES * 64) { const int ln = i & 63, cb = (i >> 6) & 3, s = i >> 8, r32 = ln & 31, h = ln >> 5; float v[8];
        const int col = 32 * cb + r32, k1 = col & 63, cs = col >> 6;
#pragma unroll
        for (int jj = 0; jj < 8; ++jj) { const int k = 16 * s + 8 * h + jj; const int idx = (k * k1 * 64) & 4095; v[jj] = (cs ? -tab[(idx - 1024) & 4095] : tab[idx]) * 0.125f; }
        v4u o; o.x = pk2(v[0], v[1]); o.y = pk2(v[2], v[3]); o.z = pk2(v[4], v[5]); o.w = pk2(v[6], v[7]); bfl[i] = o; }
    __syncthreads();
    const int gw = F.vcu * NWAVES + F.wave, NGW = F.G * NWAVES, r32 = F.lane & 31, h = F.lane >> 5;
    const bf16* hP = (const bf16*)(F.ws + WS_XN); bf16* YP = (bf16*)(F.ws + WS_YP);
    LAS unsigned char* tile = F.lds + F.wave * TILE;
    for (int bc = gw; bc < NB * 1024; bc += NGW) { const int b = bc >> 10, c = bc & 1023;
        const bf16* arow = hP + (size_t)bc * 4096 + r32 * 64 + 8 * h;
        bf16x8 a[2][4];
#pragma unroll
        for (int rb = 0; rb < 2; ++rb)
#pragma unroll
            for (int s = 0; s < 4; ++s) a[rb][s] = *(const GAS bf16x8*)(arow + rb * 2048 + 16 * s);
#pragma unroll 1
        for (int kb = 0; kb < 2; ++kb) { const int k1 = r32 + 32 * kb;
#pragma unroll
            for (int rb = 0; rb < 2; ++rb) { f32x16 ar = (f32x16){}, ai = (f32x16){};
#pragma unroll
                for (int s = 0; s < 4; ++s) { ar = __builtin_amdgcn_mfma_f32_32x32x16_bf16(a[rb][s], __builtin_bit_cast(bf16x8, bfl[(s * 4 + kb) * 64 + F.lane]), ar, 0, 0, 0);
                                              ai = __builtin_amdgcn_mfma_f32_32x32x16_bf16(a[rb][s], __builtin_bit_cast(bf16x8, bfl[(s * 4 + 2 + kb) * 64 + F.lane]), ai, 0, 0, 0); }
#pragma unroll
                for (int g = 0; g < 4; ++g) { float yr[4], yi[4];
#pragma unroll
                    for (int i = 0; i < 4; ++i) { const int r = 32 * rb + i + 8 * g + 4 * h; const float cc = twc[r * 64 + k1], ss = tws[r * 64 + k1]; const float xr = ar[4 * g + i], xi = ai[4 * g + i];
                        yr[i] = xr * cc + xi * ss; yi[i] = xi * cc - xr * ss; }
                    v2u w; w.x = pk2(yr[0], yr[1]); w.y = pk2(yr[2], yr[3]); *(LAS v2u*)(tile + r32 * TP + (32 * rb + 8 * g + 4 * h) * 2) = w;
                    w.x = pk2(yi[0], yi[1]); w.y = pk2(yi[2], yi[3]); *(LAS v2u*)(tile + r32 * TP + 128 + (32 * rb + 8 * g + 4 * h) * 2) = w; } }
            LDS_WAIT(); asm volatile("" ::: "memory");
#pragma unroll
            for (int p = 0; p < 8; ++p) { const int row = 4 * p + (F.lane >> 4), ch = F.lane & 15; const v4u v = *(const LAS v4u*)(tile + row * TP + ch * 16);
                *(GAS v4u*)(YP + (((size_t)(b * 64 + 32 * kb + row) * 1024 + c) * 128) + ch * 8) = v; }
            LDS_WAIT(); asm volatile("" ::: "memory");
        }
    }
}
__device__ __forceinline__ void fft_pass_c(Frame& F) {
    constexpr int TP = 144, TILE = 64 * TP, T0 = 8 * TILE;
    LAS float* tab = (LAS float*)F.lds; LAS v4u* bfl = (LAS v4u*)(F.lds + T0);
    fft_cos_table(F, tab);
    for (int i = F.tid; i < 32 * 64; i += NWAVES * 64) { const int ln = i & 63, cb = (i >> 6) & 3, s = i >> 8, r32 = ln & 31, h = ln >> 5; float v[8];
        const int col = 32 * cb + r32, k2 = col & 63, cso = col >> 6;
#pragma unroll
        for (int jj = 0; jj < 8; ++jj) { const int k = 16 * s + 8 * h + jj, csi = k >> 6, r = k & 63; const int idx = (r * k2 * 64) & 4095; const float cv = tab[idx], sv = tab[(idx - 1024) & 4095];
            v[jj] = ((csi == cso) ? (csi ? -cv : cv) : sv) * 0.125f; }
        v4u o; o.x = pk2(v[0], v[1]); o.y = pk2(v[2], v[3]); o.z = pk2(v[4], v[5]); o.w = pk2(v[6], v[7]); bfl[i] = o; }
    __syncthreads();
    const int gw = F.vcu * NWAVES + F.wave, NGW = F.G * NWAVES, r32 = F.lane & 31, h = F.lane >> 5;
    const bf16* YP = (const bf16*)(F.ws + WS_YP); bf16* ZT = (bf16*)(F.ws + WS_ZT);
    LAS unsigned char* tile = F.lds + F.wave * TILE;
    for (int it = gw; it < NB * 64 * 16; it += NGW) { const int b = it >> 10, k1 = (it >> 4) & 63, g64 = it & 15;
        const bf16* arow = YP + (((size_t)(b * 64 + k1) * 1024 + 64 * g64 + r32) * 128) + 8 * h;
        bf16x8 a[2][8];
#pragma unroll
        for (int rb = 0; rb < 2; ++rb)
#pragma unroll
            for (int s = 0; s < 8; ++s) a[rb][s] = *(const GAS bf16x8*)(arow + rb * 4096 + 16 * s);
#pragma unroll 1
        for (int cso = 0; cso < 2; ++cso) {
#pragma unroll
            for (int cbl = 0; cbl < 2; ++cbl)
#pragma unroll
                for (int rb = 0; rb < 2; ++rb) { f32x16 acc = (f32x16){};
#pragma unroll
                    for (int s = 0; s < 8; ++s) acc = __builtin_amdgcn_mfma_f32_32x32x16_bf16(a[rb][s], __builtin_bit_cast(bf16x8, bfl[(s * 4 + 2 * cso + cbl) * 64 + F.lane]), acc, 0, 0, 0);
#pragma unroll
                    for (int g = 0; g < 4; ++g) { v2u w; w.x = pk2(acc[4 * g], acc[4 * g + 1]); w.y = pk2(acc[4 * g + 2], acc[4 * g + 3]); *(LAS v2u*)(tile + (32 * cbl + r32) * TP + (32 * rb + 8 * g + 4 * h) * 2) = w; } }
            LDS_WAIT(); asm volatile("" ::: "memory");
#pragma unroll
            for (int p = 0; p < 8; ++p) { const int row = 8 * p + (F.lane >> 3), ch = F.lane & 7; const v4u v = *(const LAS v4u*)(tile + row * TP + ch * 16);
                *(GAS v4u*)(ZT + ((size_t)b * 8192 + k1 + 64 * row + 4096 * cso) * 1024 + 64 * g64 + 8 * ch) = v; }
            LDS_WAIT(); asm volatile("" ::: "memory");
        }
    }
}

#ifndef PROBE_REP
#define PROBE_REP -1
#endif
template <int K> __device__ __forceinline__ void run_phase(const Args& A, Frame& F, unsigned char* lds, unsigned char* obuf) {
    unsigned char* ws = F.ws;
    constexpr int l = (K >= 13) ? 1 : 0;
    { int ln = threadIdx.x & 63; asm volatile("" : "+v"(ln)); F.lane = ln; }
    if constexpr (K == 0) p0_prologue(A, F);
    else if constexpr (K == 1) { p1_phase(A, F);
        if (F.vcu >= F.G - 16) { const int j = F.vcu - (F.G - 16);
            if (F.tid < 64) { unsigned* cw = (unsigned*)(F.ctl + CW_CTX) + 64 * (j >> 1); unsigned sp = 0;
                while ((unsigned)__builtin_amdgcn_readfirstlane(__hip_atomic_load(cw, RLX_AGENT)) < 32u) { __builtin_amdgcn_s_sleep(2); if (++sp > (1u << 22)) break; }
                __builtin_amdgcn_fence(__ATOMIC_ACQUIRE, "agent"); VM_WAIT(); }
            __syncthreads();
            ProbQKV P{16, (const char*)(ws + WS_XN), (const char*)(ws + WS_XNC), (const char*)(ws + WS_WQKV)};
            SchedOne S; S.u0.pm = j >> 1; S.u0.pn = 4 + (j & 1); S.u0.e = 1; S.u0.r0 = 0; S.u0.cnt = 0; S.u0.rb = 0; S.u0.ui = 0;
            EpiQKV E{(bf16*)(ws + WS_QO), (bf16*)(ws + WS_K), (bf16*)(ws + WS_V), A.in[I_QN], A.in[I_KN], (const LAS float*)(F.lds + GTAB_OFF)};
            pg8::gemm_phase<ProbQKV, EpiQKV, SchedOne, true>(F.lds + RING_OFF, P, S, E); } }
    else if constexpr (K == 2) { ProbQKV P{16, (const char*)(ws + WS_XN), (const char*)(ws + WS_XNC), (const char*)(ws + WS_WQKV)};
        pg8::StaticOrder S; S.init(NT_TOK / 256, QKVN / 256, F.G, (int)blockIdx.x);
        { LAS float* lr = (LAS float*)(F.lds + GTAB_OFF); const float* gr = (const float*)(ws + WS_ROPE); for (int i = F.tid; i < 2048; i += NWAVES * 64) lr[i] = gr[i]; __syncthreads(); }
        EpiQKV E{(bf16*)(ws + WS_QO), (bf16*)(ws + WS_K), (bf16*)(ws + WS_V), A.in[I_QN], A.in[I_KN], (const LAS float*)(F.lds + GTAB_OFF)};
        pg8::gemm_phase<ProbQKV, EpiQKV, pg8::StaticOrder, true>(F.lds + RING_OFF, P, S, E); }
    else if constexpr (K == 3) { const int x = F.vcu >> 5, j = F.vcu & 31;
        float mref; { float gq = fabsf(A.in[I_QN][F.lane]), gk = fabsf(A.in[I_KN][F.lane]);
#pragma unroll
            for (int o = 1; o < 64; o <<= 1) { gq = fmaxf(gq, __shfl_xor(gq, o)); gk = fmaxf(gk, __shfl_xor(gk, o)); }
            mref = 64.0f * attn_body::C2 * gq * gk * 1.0001f + 0.01f; }
        for (int i = 0; i < 8; ++i) { const int pair = 4 * x + (i >> 1), b = pair >> 2, kvh = pair & 3, un = (i & 1) * 32 + j, h = kvh * 4 + (un >> 4), qb = un & 15;
            const attn_body::bf16* Qu = (const attn_body::bf16*)(ws + WS_QO) + ((size_t)b * SEQ + qb * 256) * 1024 + h * 64;
            attn_body::attn_unit<LK / 64>(Qu, (const attn_body::bf16*)(ws + WS_K) + (size_t)b * LK * KVP + kvh * 64, (const attn_body::bf16*)(ws + WS_V) + (size_t)b * LK * KVP + kvh * 64,
                                              (attn_body::bf16*)(obuf) + ((size_t)b * SEQ + qb * 256) * 1024 + h * 64, (char*)lds + RING_OFF, mref); } }
    else if constexpr (K == 4) { ProbStd<true> P{16, (const char*)(ws + WS_QO), (const char*)(ws + WS_WO), 2048, 2048};
        pg8::StaticOrder S; S.init(NT_TOK / 256, 4, F.G, (int)blockIdx.x);
        EpiResid<true> E{A.in[I_X], xres(F, 1), modp(F, 0, 0, 2)};
        pg8::gemm_phase<ProbStd<true>, EpiResid<true>, pg8::StaticOrder, true>(F.lds + RING_OFF, P, S, E); }
    else if constexpr (K == 5 || K == 13) moe_in_phase(A, F, l);
    else if constexpr (K == 6 || K == 14) { grouped_setup(F, l, true);
        ProbUp P{16, (const char*)(ws + WS_XN), (const char*)(ws + WS_W13)};
        GroupedOrder S{(const LAS int*)(F.lds + TS_OFF), F.G, (int)blockIdx.x, l};
        EpiUp E{(bf16*)(ws + WS_H1)};
        pg8::gemm_phase<ProbUp, EpiUp, GroupedOrder, true>(F.lds + RING_OFF, P, S, E); }
    else if constexpr (K == 7 || K == 15) { grouped_setup(F, l, false);
        ProbDown P{8, (const char*)(ws + WS_H1), (const char*)(ws + WS_W2)};
        GroupedOrder S{(const LAS int*)(F.lds + TS_OFF), F.G, (int)blockIdx.x, l};
        EpiDown E{(bf16*)(ws + WS_Y), (const int*)(ws + WS_LIST), (const float*)(ws + WS_GATE)};
        pg8::gemm_phase<ProbDown, EpiDown, GroupedOrder, true>(F.lds + RING_OFF, P, S, E); }
    else if constexpr (K == 8) p8_phase(A, F);
    else if constexpr (K == 9) fft_pass_a(F);
    else if constexpr (K == 10) fft_pass_c(F);
    else if constexpr (K == 11) { ProbC P{8, (const char*)(ws + WS_ZT), (const char*)(ws + WS_DFTC)};
        pg8::StaticOrder S; S.init(NT_TOK / 256, 4, F.G, (int)blockIdx.x);
        EpiC E{(bf16*)(ws + WS_QO)};
        pg8::gemm_phase<ProbC, EpiC, pg8::StaticOrder, true>(F.lds + RING_OFF, P, S, E); }
    else if constexpr (K == 12) { ProbStd<true> P{16, (const char*)(ws + WS_QO), (const char*)(ws + WS_WF), 2048, 2048};
        pg8::StaticOrder S; S.init(NT_TOK / 256, 4, F.G, (int)blockIdx.x);
        EpiResid<false> E{xres(F, 2), xres(F, 3), modp(F, 1, 0, 2)};
        pg8::gemm_phase<ProbStd<true>, EpiResid<false>, pg8::StaticOrder, true>(F.lds + RING_OFF, P, S, E); }
    else if constexpr (K == 16) final_phase(A, F);
}

__global__ void __launch_bounds__(NWAVES * 64, 2) fwd_megakernel(Args args) {
    extern __shared__ __attribute__((aligned(16))) unsigned char lds[];
    Frame F;
    F.lds = (LAS unsigned char*)lds;
    F.MISC = (volatile LAS unsigned*)(F.lds + MISC_OFF);
    F.tid = threadIdx.x; F.lane = F.tid & 63; F.wave = __builtin_amdgcn_readfirstlane(F.tid >> 6);
    F.G = gridDim.x; { const int bx = blockIdx.x; F.vcu = (F.G % 8 == 0) ? (bx % 8) * (F.G / 8) + bx / 8 : bx; }
    F.ws = args.ws; F.out = args.out; F.ctl = (gu32*)(args.ws + WS_CTL);
    for (int u = F.tid; u < (LDS_BYTES - LDSCTL_OFF) / 4; u += NWAVES * 64) ((LAS unsigned*)(F.lds + LDSCTL_OFF))[u] = 0u;
    __syncthreads();
    XcdBarrier bar; bar.bar = (unsigned*)(F.ctl + CW_BAR); bar.x = 0; bar.st = nullptr;
    if (N_LAUNCHES == 1) bar = xcd_barrier_post((unsigned*)(F.ctl + CW_BAR), F.MISC + 8);
    const Args& A = args;
    const int lo = args.ph_lo, hi = args.ph_hi;
#define PH(k) do { if (PH_EN(k) && lo <= (k) && (k) < hi) { \
        if constexpr (PROBE_REP == (k)) { run_phase<k>(A, F, lds, args.ws + WS_XN); xcd_barrier(bar); } \
        run_phase<k>(A, F, lds, args.ws + WS_QO); } \
        if (lo <= (k) && (k) + 1 < hi) xcd_barrier(bar); } while (0)
    PH(0); PH(1); PH(2); PH(3); PH(4); PH(5); PH(6); PH(7); PH(8); PH(9); PH(10); PH(11); PH(12); PH(13); PH(14); PH(15); PH(16);
#undef PH
}

extern "C" void kernel_launch(void* const* d_in, const int* in_sizes, int n_in, void* d_out, int out_size, void* d_ws, size_t ws_size, hipStream_t stream) {
    static int grid = 0;
    if (grid == 0) {
        if (n_in != 21 || out_size != NT_TOK * DM || ws_size < WS_END) { fprintf(stderr, "kernel_launch: unexpected problem (n_in %d, out %d, ws %zu < %zu)\n", n_in, out_size, ws_size, (size_t)WS_END); grid = -1; return; }
        int dev = 0, cus = 0;
        if (hipGetDevice(&dev) != hipSuccess || hipDeviceGetAttribute(&cus, hipDeviceAttributeMultiprocessorCount, dev) != hipSuccess) { grid = -1; return; }
        if (hipFuncSetAttribute((const void*)fwd_megakernel, hipFuncAttributeMaxDynamicSharedMemorySize, LDS_BYTES) != hipSuccess) { fprintf(stderr, "kernel_launch: hipFuncSetAttribute failed\n"); grid = -1; return; }
        int per_cu = 0;
        if (hipOccupancyMaxActiveBlocksPerMultiprocessor(&per_cu, (const void*)fwd_megakernel, NWAVES * 64, LDS_BYTES) != hipSuccess || per_cu < 1) fprintf(stderr, "kernel_launch: occupancy query says %d\n", per_cu);
        (void)hipGetLastError();
        grid = 256;
        if (cus != 256) fprintf(stderr, "kernel_launch: device has %d CUs, kernel built for 256\n", cus);
    }
    if (grid < 0) return;
    (void)hipMemsetAsync((char*)d_ws + WS_CTL, 0, CTL_ZERO_BYTES, stream);
    Args a{};
    for (int i = 0; i < 21; ++i) a.in[i] = (const float*)d_in[i];
    a.out = (float*)d_out; a.ws = (unsigned char*)d_ws;
    if (N_LAUNCHES == 1) { a.ph_lo = 0; a.ph_hi = N_PHASES; hipLaunchKernelGGL(fwd_megakernel, dim3(grid), dim3(NWAVES * 64), LDS_BYTES, stream, a); }
    else for (int p = 0; p < N_PHASES; ++p) { a.ph_lo = p; a.ph_hi = p + 1; hipLaunchKernelGGL(fwd_megakernel, dim3(grid), dim3(NWAVES * 64), LDS_BYTES, stream, a); }
}
```

```cpp
#include <hip/hip_runtime.h>
#include <hip/hip_bf16.h>
#include <cstdio>
#include <cstdint>
#include <cmath>

#ifndef PHMASK
#define PHMASK 0x7FFF
#endif
#define PH_EN(k) (((PHMASK) >> (k)) & 1)
#ifndef MK_N_LAUNCHES
#define MK_N_LAUNCHES 1
#endif

constexpr int NB = 8, SEQ = 4096, DM = 1024, NT_TOK = NB * SEQ, CTXL = 256, NCTX = NB * CTXL, LK = SEQ + CTXL;
constexpr int NHEAD = 16, NKVH = 4, HD = 64, QKVN = 1536, KVP = 256;
constexpr int NEXP = 32, DEXP = 512, NGRP = 4, EPG = 8;
constexpr float EPS = 1e-6f;

namespace pg8 {
#define PG8_LAS __attribute__((address_space(3)))
typedef unsigned short bf16_t;
typedef short bf16x8 __attribute__((ext_vector_type(8)));
typedef float f32x4 __attribute__((ext_vector_type(4)));
typedef unsigned u32x4 __attribute__((ext_vector_type(4)));
typedef unsigned u32x2 __attribute__((ext_vector_type(2)));
constexpr int BM = 256, BK = 64, HALF = 128, HTB = HALF * BK * 2, STAGE_BYTES = 8 * HTB, NXCD = 8, WGM = 8;

__host__ __device__ __forceinline__ int lds_byte(int r, int c) { const int st = (r >> 4) * 2 + (c >> 5), rr = r & 15, cc = c & 31, ob = rr * 64 + cc * 2; return st * 1024 + (ob ^ (((ob >> 9) & 1) << 5)); }
__host__ __device__ __forceinline__ void stage_rc(int b, int& R, int& C) { const int st = b / 1024, sb = b % 1024, swz = sb ^ (((sb >> 9) & 1) << 5); R = (st >> 1) * 16 + swz / 64; C = (st & 1) * 32 + (swz % 64) / 2; }
__host__ __device__ __forceinline__ int perm32(int rho) { const int n = rho >> 4, i = rho & 15; return 8 * (i >> 2) + 4 * n + (i & 3); }

struct Unit { int pm, pn, e, r0, cnt, rb, ui; };

__device__ __forceinline__ int xcd_remap(int wgid, int nwg) { const int q = nwg / NXCD, r = nwg % NXCD, xcd = wgid % NXCD, off = wgid / NXCD; return (xcd < r ? xcd * (q + 1) : r * (q + 1) + (xcd - r) * q) + off; }

struct StaticOrder {
    static constexpr bool WAITS = false;
    int nM, nN, nwg, G, c;
    __device__ void init(int nM_, int nN_, int G_, int c_) { nM = nM_; nN = nN_; nwg = nM * nN; G = G_; c = c_; }
    __device__ bool next(int i, Unit& u) const {
        const long L = (long)i * G + c; if (L >= nwg) return false;
        const int wgid = xcd_remap((int)L, nwg);
        const int nig = WGM * nN, gid = wgid / nig, fm = gid * WGM, gsz = (nM - fm) < WGM ? (nM - fm) : WGM;
        u.pm = fm + ((wgid % nig) % gsz); u.pn = (wgid % nig) / gsz; u.e = 0; u.r0 = 0; u.cnt = 0; u.rb = 0; u.ui = i; return true;
    }
};

__device__ __forceinline__ unsigned cvt_pk_bf16(float lo, float hi) { unsigned r; asm volatile("v_cvt_pk_bf16_f32 %0, %1, %2" : "=v"(r) : "v"(lo), "v"(hi)); return r; }

template <class Prob, class Epi, class Sched, bool ALIGN_EPI>
__device__ __forceinline__ void gemm_phase(PG8_LAS unsigned char* lds, const Prob& P, const Sched& S, const Epi& E) {
    const int tid = threadIdx.x, wid = __builtin_amdgcn_readfirstlane(tid >> 6), lane = tid & 63, wr = wid >> 2, wc = wid & 3, fr = lane & 15, fq = lane >> 4;
    const int nt = P.nt;
    int Rr[2], Cc[2];
    unsigned voffA[2], voffB[2];
#pragma unroll
    for (int i = 0; i < 2; ++i) { stage_rc(tid * 16 + i * 8192, Rr[i], Cc[i]); voffA[i] = P.a_voff(Rr[i], Cc[i]); voffB[i] = P.b_voff(Rr[i], Cc[i]); }
    const size_t hstepA = P.a_hstep(), hstepB = P.b_hstep();
    const unsigned ldsw = (unsigned)wid * 1024u;
    const int aoff = lds_byte(wr * 64 + fr, fq * 8), boff = lds_byte(wc * 32 + fr, fq * 8);
    unsigned cva0[2] = {0, 0}, cva1[2] = {0, 0}, nva0[2] = {0, 0}, nva1[2] = {0, 0};
    const PG8_LAS unsigned* tab = (const PG8_LAS unsigned*)(lds + Prob::tab_off);
#define PG8_SA(b, h) (((b) * 2 + (h)) * HTB)
#define PG8_SB(b, h) ((4 + (b) * 2 + (h)) * HTB)
#define PG8_STAGE(bufoff, gbase, voff) do { _Pragma("unroll") for (int _i = 0; _i < 2; ++_i) \
        __builtin_amdgcn_global_load_lds((const unsigned*)((const char*)(gbase) + (voff)[_i]), (PG8_LAS unsigned*)(lds + (bufoff) + ldsw + _i * 8192), 16, 0, 0); } while (0)
#define PG8_LDA(dst, b, h) do { _Pragma("unroll") for (int m = 0; m < 4; ++m) _Pragma("unroll") for (int k = 0; k < 2; ++k) dst[m][k] = *(const PG8_LAS bf16x8*)(lds + PG8_SA(b, h) + aoff + m * 2048 + k * 1024); } while (0)
#define PG8_LDB(dst, b, h) do { _Pragma("unroll") for (int n = 0; n < 2; ++n) _Pragma("unroll") for (int k = 0; k < 2; ++k) dst[n][k] = *(const PG8_LAS bf16x8*)(lds + PG8_SB(b, h) + boff + n * 2048 + k * 1024); } while (0)
#define PG8_MMA(ai, bj, At, Bt) do { __builtin_amdgcn_s_setprio(1); _Pragma("unroll") for (int m = 0; m < 4; ++m) _Pragma("unroll") for (int n = 0; n < 2; ++n) _Pragma("unroll") for (int k = 0; k < 2; ++k) \
        acc[ai][bj][m][n] = __builtin_amdgcn_mfma_f32_16x16x32_bf16(Bt[n][k], At[m][k], acc[ai][bj][m][n], 0, 0, 0); __builtin_amdgcn_s_setprio(0); } while (0)
#define PG8_WAIT_V(n) asm volatile("s_waitcnt vmcnt(" #n ")" ::: "memory")
#define PG8_WAIT_L(n) asm volatile("s_waitcnt lgkmcnt(" #n ")" ::: "memory")
#define PG8_BAR __builtin_amdgcn_s_barrier()
#define PG8_SCHED __builtin_amdgcn_sched_barrier(0)
#define PG8_STAGE_A(bufoff, gb, h, VO0, VO1) do { if constexpr (Prob::GATHER) { if ((h) == 0) PG8_STAGE(bufoff, gb, VO0); else PG8_STAGE(bufoff, gb, VO1); } else { PG8_STAGE(bufoff, (gb) + (h) * hstepA, voffA); } } while (0)
    Unit cur, nxt; int ui = 0; int pend_pm = -1;
    if (!S.next(0, cur)) return;
    if constexpr (Sched::WAITS) S.a_ready(cur);
    f32x4 acc[2][2][4][2];
#pragma unroll
    for (int a = 0; a < 2; ++a)
#pragma unroll
        for (int b = 0; b < 2; ++b)
#pragma unroll
            for (int m = 0; m < 4; ++m)
#pragma unroll
                for (int n = 0; n < 2; ++n) acc[a][b][m][n] = (f32x4){0.f, 0.f, 0.f, 0.f};
    bf16x8 At[4][2], B0[2][2], B1[2][2];
    const char* cA = P.a_unit(cur); const char* cB = P.b_unit(cur);
    if constexpr (Prob::GATHER) {
#pragma unroll
        for (int i = 0; i < 2; ++i) { cva0[i] = tab[cur.ui * 256 + Rr[i]] + (unsigned)Cc[i] * 2u; cva1[i] = tab[cur.ui * 256 + 128 + Rr[i]] + (unsigned)Cc[i] * 2u; }
    }
    PG8_STAGE(PG8_SB(0, 0), cB + P.b_kt(0), voffB); PG8_STAGE(PG8_SB(0, 1), cB + P.b_kt(0) + hstepB, voffB); PG8_STAGE_A(PG8_SA(0, 0), cA + P.a_kt(0), 0, cva0, cva1); PG8_STAGE_A(PG8_SA(0, 1), cA + P.a_kt(0), 1, cva0, cva1);
    if (wr == 1) PG8_BAR;
    PG8_WAIT_V(2); PG8_BAR;
    PG8_STAGE(PG8_SB(1, 0), cB + P.b_kt(1), voffB); PG8_STAGE_A(PG8_SA(1, 0), cA + P.a_kt(1), 0, cva0, cva1); PG8_STAGE(PG8_SB(1, 1), cB + P.b_kt(1) + hstepB, voffB);
    PG8_WAIT_V(6); PG8_BAR;
    for (;;) {
        const bool has_next = S.next(ui + 1, nxt);
        if constexpr (Sched::WAITS) { if (has_next) S.a_ready(nxt); }
        const char* nA = has_next ? P.a_unit(nxt) : cA; const char* nB = has_next ? P.b_unit(nxt) : cB;
        if constexpr (Prob::GATHER) {
            const int nu = has_next ? nxt.ui : cur.ui;
#pragma unroll
            for (int i = 0; i < 2; ++i) { nva0[i] = tab[nu * 256 + Rr[i]] + (unsigned)Cc[i] * 2u; nva1[i] = tab[nu * 256 + 128 + Rr[i]] + (unsigned)Cc[i] * 2u; }
        }
        for (int t = 0; t < nt; t += 2) {
            const bool last = (t == nt - 2);
            const char* a1 = cA + P.a_kt(t + 1);
            const char* a2 = last ? nA + P.a_kt(0) : cA + P.a_kt(t + 2); const char* b2 = last ? nB + P.b_kt(0) : cB + P.b_kt(t + 2);
            const char* a3 = last ? nA + P.a_kt(1) : cA + P.a_kt(t + 3); const char* b3 = last ? nB + P.b_kt(1) : cB + P.b_kt(t + 3);
            unsigned sv0[2] = {0, 0}, sv1[2] = {0, 0};
            if constexpr (Prob::GATHER) {
#pragma unroll
                for (int i = 0; i < 2; ++i) { sv0[i] = last ? nva0[i] : cva0[i]; sv1[i] = last ? nva1[i] : cva1[i]; }
            }
            PG8_LDB(B0, 0, 0); PG8_LDB(B1, 0, 1); PG8_SCHED; PG8_LDA(At, 0, 0); PG8_STAGE_A(PG8_SA(1, 1), a1, 1, cva0, cva1);
            PG8_WAIT_V(8); PG8_WAIT_L(0); PG8_BAR; PG8_MMA(0, 0, At, B0); PG8_MMA(0, 1, At, B1); PG8_BAR; PG8_SCHED;
            PG8_LDA(At, 0, 1); PG8_STAGE(PG8_SB(0, 0), b2, voffB); PG8_STAGE(PG8_SB(0, 1), b2 + hstepB, voffB); PG8_STAGE_A(PG8_SA(0, 0), a2, 0, sv0, sv1);
            PG8_WAIT_V(8); PG8_WAIT_L(0); PG8_BAR; PG8_MMA(1, 0, At, B0); PG8_MMA(1, 1, At, B1); PG8_BAR; PG8_SCHED;
            PG8_LDB(B0, 1, 0); PG8_LDB(B1, 1, 1); PG8_SCHED; PG8_LDA(At, 1, 0); PG8_STAGE_A(PG8_SA(0, 1), a2, 1, sv0, sv1);
            PG8_WAIT_V(8); PG8_WAIT_L(0); PG8_BAR; PG8_MMA(0, 0, At, B0); PG8_MMA(0, 1, At, B1); PG8_BAR; PG8_SCHED;
            PG8_LDA(At, 1, 1); PG8_STAGE(PG8_SB(1, 0), b3, voffB); PG8_STAGE(PG8_SB(1, 1), b3 + hstepB, voffB); PG8_STAGE_A(PG8_SA(1, 0), a3, 0, sv0, sv1);
            PG8_WAIT_V(8); PG8_WAIT_L(0); PG8_BAR; PG8_MMA(1, 0, At, B0); PG8_MMA(1, 1, At, B1); PG8_BAR; PG8_SCHED;
            if constexpr (Epi::PUBLISH) { if (pend_pm >= 0) { E.publish(pend_pm, lane); pend_pm = -1; } }
        }
        if constexpr (ALIGN_EPI) { if (wr == 0) PG8_BAR; }
        E(acc, cur, wr, wc, fr, fq);
        if constexpr (Epi::PUBLISH) pend_pm = cur.pm;
        if (!has_next) break;
#pragma unroll
        for (int a = 0; a < 2; ++a)
#pragma unroll
            for (int b = 0; b < 2; ++b)
#pragma unroll
                for (int m = 0; m < 4; ++m)
#pragma unroll
                    for (int n = 0; n < 2; ++n) acc[a][b][m][n] = (f32x4){0.f, 0.f, 0.f, 0.f};
        cur = nxt; cA = nA; cB = nB; ++ui;
        if constexpr (Prob::GATHER) {
#pragma unroll
            for (int i = 0; i < 2; ++i) { cva0[i] = nva0[i]; cva1[i] = nva1[i]; }
        }
        if constexpr (ALIGN_EPI) { if (wr == 1) PG8_BAR; }
    }
    PG8_WAIT_V(0);
    if constexpr (Epi::PUBLISH) { if (pend_pm >= 0) E.publish(pend_pm, lane); }
    if constexpr (!ALIGN_EPI) { if (wr == 0) PG8_BAR; }
    PG8_BAR;
#undef PG8_SA
#undef PG8_SB
#undef PG8_STAGE
#undef PG8_STAGE_A
#undef PG8_LDA
#undef PG8_LDB
#undef PG8_MMA
#undef PG8_WAIT_V
#undef PG8_WAIT_L
#undef PG8_BAR
#undef PG8_SCHED
}
}

namespace attn_body {
using bf16=__hip_bfloat16;
using bf16x8=__attribute__((ext_vector_type(8)))short;
using s16x4=__attribute__((ext_vector_type(4)))short;
using f32x16=__attribute__((ext_vector_type(16)))float;
using u32x4=__attribute__((ext_vector_type(4)))unsigned;
constexpr int D=64,QP=1024,KP=256;
constexpr int NW=8,QBLK=32,QB=QBLK*NW,KVBLK=64;
__device__ __forceinline__ int crow(int r,int hi){return (r&3)+8*(r>>2)+4*hi;}
#define SBAR() __builtin_amdgcn_sched_barrier(0)
constexpr int NSLOT=3, SLOTB=8192;
constexpr int LDS_K=0, LDS_V=NSLOT*SLOTB, LDS_WS=2*NSLOT*SLOTB, LDS_OST=LDS_WS+NW*64*4, LDS_BYTES=LDS_OST+NW*4096;
constexpr float C2=0.125f*1.4426950408889634f;
__device__ __forceinline__ void glds16(const void*gsrc,unsigned lds_dst){unsigned keep;
  asm volatile("s_mov_b32 %0, m0\n\ts_mov_b32 m0, %2\n\ts_nop 0\n\tglobal_load_lds_dwordx4 %1, off\n\ts_mov_b32 m0, %0":"=&s"(keep):"v"(gsrc),"s"(lds_dst):"memory");}
__device__ __forceinline__ float max3f(float a,float b,float c){float r;asm("v_max3_f32 %0, %1, %2, %3":"=v"(r):"v"(a),"v"(b),"v"(c));return r;}
__device__ __forceinline__ float max2f(float a,float b){float r;asm("v_max_f32_e32 %0, %1, %2":"=v"(r):"v"(a),"v"(b));return r;}
__device__ __forceinline__ float fadd_s(float a,float b){float r;asm("v_add_f32_e32 %0, %1, %2":"=v"(r):"v"(a),"v"(b));return r;}
__device__ __forceinline__ float fsub_s(float a,float b){float r;asm("v_sub_f32_e32 %0, %1, %2":"=v"(r):"v"(a),"v"(b));return r;}
typedef float f32x2_t __attribute__((ext_vector_type(2))); typedef __bf16 bf16x2_t __attribute__((ext_vector_type(2)));
__device__ __forceinline__ unsigned cvtpk_s(float lo,float hi){f32x2_t v={lo,hi};bf16x2_t b=__builtin_convertvector(v,bf16x2_t);return __builtin_bit_cast(unsigned,b);}
#define WAIT_BAR(N) asm volatile("s_waitcnt vmcnt(" #N ") lgkmcnt(0)\n\ts_barrier":::"memory")

__device__ __forceinline__ void qkt(f32x16&p0,f32x16&p1,const char*Kslot,const bf16x8*qr,const f32x16&negm,int r32,int hi){
  const char*kb=Kslot+hi*1024+r32*16;
  #pragma unroll
  for(int d0=0;d0<4;++d0){
    const bf16x8 b0=*reinterpret_cast<const bf16x8*>(kb+d0*2048);
    const bf16x8 b1=*reinterpret_cast<const bf16x8*>(kb+d0*2048+512);
    if(d0==0){p0=__builtin_amdgcn_mfma_f32_32x32x16_bf16(b0,qr[0],negm,0,0,0);p1=__builtin_amdgcn_mfma_f32_32x32x16_bf16(b1,qr[0],negm,0,0,0);}
    else{p0=__builtin_amdgcn_mfma_f32_32x32x16_bf16(b0,qr[d0],p0,0,0,0);p1=__builtin_amdgcn_mfma_f32_32x32x16_bf16(b1,qr[d0],p1,0,0,0);}}
}
typedef __attribute__((address_space(3))) const char* lds_cptr;
typedef short v4i16_t __attribute__((ext_vector_type(4)));
__device__ __forceinline__ void kload8(bf16x8*kf,lds_cptr kp){
  kf[0]=*(const __attribute__((address_space(3))) bf16x8*)(kp);      kf[1]=*(const __attribute__((address_space(3))) bf16x8*)(kp+512);
  kf[2]=*(const __attribute__((address_space(3))) bf16x8*)(kp+2048); kf[3]=*(const __attribute__((address_space(3))) bf16x8*)(kp+2560);
  kf[4]=*(const __attribute__((address_space(3))) bf16x8*)(kp+4096); kf[5]=*(const __attribute__((address_space(3))) bf16x8*)(kp+4608);
  kf[6]=*(const __attribute__((address_space(3))) bf16x8*)(kp+6144); kf[7]=*(const __attribute__((address_space(3))) bf16x8*)(kp+6656);
}
__device__ __forceinline__ void kload2(bf16x8*kf,lds_cptr kp,int j){ kf[2*j]=*(const __attribute__((address_space(3))) bf16x8*)(kp+j*2048); kf[2*j+1]=*(const __attribute__((address_space(3))) bf16x8*)(kp+j*2048+512); }
__device__ __forceinline__ s16x4 vtr(lds_cptr p){ return __builtin_bit_cast(s16x4,__builtin_amdgcn_ds_read_tr16_b64_v4i16((__attribute__((address_space(3))) v4i16_t*)p)); }
__device__ __forceinline__ float rowmax(const f32x16&p0,const f32x16&p1){
  float a=max3f(p0[0],p0[1],p1[0]),b=max3f(p0[2],p0[3],p1[1]);a=max3f(a,p1[2],p1[3]);
  #pragma unroll
  for(int r=4;r<16;r+=4){a=max3f(a,p0[r],p0[r+1]);b=max3f(b,p0[r+2],p0[r+3]);a=max3f(a,p1[r],p1[r+1]);b=max3f(b,p1[r+2],p1[r+3]);}
  const float m=max2f(a,b);
  auto rr=__builtin_amdgcn_permlane32_swap(__float_as_uint(m),__float_as_uint(m),false,false);
  return max2f(__uint_as_float(rr[0]),__uint_as_float(rr[1]));
}
__device__ __forceinline__ void pv(f32x16*o,int vb,bf16x8 pa0,bf16x8 pa1,bf16x8 pa2,bf16x8 pa3){
  #pragma unroll
  for(int d0=0;d0<2;++d0){s16x4 lo[4],hi[4];
    #pragma unroll
    for(int ks=0;ks<4;++ks){
      asm volatile("ds_read_b64_tr_b16 %0,%1 offset:%c2":"=&v"(lo[ks]):"v"(vb),"i"(d0*4096+ks*1024):"memory");
      asm volatile("ds_read_b64_tr_b16 %0,%1 offset:%c2":"=&v"(hi[ks]):"v"(vb),"i"(d0*4096+ks*1024+512):"memory");}
    asm volatile("s_waitcnt lgkmcnt(0)":::"memory");SBAR();
    #define PK(k) (bf16x8){lo[k][0],lo[k][1],lo[k][2],lo[k][3],hi[k][0],hi[k][1],hi[k][2],hi[k][3]}
    o[d0]=__builtin_amdgcn_mfma_f32_32x32x16_bf16(pa0,PK(0),o[d0],0,0,0);
    o[d0]=__builtin_amdgcn_mfma_f32_32x32x16_bf16(pa1,PK(1),o[d0],0,0,0);
    o[d0]=__builtin_amdgcn_mfma_f32_32x32x16_bf16(pa2,PK(2),o[d0],0,0,0);
    o[d0]=__builtin_amdgcn_mfma_f32_32x32x16_bf16(pa3,PK(3),o[d0],0,0,0);
    #undef PK
  }
}
#define ATTN_STORE16(p,v) (*(u32x4*)(p)=(v))
template<int NT> __device__ __forceinline__ void attn_unit(const bf16*Qu,const bf16*__restrict__ Kh,const bf16*__restrict__ Vh,bf16*Ou,char*shm,float mref){
  const int tid=threadIdx.x,lane=tid&63,r32=lane&31,hi=lane>>5; const int wid=__builtin_amdgcn_readfirstlane(tid>>6);
  const bf16*Qw=Qu+(long)(wid*QBLK)*QP;
  const unsigned lds0=(unsigned)(uintptr_t)shm;
  float*wsf=(float*)(shm+LDS_WS)+wid*64;
  const bf16*ksrc=Kh+(long)lane*KP+wid*8;
  const bf16*vsrc=Vh+(long)(16*(wid&3)+(lane>>2))*KP+(wid>>2)*32+(lane&3)*8;
  const unsigned kdst=lds0+LDS_K+wid*1024, vdst=lds0+LDS_V+wid*1024;
  #define DMA_K(t,slot) glds16(ksrc+(long)(t)*KVBLK*KP,(unsigned)__builtin_amdgcn_readfirstlane(kdst+(slot)))
  #define DMA_V(t,slot) glds16(vsrc+(long)(t)*KVBLK*KP,(unsigned)__builtin_amdgcn_readfirstlane(vdst+(slot)))
  const int vb0=(int)(lds0+LDS_V)+((lane>>4)&1)*32+(lane&3)*8+(4*hi+((lane&15)>>2))*64;
  const char*Kbase=shm+LDS_K; bf16x8 kf[8];
  const lds_cptr shm3=(lds_cptr)shm; const lds_cptr kp0=shm3+LDS_K+hi*1024+r32*16; const lds_cptr vp0=shm3+LDS_V+((lane>>4)&1)*32+(lane&3)*8+(4*hi+((lane&15)>>2))*64;
  DMA_K(0,0);DMA_V(0,0);DMA_K(1,SLOTB);
  bf16x8 qr[4];
  #pragma unroll
  for(int d0=0;d0<4;++d0)qr[d0]=*reinterpret_cast<const bf16x8*>(&Qw[(long)r32*QP+d0*16+hi*8]);
  float l_reg=0.f;f32x16 o[2];o[0]=f32x16{};o[1]=f32x16{};f32x16 negm;
  _Pragma("unroll") for(int r=0;r<16;++r)negm[r]=-mref; asm volatile("":"+v"(negm));
  f32x16 pA0,pA1,pB0,pB1;
  int sl_prev=0,sl_cur=0,sl_next=SLOTB;
  #define ROT() do{sl_prev=sl_cur;sl_cur=sl_next;sl_next=(sl_next==(NSLOT-1)*SLOTB)?0:sl_next+SLOTB;}while(0)
  DMA_K(2,2*SLOTB);
  WAIT_BAR(3);
  qkt(pA0,pA1,Kbase,qr,negm,r32,hi);asm volatile("s_nop 15\n\ts_nop 7":"+v"(pA0),"+v"(pA1));
  _Pragma("unroll") for(int r=0;r<16;++r)pA0[r]=__builtin_amdgcn_exp2f(pA0[r]);
  _Pragma("unroll") for(int r=0;r<16;++r)pA1[r]=__builtin_amdgcn_exp2f(pA1[r]);
  WAIT_BAR(0);
  DMA_K(3,0);DMA_V(1,SLOTB);
  ROT();
  kload8(kf,kp0+sl_cur);
  WAIT_BAR(2);
  s16x4 vlo[8],vhi[8]; u32x4 pw0,pw1,pw2,pw3;
  #define PKW(P,B) cvtpk_s(P[B],P[B+1])
  #define PAF(k) __builtin_bit_cast(bf16x8,pw##k)
  #define VFR(i) (bf16x8){vlo[i][0],vlo[i][1],vlo[i][2],vlo[i][3],vhi[i][0],vhi[i][1],vhi[i][2],vhi[i][3]}
  #define PIN(x) asm volatile("":"+v"(x))
  #define MX3(a,b,c) __builtin_fmaxf(__builtin_fmaxf((a),(b)),(c))
  #define GAPA(MF,A0,A1,A2,A3,W0,W1,PW) do{ MF; sacc+=A0; sacc+=A1; sacc+=A2; sacc+=A3; PIN(sacc); W0; W1; PIN(PW); SBAR(); }while(0)
  #define EX(v) __builtin_amdgcn_exp2f(v)
  #define GAPB(MF,X,B) do{ MF; X[B]=EX(X[B]); X[B+1]=EX(X[B+1]); X[B+2]=EX(X[B+2]); X[B+3]=EX(X[B+3]); PIN(X); SBAR(); }while(0)
  #define VRD(i) do{ vlo[i]=vtr(vp_+(((i)>>2)*4096+((i)&3)*1024)); vhi[i]=vtr(vp_+(((i)>>2)*4096+((i)&3)*1024+512)); }while(0)
  #define KRD(G,j) do{ if(G){ kload2(kf,kp0+sl_next,j); SBAR(); } }while(0)
  #define STEP(C0,C1,P0,P1,t,GK,GV,GL) do{ SBAR(); \
    const lds_cptr vp_=vp0+sl_prev; \
    VRD(0); SBAR(); float sacc=(P0[0]+P0[1]); \
    GAPA(C0=__builtin_amdgcn_mfma_f32_32x32x16_bf16(kf[0],qr[0],negm,0,0,0), P0[2],P0[3],P0[4],P0[5],     pw0[0]=PKW(P0,0), pw0[1]=PKW(P0,2), pw0); \
    VRD(4); SBAR(); GAPA(C1=__builtin_amdgcn_mfma_f32_32x32x16_bf16(kf[1],qr[0],negm,0,0,0), P0[6],P0[7],P0[8],P0[9],     pw0[2]=PKW(P0,4), pw0[3]=PKW(P0,6), pw0); \
    VRD(1); SBAR(); GAPA(C0=__builtin_amdgcn_mfma_f32_32x32x16_bf16(kf[2],qr[1],C0,0,0,0),   P0[10],P0[11],P0[12],P0[13], pw1[0]=PKW(P0,8), pw1[1]=PKW(P0,10), pw1); \
    VRD(5); SBAR(); GAPA(C1=__builtin_amdgcn_mfma_f32_32x32x16_bf16(kf[3],qr[1],C1,0,0,0),   P0[14],P0[15],P1[0],P1[1],   pw1[2]=PKW(P0,12),pw1[3]=PKW(P0,14), pw1); \
    VRD(2); SBAR(); GAPA(C0=__builtin_amdgcn_mfma_f32_32x32x16_bf16(kf[4],qr[2],C0,0,0,0),   P1[2],P1[3],P1[4],P1[5],     pw2[0]=PKW(P1,0), pw2[1]=PKW(P1,2), pw2); \
    VRD(6); SBAR(); GAPA(C1=__builtin_amdgcn_mfma_f32_32x32x16_bf16(kf[5],qr[2],C1,0,0,0),   P1[6],P1[7],P1[8],P1[9],     pw2[2]=PKW(P1,4), pw2[3]=PKW(P1,6), pw2); \
    VRD(3); SBAR(); GAPA(C0=__builtin_amdgcn_mfma_f32_32x32x16_bf16(kf[6],qr[3],C0,0,0,0),   P1[10],P1[11],P1[12],P1[13], pw3[0]=PKW(P1,8), pw3[1]=PKW(P1,10), pw3); \
    VRD(7); SBAR(); GAPA(C1=__builtin_amdgcn_mfma_f32_32x32x16_bf16(kf[7],qr[3],C1,0,0,0),   P1[14],P1[15],0.f,0.f,       pw3[2]=PKW(P1,12),pw3[3]=PKW(P1,14), pw3); \
    l_reg+=sacc; \
    if(GK){DMA_K((t)+3,sl_cur);} if(GV){DMA_V((t)+1,sl_next);} \
    SBAR(); \
    GAPB(o[0]=__builtin_amdgcn_mfma_f32_32x32x16_bf16(PAF(0),VFR(0),o[0],0,0,0), C0,0); \
    GAPB(o[1]=__builtin_amdgcn_mfma_f32_32x32x16_bf16(PAF(0),VFR(4),o[1],0,0,0), C0,4); \
    KRD(GL,0); GAPB(o[0]=__builtin_amdgcn_mfma_f32_32x32x16_bf16(PAF(1),VFR(1),o[0],0,0,0), C0,8); \
    KRD(GL,1); GAPB(o[1]=__builtin_amdgcn_mfma_f32_32x32x16_bf16(PAF(1),VFR(5),o[1],0,0,0), C0,12); \
    KRD(GL,2); GAPB(o[0]=__builtin_amdgcn_mfma_f32_32x32x16_bf16(PAF(2),VFR(2),o[0],0,0,0), C1,0); \
    KRD(GL,3); GAPB(o[1]=__builtin_amdgcn_mfma_f32_32x32x16_bf16(PAF(2),VFR(6),o[1],0,0,0), C1,4); \
    GAPB(o[0]=__builtin_amdgcn_mfma_f32_32x32x16_bf16(PAF(3),VFR(3),o[0],0,0,0), C1,8); \
    GAPB(o[1]=__builtin_amdgcn_mfma_f32_32x32x16_bf16(PAF(3),VFR(7),o[1],0,0,0), C1,12); \
    }while(0)
  int t=1;
  for(;t+5<NT;t+=2){
    STEP(pB0,pB1,pA0,pA1,t,true,true,true);     WAIT_BAR(2); ROT();
    STEP(pA0,pA1,pB0,pB1,t+1,true,true,true);   WAIT_BAR(2); ROT();
  }
  #define ENDW(tt) do{ if((tt)+3<NT){WAIT_BAR(2);} else if((tt)+2<NT){WAIT_BAR(1);} else {WAIT_BAR(0);} }while(0)
  for(;t+1<NT;t+=2){
    STEP(pB0,pB1,pA0,pA1,t,(t+3<NT),(t+1<NT),(t+1<NT));       ENDW(t);   ROT();
    STEP(pA0,pA1,pB0,pB1,t+1,(t+4<NT),(t+2<NT),(t+2<NT));     ENDW(t+1); ROT();
  }
  STEP(pB0,pB1,pA0,pA1,NT-1,false,false,false);
  { float sacc=pB0[0]+pB0[1]; _Pragma("unroll") for(int r=2;r<16;++r)sacc+=pB0[r]; _Pragma("unroll") for(int r=0;r<16;++r)sacc+=pB1[r]; l_reg+=sacc;
    pw0=(u32x4){PKW(pB0,0),PKW(pB0,2),PKW(pB0,4),PKW(pB0,6)};pw1=(u32x4){PKW(pB0,8),PKW(pB0,10),PKW(pB0,12),PKW(pB0,14)};pw2=(u32x4){PKW(pB1,0),PKW(pB1,2),PKW(pB1,4),PKW(pB1,6)};pw3=(u32x4){PKW(pB1,8),PKW(pB1,10),PKW(pB1,12),PKW(pB1,14)};
    SBAR(); pv(o,vb0+sl_cur,PAF(0),PAF(1),PAF(2),PAF(3)); }
  #undef PKW
  #undef PAF
  #undef VFR
  #undef PIN
  #undef MX3
  #undef GAPA
  #undef GAPB
  #undef EX
  #undef VRD
  #undef KRD
  #undef STEP
  #undef ENDW
  {auto rr=__builtin_amdgcn_permlane32_swap(__float_as_uint(l_reg),__float_as_uint(l_reg),false,false);l_reg=__uint_as_float(rr[0])+__uint_as_float(rr[1]);}
  if(hi==0)wsf[32+r32]=l_reg;asm volatile("s_waitcnt lgkmcnt(0)":::"memory");
  float rli[16];
  #pragma unroll
  for(int r=0;r<16;++r)rli[r]=__builtin_amdgcn_rcpf(wsf[32+crow(r,hi)]);
  bf16*Ow=Ou+(long)(wid*QBLK)*QP;
  { bf16*stg=(bf16*)(shm+LDS_OST)+wid*2048;
    #pragma unroll
    for(int r=0;r<16;++r){const int orow=crow(r,hi);
      #pragma unroll
      for(int d0=0;d0<2;++d0)stg[orow*64+d0*32+r32]=__float2bfloat16(o[d0][r]*rli[r]);}
    asm volatile("s_waitcnt lgkmcnt(0)":::"memory");
    #pragma unroll
    for(int i=0;i<4;++i){const int row=i*8+(lane>>3),ch=lane&7; const u32x4 v=*(const u32x4*)(stg+row*64+ch*8); ATTN_STORE16(Ow+(long)row*QP+ch*8,v);} }
  asm volatile("s_waitcnt lgkmcnt(0)\n\ts_barrier":::"memory");
  #undef DMA_K
  #undef DMA_V
  #undef ROT
}
#undef SBAR
#undef WAIT_BAR
}

constexpr int NWAVES = 8;
constexpr int N_LAUNCHES = MK_N_LAUNCHES;
constexpr int N_PHASES = 15;

constexpr size_t MiB = 1u << 20;
constexpr size_t WS_CTL = 0, CTL_ZERO_BYTES = 1 * MiB;
constexpr size_t WS_MOD = 1 * MiB;
constexpr size_t WS_ROPE = 1 * MiB + 512 * 1024;
constexpr size_t WS_RBIAS = WS_ROPE + 16 * 1024;
constexpr size_t WS_DFTC = 1 * MiB + 768 * 1024;
constexpr size_t WS_RW = 2 * MiB;
constexpr size_t WS_WQKV = 6 * MiB, WS_WO = 9 * MiB, WS_WF = 11 * MiB;
constexpr size_t WS_LIST = 13 * MiB;
constexpr size_t WS_GATE = 17 * MiB;
constexpr size_t WS_W13 = 18 * MiB;
constexpr size_t WS_W2 = 146 * MiB;
constexpr size_t WS_ZT = 210 * MiB;
constexpr size_t WS_X3 = 210 * MiB;
constexpr size_t WS_YP = 342 * MiB;
constexpr size_t WS_XN = 274 * MiB;
constexpr size_t WS_XNC = 338 * MiB;
constexpr size_t WS_QO = 342 * MiB;
constexpr size_t WS_K = 406 * MiB, WS_V = 423 * MiB;
constexpr size_t WS_H1 = 342 * MiB;
constexpr size_t WS_Y = 440 * MiB;
constexpr size_t WS_END = 568 * MiB;
constexpr int CW_TMO = 0, CW_CODE = 1, CW_BAR = 4096, CW_CNT = 16384, CW_CTX = 16384 + 256, CW_UPC = 32768, UPC_WORDS = 288 * 64;

constexpr int RING_OFF = 0, RING_BYTES = 131072;
constexpr int LDSCTL_OFF = RING_BYTES, MISC_OFF = LDSCTL_OFF + 320;
constexpr int TS_OFF = LDSCTL_OFF + 512;
constexpr int HIST_OFF = LDSCTL_OFF + 1024;
constexpr int GTAB_OFF = LDSCTL_OFF + 2048;
constexpr int LDS_BYTES = 147456;

#define GAS __attribute__((address_space(1)))
#define LAS __attribute__((address_space(3)))
typedef unsigned short bf16;
typedef unsigned v4u __attribute__((ext_vector_type(4)));
typedef unsigned v2u __attribute__((ext_vector_type(2)));
typedef float f32x4 __attribute__((ext_vector_type(4)));
typedef short bf16x8 __attribute__((ext_vector_type(8)));
typedef GAS unsigned gu32;
#define RLX_AGENT __ATOMIC_RELAXED, __HIP_MEMORY_SCOPE_AGENT
#define LDS_WAIT() asm volatile("s_waitcnt lgkmcnt(0)" ::: "memory")
#define VM_WAIT() asm volatile("s_waitcnt vmcnt(0)" ::: "memory")
__device__ __forceinline__ unsigned f2bf(float f) { unsigned u = __builtin_bit_cast(unsigned, f); return (u + 0x7fffu + ((u >> 16) & 1u)) >> 16; }
__device__ __forceinline__ unsigned pk2(float lo, float hi) { return f2bf(lo) | (f2bf(hi) << 16); }
__device__ __forceinline__ float bf2f(unsigned h) { return __builtin_bit_cast(float, h << 16); }

#define XB_TMO      128
#define XB_XCNT(j)  (256  + 64 * (j))
#define XB_XSUB(j)  (1280 + 64 * (j))
#define XB_XGEN(j)  (2304 + 64 * (j))
#define XB_TOP      3328
#define XB_TOPGEN   3392
#define XCD_BAR_WORDS 3456
#define XB_SPIN_CAP (1u << 18)
__device__ __forceinline__ unsigned xb_ld(unsigned* p)              { return __hip_atomic_load(p, __ATOMIC_RELAXED, __HIP_MEMORY_SCOPE_AGENT); }
__device__ __forceinline__ unsigned xb_add(unsigned* p, unsigned v) { return __hip_atomic_fetch_add(p, v, __ATOMIC_RELAXED, __HIP_MEMORY_SCOPE_AGENT); }
__device__ __forceinline__ unsigned xb_xcc_id() { return (unsigned)__builtin_amdgcn_s_getreg((3 << 11) | 20) & 0xFu; }
#define XB_SPIN(cond, bar) do { unsigned _sp = 0; while (cond) { __builtin_amdgcn_s_sleep(1); \
    if ((++_sp & 255u) == 0u) { if (xb_ld(&(bar)[XB_TMO])) break; if (_sp > XB_SPIN_CAP) { atomicAdd(&(bar)[XB_TMO], 1u); break; } } } } while (0)
struct XcdBarrier { unsigned* bar; unsigned x; volatile LAS unsigned* st; };
__device__ __forceinline__ XcdBarrier xcd_barrier_post(unsigned* bar, volatile LAS unsigned* st) {
    XcdBarrier b; b.bar = bar; b.x = xb_xcc_id(); b.st = st;
    if (threadIdx.x == 0) (void)xb_add(&bar[XB_XCNT(b.x)], 1u);
    return b;
}
__device__ __forceinline__ void xcd_barrier_complete(unsigned* bar, unsigned x, unsigned& nloc, unsigned& nx) {
    const unsigned G = gridDim.x * gridDim.y * gridDim.z;
    unsigned sum, cnt, mine, sp = 0u;
    for (;;) {
        sum = 0u; cnt = 0u; mine = 0u;
#pragma unroll
        for (unsigned j = 0; j < 16; ++j) { const unsigned c = xb_ld(&bar[XB_XCNT(j)]); sum += c; cnt += (c > 0u) ? 1u : 0u; mine = (j == x) ? c : mine; }
        if (sum == G) break;
        __builtin_amdgcn_s_sleep(1);
        if ((++sp & 255u) == 0u) { if (xb_ld(&bar[XB_TMO])) break; if (sp > XB_SPIN_CAP) { atomicAdd(&bar[XB_TMO], 1u); break; } }
    }
    nloc = mine > 0u ? mine : 1u; nx = cnt > 0u ? cnt : 1u;
}
__device__ __forceinline__ void xcd_barrier(const XcdBarrier& b) {
    asm volatile("s_waitcnt vmcnt(0)" ::: "memory");
    __syncthreads();
    if (threadIdx.x == 0) {
        unsigned* bar = b.bar;
        __builtin_amdgcn_s_waitcnt(0);
        unsigned nloc = b.st[0], nx = b.st[1];
        if (nloc == 0u) { xcd_barrier_complete(bar, b.x, nloc, nx); b.st[0] = nloc; b.st[1] = nx; }
        const unsigned old = xb_add(&bar[XB_XSUB(b.x)], 1u);
        const unsigned gen = old / nloc;
        if (old + 1u == (gen + 1u) * nloc) {
            __builtin_amdgcn_fence(__ATOMIC_RELEASE, "agent");
            asm volatile("s_waitcnt vmcnt(0)" ::: "memory");
            const unsigned og = xb_add(&bar[XB_TOP], 1u);
            const unsigned tg = og / nx;
            if (og + 1u == (tg + 1u) * nx) xb_add(&bar[XB_TOPGEN], 1u);
            else XB_SPIN(xb_ld(&bar[XB_TOPGEN]) == tg, bar);
            __builtin_amdgcn_fence(__ATOMIC_ACQUIRE, "agent");
            xb_add(&bar[XB_XGEN(b.x)], 1u);
            asm volatile("s_waitcnt vmcnt(0)" ::: "memory");
        } else {
            XB_SPIN(xb_ld(&bar[XB_XGEN(b.x)]) == gen, bar);
            __builtin_amdgcn_fence(__ATOMIC_ACQUIRE, "agent");
            asm volatile("s_waitcnt vmcnt(0)" ::: "memory");
        }
    }
    __syncthreads();
}

struct Args { const float* in[21]; float* out; unsigned char* ws; int ph_lo, ph_hi; };
struct Frame {
    LAS unsigned char* lds;
    volatile LAS unsigned* MISC;
    gu32* ctl;
    int tid, lane, wave;
    int vcu, G;
    unsigned char* ws;
    float* out;
};
enum { I_X = 0, I_C, I_CTX, I_CCTX, I_WMOD, I_BMOD, I_NMIX, I_NFFN, I_WQKV, I_QN, I_KN, I_WO, I_WF, I_WRG, I_BRG, I_WRE, I_BRE, I_W1, I_W3, I_W2, I_FN };

__device__ __forceinline__ float wave_sum(float v) {
#pragma unroll
    for (int o = 1; o < 64; o <<= 1) v += __shfl_xor(v, o);
    return v;
}

struct TItem { const float* src; bf16* dst; int N, ldk; };
__device__ __forceinline__ void p0_item_load(const TItem& t, int lane, f32x4 (&v)[8]) {
#pragma unroll
    for (int i = 0; i < 8; ++i) v[i] = *(const GAS f32x4*)(t.src + (size_t)((lane >> 3) + 8 * i) * t.N + 4 * (lane & 7));
}
__device__ __forceinline__ void p0_item_store(const TItem& t, int lane, const f32x4 (&v)[8], LAS float* scr) {
#pragma unroll
    for (int i = 0; i < 8; ++i) { LAS float* d = scr + ((lane >> 3) + 8 * i) * 33 + 4 * (lane & 7); d[0] = v[i].x; d[1] = v[i].y; d[2] = v[i].z; d[3] = v[i].w; }
    LDS_WAIT(); asm volatile("" ::: "memory");
    const int c = lane & 7;
#pragma unroll
    for (int j = 0; j < 4; ++j) { const int n = (lane >> 3) + 8 * j; const LAS float* s = scr + (8 * c) * 33 + n;
        v4u o; o.x = pk2(s[0 * 33], s[1 * 33]); o.y = pk2(s[2 * 33], s[3 * 33]); o.z = pk2(s[4 * 33], s[5 * 33]); o.w = pk2(s[6 * 33], s[7 * 33]);
        *(GAS v4u*)(t.dst + (size_t)n * t.ldk + 8 * c) = o; }
    LDS_WAIT(); asm volatile("" ::: "memory");
}
__device__ __forceinline__ void p0_prologue(const Args& A, Frame& F) {
    LAS float* L = (LAS float*)(F.lds);
    if (F.vcu < 192) {
        const int l = F.vcu / 96, cg = F.vcu % 96;
        LAS float* sc = L;
        LAS float* part = L + 10240;
        for (int i = F.tid; i < 9 * 1024; i += NWAVES * 64) { const int r = i >> 10, k = i & 1023; const float c = (r < 8) ? A.in[I_C][r * 1024 + k] : A.in[I_CCTX][k]; sc[i] = c / (1.f + __expf(-c)); }
        __syncthreads();
        f32x4 acc[9];
#pragma unroll
        for (int r = 0; r < 9; ++r) acc[r] = (f32x4){0.f, 0.f, 0.f, 0.f};
        const int c4 = F.lane & 15, kg = F.lane >> 4;
        const float* wp = A.in[I_WMOD] + (size_t)l * 1024 * 6144 + cg * 64 + 4 * c4;
        const int kb = F.wave * 128;
        for (int i0 = 0; i0 < 32; i0 += 8) { f32x4 w[8];
#pragma unroll
            for (int i = 0; i < 8; ++i) w[i] = *(const GAS f32x4*)(wp + (size_t)(kb + 4 * (i0 + i) + kg) * 6144);
#pragma unroll
            for (int i = 0; i < 8; ++i) { const int k = kb + 4 * (i0 + i) + kg;
#pragma unroll
                for (int r = 0; r < 9; ++r) acc[r] += w[i] * sc[r * 1024 + k]; } }
#pragma unroll
        for (int r = 0; r < 9; ++r) {
#pragma unroll
            for (int j = 0; j < 4; ++j) { float v = acc[r][j]; v += __shfl_xor(v, 16); v += __shfl_xor(v, 32); acc[r][j] = v; }
            if (kg == 0) *(LAS f32x4*)(part + (F.wave * 9 + r) * 64 + 4 * c4) = acc[r]; }
        __syncthreads();
        for (int i = F.tid; i < 9 * 64; i += NWAVES * 64) { const int r = i >> 6, c = i & 63; float s = 0.f;
#pragma unroll
            for (int w = 0; w < 8; ++w) s += part[(w * 9 + r) * 64 + c];
            ((float*)(F.ws + WS_MOD))[(l * 9 + r) * 6144 + cg * 64 + c] = s + A.in[I_BMOD][l * 6144 + cg * 64 + c]; }
        __syncthreads();
    }
    LAS float* tab = L + 16384;
    for (int i = F.tid; i < 4096; i += NWAVES * 64) tab[i] = cospif((float)i * (1.0f / 2048.0f));
    __syncthreads();
    const int gw = F.vcu * NWAVES + F.wave, NGW = F.G * NWAVES;
    {
      bf16* DC = (bf16*)(F.ws + WS_DFTC);
      for (int m = gw; m < 256; m += NGW) { const int c0 = 8 * F.lane; float v[8];
#pragma unroll
          for (int i = 0; i < 8; ++i) { const int c = c0 + i; const int cc = c & 255; const int idx = (m * cc * 16) & 4095; v[i] = (c < 256) ? tab[idx] * (1.0f / 16.0f) : -tab[(idx - 1024) & 4095] * (1.0f / 16.0f); }
          v4u o; o.x = pk2(v[0], v[1]); o.y = pk2(v[2], v[3]); o.z = pk2(v[4], v[5]); o.w = pk2(v[6], v[7]);
          *(GAS v4u*)(DC + (size_t)m * 512 + c0) = o; }
      if (F.vcu == F.G - 1) { float* R = (float*)(F.ws + WS_ROPE);
          for (int i = F.tid; i < 1024; i += NWAVES * 64) { const int pos = i >> 4, j = i & 15; const float inv = powf(10000.0f, -(float)j / 16.0f); const float ang = (float)pos * inv; R[i] = cosf(ang); R[1024 + i] = sinf(ang); } }
    }
    __syncthreads();
    LAS float* scr = (LAS float*)(F.lds + F.wave * 16384);
    constexpr int I_QKV = 16 * 48, I_SQ = 16 * 32, I_MOE = 768 * 64;
    constexpr int NITEMS = I_QKV + 2 * I_SQ + I_MOE;
    auto item_of = [&](int it) -> TItem {
        int r = it; TItem t;
        auto mk = [&](const float* W, int N, bf16* WT, int ldk, int row_off, int kb, int nb) { t.src = W + (size_t)(64 * kb) * N + 32 * nb; t.dst = WT + (size_t)(row_off + 32 * nb) * ldk + 64 * kb; t.N = N; t.ldk = ldk; };
        if (r < I_QKV) { mk(A.in[I_WQKV], QKVN, (bf16*)(F.ws + WS_WQKV), 1024, 0, r / 48, r % 48); return t; } r -= I_QKV;
        if (r < I_SQ) { mk(A.in[I_WO], 1024, (bf16*)(F.ws + WS_WO), 1024, 0, r / 32, r % 32); return t; } r -= I_SQ;
        if (r < I_SQ) { mk(A.in[I_WF], 1024, (bf16*)(F.ws + WS_WF), 1024, 0, r / 32, r % 32); return t; } r -= I_SQ;
        const int le = r / 768, q = r % 768;
        if (q < 256) mk(A.in[I_W1] + (size_t)le * 1024 * 512, 512, (bf16*)(F.ws + WS_W13) + (size_t)le * 1024 * 1024, 1024, 0, q / 16, q % 16);
        else if (q < 512) mk(A.in[I_W3] + (size_t)le * 1024 * 512, 512, (bf16*)(F.ws + WS_W13) + (size_t)le * 1024 * 1024, 1024, 512, (q - 256) / 16, (q - 256) % 16);
        else mk(A.in[I_W2] + (size_t)le * 512 * 1024, 1024, (bf16*)(F.ws + WS_W2) + (size_t)le * 1024 * 512, 512, 0, (q - 512) / 32, (q - 512) % 32);
        return t; };
    if (gw < NITEMS) {
        TItem cur = item_of(gw); f32x4 va[8], vb[8];
        p0_item_load(cur, F.lane, va);
        for (int it = gw; it < NITEMS; it += 2 * NGW) {
            const bool h1 = it + NGW < NITEMS; TItem n1 = cur; if (h1) { n1 = item_of(it + NGW); p0_item_load(n1, F.lane, vb); }
            p0_item_store(cur, F.lane, va, scr);
            if (!h1) break;
            const bool h2 = it + 2 * NGW < NITEMS; if (h2) { cur = item_of(it + 2 * NGW); p0_item_load(cur, F.lane, va); }
            p0_item_store(n1, F.lane, vb, scr);
            if (!h2) break;
        }
    }
}

struct RowVec { f32x4 v[4]; };
__device__ __forceinline__ RowVec ld_row(const float* p, int lane) { RowVec r; const GAS f32x4* q = (const GAS f32x4*)p + lane;
#pragma unroll
    for (int j = 0; j < 4; ++j) r.v[j] = q[64 * j]; return r; }
__device__ __forceinline__ void st_row(float* p, int lane, const RowVec& r) { GAS f32x4* q = (GAS f32x4*)p + lane;
#pragma unroll
    for (int j = 0; j < 4; ++j) q[64 * j] = r.v[j]; }
__device__ __forceinline__ RowVec ld_row_bf16(const bf16* p, int lane) { RowVec r; const GAS v2u* q = (const GAS v2u*)p + lane;
#pragma unroll
    for (int j = 0; j < 4; ++j) { const v2u w = q[64 * j]; r.v[j] = (f32x4){bf2f(w.x & 0xffffu), bf2f(w.x >> 16), bf2f(w.y & 0xffffu), bf2f(w.y >> 16)}; } return r; }
__device__ __forceinline__ void st_row_bf16(bf16* p, int lane, const RowVec& r) { GAS v2u* q = (GAS v2u*)p + lane;
#pragma unroll
    for (int j = 0; j < 4; ++j) { v2u w; w.x = pk2(r.v[j].x, r.v[j].y); w.y = pk2(r.v[j].z, r.v[j].w); q[64 * j] = w; } }
__device__ __forceinline__ float row_ss(const RowVec& r) { float s = 0.f;
#pragma unroll
    for (int j = 0; j < 4; ++j) s += (r.v[j].x * r.v[j].x + r.v[j].y * r.v[j].y) + (r.v[j].z * r.v[j].z + r.v[j].w * r.v[j].w);
    return wave_sum(s); }
__device__ __forceinline__ void ld_mod(const float* gain, const float* scale, const float* shift, int lane, RowVec& gm, RowVec& sh) {
    const RowVec g = ld_row(gain, lane), s = ld_row(scale, lane); sh = ld_row(shift, lane);
#pragma unroll
    for (int j = 0; j < 4; ++j) gm.v[j] = g.v[j] * (s.v[j] + 1.0f);
}
__device__ __forceinline__ bf16* xres(Frame& F, int which) { return which == 1 ? (bf16*)((unsigned char*)F.out + 64 * MiB) : which == 2 ? (bf16*)F.out : (bf16*)(F.ws + WS_X3); }
__device__ __forceinline__ const float* modp(Frame& F, int l, int r, int chunk) { return (const float*)(F.ws + WS_MOD) + (size_t)(l * 9 + r) * 6144 + chunk * 1024; }

__device__ __forceinline__ void p1_phase(const Args& A, Frame& F) {
    const int gw = F.vcu * NWAVES + F.wave, NGW = F.G * NWAVES;
    const int NLB = F.G - 16;
    { const int row = 8 * F.vcu + F.wave; RowVec gm, sh; ld_mod(A.in[I_NMIX], modp(F, 0, 8, 1), modp(F, 0, 8, 0), F.lane, gm, sh);
      RowVec x = ld_row(A.in[I_CTX] + (size_t)row * DM, F.lane); const float rstd = rsqrtf(row_ss(x) * (1.0f / DM) + EPS);
#pragma unroll
      for (int j = 0; j < 4; ++j) x.v[j] = x.v[j] * rstd * gm.v[j] + sh.v[j];
      st_row_bf16((bf16*)(F.ws + WS_XNC) + (size_t)row * DM, F.lane, x);
      VM_WAIT(); __syncthreads();
      if (F.tid == 0) { __builtin_amdgcn_fence(__ATOMIC_RELEASE, "agent"); VM_WAIT(); __hip_atomic_fetch_add((unsigned*)(F.ctl + CW_CTX) + 64 * (F.vcu >> 5), 1u, RLX_AGENT); } }
    if (F.vcu < NLB) for (int it = gw; it < NT_TOK / 16; it += NLB * NWAVES) { const int t0 = it * 16, b = t0 / SEQ; RowVec gm, sh; ld_mod(A.in[I_NMIX], modp(F, 0, b, 1), modp(F, 0, b, 0), F.lane, gm, sh);
        for (int r = 0; r < 16; ++r) { RowVec x = ld_row(A.in[I_X] + (size_t)(t0 + r) * DM, F.lane); const float rstd = rsqrtf(row_ss(x) * (1.0f / DM) + EPS);
#pragma unroll
            for (int j = 0; j < 4; ++j) x.v[j] = x.v[j] * rstd * gm.v[j] + sh.v[j];
            st_row_bf16((bf16*)(F.ws + WS_XN) + (size_t)(t0 + r) * DM, F.lane, x); } }
    for (int it = gw; it < 2 * 8 * 48; it += NGW) { const int l = it / 384, b = (it / 48) % 8, c = it % 48;
        bf16* hi = (bf16*)(F.ws + WS_RW) + ((size_t)((l * 8 + b) * 2 + 0) * 48 + c) * 1024; bf16* lo = hi + 48 * 1024;
        const float* gain = A.in[I_NFFN] + l * 1024; const float* sc2 = modp(F, l, b, 4); const float* sh2 = modp(F, l, b, 3);
        float bs = 0.f;
        for (int j = 0; j < 16; ++j) { const int k = F.lane + 64 * j; float w = 0.f;
            if (c < 4) w = A.in[I_WRG][(size_t)l * 1024 * 4 + k * 4 + c]; else if (c < 36) w = A.in[I_WRE][(size_t)l * 1024 * 32 + k * 32 + (c - 4)];
            const float wp = gain[k] * (1.0f + sc2[k]) * w; const unsigned h = f2bf(wp); hi[k] = (bf16)h; lo[k] = (bf16)f2bf(wp - bf2f(h)); bs += sh2[k] * w; }
        bs = wave_sum(bs);
        if (F.lane == 0) { float br = 0.f; if (c < 4) br = A.in[I_BRG][l * 4 + c]; else if (c < 36) br = A.in[I_BRE][l * 32 + (c - 4)]; ((float*)(F.ws + WS_RBIAS))[(l * 8 + b) * 48 + c] = bs + br; } }
}


using pg8::Unit; using pg8::perm32;
template <bool PERM> struct ProbStd {
    static constexpr bool GATHER = false; static constexpr int tab_off = 0;
    int nt; const char* A; const char* B; int lda2, ldb2;
    __device__ __forceinline__ const char* a_unit(const Unit& u) const { return A + (size_t)u.pm * 256 * lda2; }
    __device__ __forceinline__ size_t a_hstep() const { return (size_t)128 * lda2; }
    __device__ __forceinline__ size_t a_kt(int t) const { return (size_t)t * 128; }
    __device__ __forceinline__ unsigned a_voff(int R, int C) const { return (unsigned)(R * lda2 + C * 2); }
    __device__ __forceinline__ const char* b_unit(const Unit& u) const { return B + (size_t)u.pn * 256 * ldb2; }
    __device__ __forceinline__ size_t b_hstep() const { return (size_t)128 * ldb2; }
    __device__ __forceinline__ size_t b_kt(int t) const { return (size_t)t * 128; }
    __device__ __forceinline__ unsigned b_voff(int R, int C) const { const int Rb = PERM ? ((R & ~31) + perm32(R & 31)) : R; return (unsigned)(Rb * ldb2 + C * 2); }
};
struct ProbQKV {
    static constexpr bool GATHER = false; static constexpr int tab_off = 0;
    int nt; const char* XN; const char* XNC; const char* W;
    __device__ __forceinline__ const char* a_unit(const Unit& u) const { return XN + (size_t)u.e * (size_t)(WS_XNC - WS_XN) + (size_t)u.pm * 256 * 2048; }
    __device__ __forceinline__ size_t a_hstep() const { return (size_t)128 * 2048; }
    __device__ __forceinline__ size_t a_kt(int t) const { return (size_t)t * 128; }
    __device__ __forceinline__ unsigned a_voff(int R, int C) const { return (unsigned)(R * 2048 + C * 2); }
    __device__ __forceinline__ const char* b_unit(const Unit& u) const { return W + (size_t)u.pn * 256 * 2048; }
    __device__ __forceinline__ size_t b_hstep() const { return (size_t)32 * 2048; }
    __device__ __forceinline__ size_t b_kt(int t) const { return (size_t)t * 128; }
    __device__ __forceinline__ unsigned b_voff(int R, int C) const { return (unsigned)((64 * (R >> 5) + (R & 31)) * 2048 + C * 2); }
};
struct ProbUp {
    static constexpr bool GATHER = true; static constexpr int tab_off = GTAB_OFF;
    int nt; const char* XN; const char* W;
    __device__ __forceinline__ const char* a_unit(const Unit&) const { return XN; }
    __device__ __forceinline__ size_t a_hstep() const { return 0; }
    __device__ __forceinline__ size_t a_kt(int t) const { return (size_t)t * 128; }
    __device__ __forceinline__ unsigned a_voff(int, int) const { return 0u; }
    __device__ __forceinline__ const char* b_unit(const Unit& u) const { return W + ((size_t)u.e * 1024 + 128 * u.pn) * 2048; }
    __device__ __forceinline__ size_t b_hstep() const { return (size_t)512 * 2048; }
    __device__ __forceinline__ size_t b_kt(int t) const { return (size_t)t * 128; }
    __device__ __forceinline__ unsigned b_voff(int R, int C) const { const int Rb = (R & ~31) + perm32(R & 31); return (unsigned)(Rb * 2048 + C * 2); }
};
struct ProbDown {
    static constexpr bool GATHER = false; static constexpr int tab_off = 0;
    int nt; const char* H1; const char* W;
    __device__ __forceinline__ const char* a_unit(const Unit& u) const { return H1 + (size_t)u.rb * 1024; }
    __device__ __forceinline__ size_t a_hstep() const { return (size_t)128 * 1024; }
    __device__ __forceinline__ size_t a_kt(int t) const { return (size_t)t * 128; }
    __device__ __forceinline__ unsigned a_voff(int R, int C) const { return (unsigned)(R * 1024 + C * 2); }
    __device__ __forceinline__ const char* b_unit(const Unit& u) const { return W + ((size_t)u.e * 1024 + 256 * u.pn) * 1024; }
    __device__ __forceinline__ size_t b_hstep() const { return (size_t)128 * 1024; }
    __device__ __forceinline__ size_t b_kt(int t) const { return (size_t)t * 128; }
    __device__ __forceinline__ unsigned b_voff(int R, int C) const { const int Rb = (R & ~31) + perm32(R & 31); return (unsigned)(Rb * 1024 + C * 2); }
};
struct ProbC {
    static constexpr bool GATHER = false; static constexpr int tab_off = 0;
    int nt; const char* ZT; const char* DC;
    __device__ __forceinline__ const char* a_unit(const Unit& u) const { return ZT + (((size_t)(u.pm >> 4) * 8192 + (u.pm & 15) * 256) * 1024 + 256 * u.pn) * 2; }
    __device__ __forceinline__ size_t a_hstep() const { return (size_t)128 * 2048; }
    __device__ __forceinline__ size_t a_kt(int t) const { return (size_t)(t & 3) * 128 + (size_t)(t >> 2) * ((size_t)4096 * 2048); }
    __device__ __forceinline__ unsigned a_voff(int R, int C) const { return (unsigned)(R * 2048 + C * 2); }
    __device__ __forceinline__ const char* b_unit(const Unit&) const { return DC; }
    __device__ __forceinline__ size_t b_hstep() const { return (size_t)128 * 1024; }
    __device__ __forceinline__ size_t b_kt(int t) const { return (size_t)t * 128; }
    __device__ __forceinline__ unsigned b_voff(int R, int C) const { const int Rb = (R & ~31) + perm32(R & 31); return (unsigned)(Rb * 1024 + C * 2); }
};

struct SchedOne {
    static constexpr bool WAITS = false;
    Unit u0;
    __device__ __forceinline__ bool next(int i, Unit& u) const { if (i != 0) return false; u = u0; return true; }
};
template <bool WAIT> struct GroupedOrderT {
    static constexpr bool WAITS = WAIT;
    const LAS int* ts; int G, c, layer, i0, off; unsigned* upc;
    __device__ __forceinline__ bool next(int i, Unit& u) const {
        const int nrt = ts[32], nwg = nrt * 4; const int L = (i + i0) * G + c - off; if (L < 0 || L >= nwg) return false;
        const int wgid = pg8::xcd_remap(L, nwg); const int rt = wgid >> 2;
        int e = 0;
#pragma unroll 1
        for (int j = 1; j < 32; ++j) if (ts[j] <= rt) e = j;
        e = __builtin_amdgcn_readfirstlane(e);
        u.pm = __builtin_amdgcn_readfirstlane(rt); u.pn = __builtin_amdgcn_readfirstlane(wgid & 3); u.e = layer * 32 + e;
        u.r0 = __builtin_amdgcn_readfirstlane((rt - ts[e]) * 256); u.cnt = __builtin_amdgcn_readfirstlane(ts[33 + e]); u.rb = u.pm * 256; u.ui = i; return true;
    }
    __device__ __forceinline__ void a_ready(const Unit& u) const {
        unsigned* p = upc + 64 * u.pm; unsigned sp = 0;
        while ((unsigned)__builtin_amdgcn_readfirstlane(__hip_atomic_load(p, __ATOMIC_RELAXED, __HIP_MEMORY_SCOPE_AGENT)) < 32u) { __builtin_amdgcn_s_sleep(2); if (++sp > (1u << 22)) break; }
        __builtin_amdgcn_fence(__ATOMIC_ACQUIRE, "agent"); asm volatile("s_waitcnt vmcnt(0)" ::: "memory");
    }
};
typedef GroupedOrderT<false> GroupedOrder;

typedef pg8::f32x4 (AccT)[2][2][4][2];
struct EpiQKV {
    static constexpr bool PUBLISH = false;
    bf16* Q; bf16* K; bf16* V; const float* qn; const float* kn; const LAS float* rope;
    __device__ __forceinline__ void operator()(const AccT& acc, const Unit& u, int wr, int wc, int fr, int fq) const {
        const int pn = u.pn; const bool ctx = u.e != 0;
        f32x4 gv[2][2];
        if (pn != 5) { const float* g = (pn == 4) ? kn : qn;
#pragma unroll
            for (int bj = 0; bj < 2; ++bj)
#pragma unroll
                for (int n = 0; n < 2; ++n) gv[bj][n] = *(const f32x4*)(g + 32 * bj + 16 * n + 4 * fq); }
#pragma unroll
        for (int ai = 0; ai < 2; ++ai)
#pragma unroll
            for (int m = 0; m < 4; ++m) {
                const int row = 128 * ai + 64 * wr + 16 * m + fr; const int tok = u.pm * 256 + row; const int pos = tok & (SEQ - 1);
                const size_t krow = ctx ? ((size_t)u.pm * LK + SEQ + row) : ((size_t)(tok >> 12) * LK + pos);
                f32x4 y[2][2];
#pragma unroll
                for (int bj = 0; bj < 2; ++bj)
#pragma unroll
                    for (int n = 0; n < 2; ++n) y[bj][n] = acc[ai][bj][m][n];
                if (pn != 5) {
                    float ss = 0.f;
#pragma unroll
                    for (int bj = 0; bj < 2; ++bj)
#pragma unroll
                        for (int n = 0; n < 2; ++n) ss += (y[bj][n].x * y[bj][n].x + y[bj][n].y * y[bj][n].y) + (y[bj][n].z * y[bj][n].z + y[bj][n].w * y[bj][n].w);
                    ss += __shfl_xor(ss, 16); ss += __shfl_xor(ss, 32);
                    const float rstd = rsqrtf(ss * (1.0f / 64.0f) + EPS);
#pragma unroll
                    for (int bj = 0; bj < 2; ++bj)
#pragma unroll
                        for (int n = 0; n < 2; ++n) y[bj][n] = y[bj][n] * rstd * gv[bj][n];
                    if (!ctx) {
                        const int pr[2] = {pos >> 6, pos & 63};
#pragma unroll
                        for (int bj = 0; bj < 2; ++bj) { const f32x4 cs = *(const LAS f32x4*)(rope + pr[bj] * 16 + 4 * fq), sn = *(const LAS f32x4*)(rope + 1024 + pr[bj] * 16 + 4 * fq);
                            const f32x4 a = y[bj][0], b2 = y[bj][1]; y[bj][0] = a * cs - b2 * sn; y[bj][1] = b2 * cs + a * sn; }
                    }
                }
                bf16* dst;
                if (pn < 4) { dst = Q + (size_t)tok * 1024 + (4 * pn + wc) * 64;
#pragma unroll
                    for (int bj = 0; bj < 2; ++bj)
#pragma unroll
                        for (int n = 0; n < 2; ++n) y[bj][n] = y[bj][n] * attn_body::C2; }
                else dst = ((pn == 4) ? K : V) + krow * KVP + wc * 64;
#pragma unroll
                for (int bj = 0; bj < 2; ++bj)
#pragma unroll
                    for (int n = 0; n < 2; ++n) { v2u w; w.x = pg8::cvt_pk_bf16(y[bj][n].x, y[bj][n].y); w.y = pg8::cvt_pk_bf16(y[bj][n].z, y[bj][n].w); *(v2u*)(dst + 32 * bj + 16 * n + 4 * fq) = w; }
                asm volatile("" ::: "memory");
            }
    }
};
__device__ __forceinline__ v4u pack8(const f32x4& a, const f32x4& b) { v4u w; w.x = pg8::cvt_pk_bf16(a.x, a.y); w.y = pg8::cvt_pk_bf16(a.z, a.w); w.z = pg8::cvt_pk_bf16(b.x, b.y); w.w = pg8::cvt_pk_bf16(b.z, b.w); return w; }
template <bool BASE_F32> struct EpiResid {
    static constexpr bool PUBLISH = false;
    const void* base; bf16* out; const float* gate;
    __device__ __forceinline__ void operator()(const AccT& acc, const Unit& u, int wr, int wc, int fr, int fq) const {
        const int b = (u.pm * 256) >> 12; const int col0 = u.pn * 256 + wc * 32 + 8 * fq; const float* g = gate + b * 6144 + col0;
        f32x4 gv[2][2];
#pragma unroll
        for (int bj = 0; bj < 2; ++bj)
#pragma unroll
            for (int n = 0; n < 2; ++n) gv[bj][n] = *(const f32x4*)(g + bj * 128 + n * 4);
#pragma unroll
        for (int ai = 0; ai < 2; ++ai)
#pragma unroll
            for (int m = 0; m < 4; ++m) { const size_t off = (size_t)(u.pm * 256 + ai * 128 + wr * 64 + m * 16 + fr) * 1024 + col0;
#pragma unroll
                for (int bj = 0; bj < 2; ++bj) { f32x4 b0, b1;
                    if constexpr (BASE_F32) { b0 = *(const f32x4*)((const float*)base + off + bj * 128); b1 = *(const f32x4*)((const float*)base + off + bj * 128 + 4); }
                    else { const v4u w = *(const v4u*)((const bf16*)base + off + bj * 128); b0 = (f32x4){bf2f(w.x & 0xffffu), bf2f(w.x >> 16), bf2f(w.y & 0xffffu), bf2f(w.y >> 16)}; b1 = (f32x4){bf2f(w.z & 0xffffu), bf2f(w.z >> 16), bf2f(w.w & 0xffffu), bf2f(w.w >> 16)}; }
                    *(v4u*)(out + off + bj * 128) = pack8(b0 + gv[bj][0] * acc[ai][bj][m][0], b1 + gv[bj][1] * acc[ai][bj][m][1]); } }
    }
};
__device__ __forceinline__ void store16_sc1(void* p, v4u v) { asm volatile("global_store_dwordx4 %0, %1, off sc1\n\ts_nop 1" :: "v"(p), "v"(v) : "memory"); }
struct EpiUp {
    bf16* H1; unsigned* upc;
    __device__ __forceinline__ void operator()(const AccT& acc, const Unit& u, int wr, int wc, int fr, int fq) const {
#pragma unroll
        for (int ai = 0; ai < 2; ++ai)
#pragma unroll
            for (int m = 0; m < 4; ++m) { f32x4 h[2];
#pragma unroll
                for (int n = 0; n < 2; ++n) { const f32x4 a = acc[ai][0][m][n], b = acc[ai][1][m][n];
#pragma unroll
                    for (int i = 0; i < 4; ++i) h[n][i] = a[i] * __builtin_amdgcn_rcpf(1.0f + __builtin_amdgcn_exp2f(-1.4426950408889634f * a[i])) * b[i]; }
                store16_sc1(H1 + (size_t)(u.rb + 128 * ai + 64 * wr + 16 * m + fr) * 512 + 128 * u.pn + 32 * wc + 8 * fq, pack8(h[0], h[1])); }
    }
    static constexpr bool PUBLISH = true;
    __device__ __forceinline__ void publish(int pm, int lane) const { if (lane == 0) __hip_atomic_fetch_add(upc + 64 * pm, 1u, __ATOMIC_RELAXED, __HIP_MEMORY_SCOPE_AGENT); }
};
struct EpiDown {
    static constexpr bool PUBLISH = false;
    bf16* Y; const int* list; const float* gate;
    __device__ __forceinline__ void operator()(const AccT& acc, const Unit& u, int wr, int wc, int fr, int fq) const {
        const int* le = list + (size_t)(u.e & 31) * NT_TOK;
        int a[8]; float g[8];
#pragma unroll
        for (int q = 0; q < 8; ++q) { const int ridx = u.r0 + 128 * (q >> 2) + 64 * wr + 16 * (q & 3) + fr; a[q] = le[ridx < u.cnt ? ridx : 0]; if (ridx >= u.cnt) a[q] = -1; }
#pragma unroll
        for (int q = 0; q < 8; ++q) g[q] = gate[a[q] < 0 ? 0 : a[q]];
#pragma unroll
        for (int q = 0; q < 8; ++q) if (a[q] >= 0) { bf16* dst = Y + (size_t)a[q] * 1024 + 256 * u.pn + 32 * wc + 8 * fq;
#pragma unroll
            for (int bj = 0; bj < 2; ++bj) *(v4u*)(dst + 128 * bj) = pack8(acc[q >> 2][bj][q & 3][0] * g[q], acc[q >> 2][bj][q & 3][1] * g[q]); }
    }
};
struct EpiS {
    static constexpr bool PUBLISH = false;
    bf16* ZT;
    __device__ __forceinline__ void operator()(const AccT& acc, const Unit& u, int wr, int wc, int fr, int fq) const {
#pragma unroll
        for (int ai = 0; ai < 2; ++ai)
#pragma unroll
            for (int m = 0; m < 4; ++m) { const int kp = u.pm * 256 + 128 * ai + 64 * wr + 16 * m + fr;
#pragma unroll
                for (int bj = 0; bj < 2; ++bj) { const int col = u.pn * 256 + 128 * bj + 32 * wc + 8 * fq; const int b = col >> 10, c = col & 1023;
                    *(v4u*)(ZT + ((size_t)b * 8192 + kp) * 1024 + c) = pack8(acc[ai][bj][m][0], acc[ai][bj][m][1]); } }
    }
};
struct EpiC {
    static constexpr bool PUBLISH = false;
    bf16* Fm;
    __device__ __forceinline__ void operator()(const AccT& acc, const Unit& u, int wr, int wc, int fr, int fq) const {
#pragma unroll
        for (int ai = 0; ai < 2; ++ai)
#pragma unroll
            for (int m = 0; m < 4; ++m) { bf16* dst = Fm + (size_t)(u.pm * 256 + 128 * ai + 64 * wr + 16 * m + fr) * 1024 + u.pn * 256 + 32 * wc + 8 * fq;
#pragma unroll
                for (int bj = 0; bj < 2; ++bj) *(v4u*)(dst + 128 * bj) = pack8(acc[ai][bj][m][0], acc[ai][bj][m][1]); }
    }
};

__device__ __forceinline__ void moe_in_phase(const Args& A, Frame& F, int l) {
    const bf16* X = xres(F, l == 0 ? 1 : 3);
    LAS unsigned* hist = (LAS unsigned*)(F.lds + HIST_OFF); LAS unsigned* hbase = hist + 32;
    unsigned* cnt = (unsigned*)(F.ctl + CW_CNT) + l * 32;
    int* list = (int*)(F.ws + WS_LIST); float* gate = (float*)(F.ws + WS_GATE);
    for (int blk = F.vcu; blk < NT_TOK / 128; blk += F.G) {
        const int tokb = blk * 128, tok0 = tokb + F.wave * 16, b = tokb / SEQ;
        if (F.tid < 32) hist[F.tid] = 0u;
        __syncthreads();
        const int ti = F.lane & 15, kq = F.lane >> 4;
        const bf16* xr = X + (size_t)(tok0 + ti) * DM + 8 * kq;
        const bf16* wh = (const bf16*)(F.ws + WS_RW) + (size_t)((l * 8 + b) * 2) * 48 * 1024 + (size_t)ti * 1024 + 8 * kq;
        const bf16* wl = wh + 48 * 1024;
        f32x4 acc[3]; acc[0] = (f32x4){0.f, 0.f, 0.f, 0.f}; acc[1] = acc[0]; acc[2] = acc[0];
        float ss = 0.f;
#pragma unroll 2
        for (int s = 0; s < 32; ++s) {
            const v4u h = *(const GAS v4u*)(xr + 32 * s);
            { const float a0 = bf2f(h.x & 0xffffu), a1 = bf2f(h.x >> 16), a2 = bf2f(h.y & 0xffffu), a3 = bf2f(h.y >> 16), a4 = bf2f(h.z & 0xffffu), a5 = bf2f(h.z >> 16), a6 = bf2f(h.w & 0xffffu), a7 = bf2f(h.w >> 16);
              ss += (a0 * a0 + a1 * a1) + (a2 * a2 + a3 * a3) + (a4 * a4 + a5 * a5) + (a6 * a6 + a7 * a7); }
            const bf16x8 ah = __builtin_bit_cast(bf16x8, h);
#pragma unroll
            for (int cb = 0; cb < 3; ++cb) { const bf16x8 bh = *(const GAS bf16x8*)(wh + cb * 16 * 1024 + 32 * s), bl = *(const GAS bf16x8*)(wl + cb * 16 * 1024 + 32 * s);
                acc[cb] = __builtin_amdgcn_mfma_f32_16x16x32_bf16(ah, bh, acc[cb], 0, 0, 0);
                acc[cb] = __builtin_amdgcn_mfma_f32_16x16x32_bf16(ah, bl, acc[cb], 0, 0, 0); }
        }
        ss += __shfl_xor(ss, 16); ss += __shfl_xor(ss, 32);
        LAS float* scr = (LAS float*)(F.lds + F.wave * 16384);
#pragma unroll
        for (int cb = 0; cb < 3; ++cb)
#pragma unroll
            for (int r = 0; r < 4; ++r) scr[(4 * kq + r) * 49 + 16 * cb + ti] = acc[cb][r];
        if (kq == 0) scr[16 * 49 + ti] = rsqrtf(ss * (1.0f / DM) + EPS);
        LDS_WAIT(); asm volatile("" ::: "memory");
        int e0 = 0, e1 = 0; unsigned rk0 = 0, rk1 = 0; float w0 = 0.f, w1 = 0.f;
        if (F.lane < 16) {
            const float rstd = scr[16 * 49 + F.lane]; const float* bias = (const float*)(F.ws + WS_RBIAS) + (l * 8 + b) * 48; const LAS float* raw = scr + F.lane * 49;
            float lg[4];
#pragma unroll
            for (int g = 0; g < 4; ++g) lg[g] = rstd * raw[g] + bias[g];
            int gs = 0; float mx = lg[0];
#pragma unroll
            for (int g = 1; g < 4; ++g) if (lg[g] > mx) { mx = lg[g]; gs = g; }
            float den = 0.f;
#pragma unroll
            for (int g = 0; g < 4; ++g) den += __expf(lg[g] - mx);
            const float pgrp = 1.0f / den;
            float le[8];
#pragma unroll
            for (int j = 0; j < 8; ++j) le[j] = rstd * raw[4 + gs * 8 + j] + bias[4 + gs * 8 + j];
            int i0 = 0; float m0 = le[0];
#pragma unroll
            for (int j = 1; j < 8; ++j) if (le[j] > m0) { m0 = le[j]; i0 = j; }
            int i1 = -1; float m1 = -INFINITY;
#pragma unroll
            for (int j = 0; j < 8; ++j) if (j != i0 && le[j] > m1) { m1 = le[j]; i1 = j; }
            const float d = __expf(m1 - m0); w0 = pgrp / (1.0f + d); w1 = pgrp * d / (1.0f + d);
            e0 = gs * 8 + i0; e1 = gs * 8 + i1;
            rk0 = __hip_atomic_fetch_add(hist + e0, 1u, __ATOMIC_RELAXED, __HIP_MEMORY_SCOPE_WORKGROUP);
            rk1 = __hip_atomic_fetch_add(hist + e1, 1u, __ATOMIC_RELAXED, __HIP_MEMORY_SCOPE_WORKGROUP);
        }
        __syncthreads();
        if (F.tid < 32) hbase[F.tid] = __hip_atomic_fetch_add(cnt + F.tid, hist[F.tid], __ATOMIC_RELAXED, __HIP_MEMORY_SCOPE_AGENT);
        __syncthreads();
        if (F.lane < 16) { const int t = tok0 + F.lane;
            list[(size_t)e0 * NT_TOK + hbase[e0] + rk0] = 2 * t; list[(size_t)e1 * NT_TOK + hbase[e1] + rk1] = 2 * t + 1;
            gate[2 * t] = w0; gate[2 * t + 1] = w1; }
        RowVec gm, sh; ld_mod(A.in[I_NFFN] + l * 1024, modp(F, l, b, 4), modp(F, l, b, 3), F.lane, gm, sh);
        for (int r = 0; r < 16; ++r) { RowVec x = ld_row_bf16(X + (size_t)(tok0 + r) * DM, F.lane); const float rstd = scr[16 * 49 + r];
#pragma unroll
            for (int j = 0; j < 4; ++j) x.v[j] = x.v[j] * rstd * gm.v[j] + sh.v[j];
            st_row_bf16((bf16*)(F.ws + WS_XN) + (size_t)(tok0 + r) * DM, F.lane, x); }
        __syncthreads();
    }
}

__device__ __forceinline__ void grouped_setup(Frame& F, int l, bool with_tab) {
    LAS int* ts = (LAS int*)(F.lds + TS_OFF);
    const unsigned* cnt = (const unsigned*)(F.ctl + CW_CNT) + l * 32;
    if (F.tid < 32) ts[33 + F.tid] = (int)__hip_atomic_load(cnt + F.tid, __ATOMIC_RELAXED, __HIP_MEMORY_SCOPE_AGENT);
    __syncthreads();
    if (F.tid == 0) { int s = 0; for (int e = 0; e < 32; ++e) { ts[e] = s; s += (ts[33 + e] + 255) >> 8; } ts[32] = s; }
    __syncthreads();
    {
        GroupedOrder S{(const LAS int*)ts, F.G, (int)blockIdx.x, l, 0, 0, nullptr}; Unit u;
        const int* list = (const int*)(F.ws + WS_LIST); const float* gate = (const float*)(F.ws + WS_GATE);
        for (int i = 0; i < 5; ++i) { if (!S.next(i, u)) break;
            if (F.tid < 256) { const int ridx = u.r0 + F.tid; int a = -1; if (ridx < u.cnt) a = list[(size_t)(u.e & 31) * NT_TOK + ridx];
                if (with_tab) ((LAS unsigned*)(F.lds + GTAB_OFF))[i * 256 + F.tid] = (unsigned)((a < 0 ? 0 : a) >> 1) * 2048u;
                else { v2u ag; ag.x = (unsigned)a; ag.y = (a < 0) ? 0u : __builtin_bit_cast(unsigned, gate[a]); ((LAS v2u*)(F.lds + GTAB_OFF))[i * 256 + F.tid] = ag; } } }
        __syncthreads();
    }
}

__device__ __forceinline__ void p8_phase(const Args& A, Frame& F) {
    LAS unsigned char* tile = F.lds;
    const bf16* Y = (const bf16*)(F.ws + WS_Y); bf16* hT = (bf16*)(F.ws + WS_XN);
    for (int it = F.vcu; it < NT_TOK / 32; it += F.G) {
        const int b = it >> 7, rr = (it >> 1) & 63, qh = it & 1;
        const RowVec g2 = ld_row(modp(F, 0, b, 5), F.lane); RowVec gm, sh; ld_mod(A.in[I_NMIX] + 1024, modp(F, 1, b, 1), modp(F, 1, b, 0), F.lane, gm, sh);
        for (int q = 0; q < 4; ++q) { const int r = F.wave * 4 + q; const size_t t = (size_t)b * SEQ + 64 * (32 * qh + r) + rr;
            RowVec x = ld_row_bf16(xres(F, 1) + t * DM, F.lane); const RowVec y0 = ld_row_bf16(Y + (2 * t) * DM, F.lane), y1 = ld_row_bf16(Y + (2 * t + 1) * DM, F.lane);
#pragma unroll
            for (int j = 0; j < 4; ++j) x.v[j] = x.v[j] + g2.v[j] * (y0.v[j] + y1.v[j]);
            st_row_bf16(xres(F, 2) + t * DM, F.lane, x);
            const float rstd = rsqrtf(row_ss(x) * (1.0f / DM) + EPS);
#pragma unroll
            for (int j = 0; j < 4; ++j) { const f32x4 h = x.v[j] * rstd * gm.v[j] + sh.v[j]; v2u w; w.x = pk2(h.x, h.y); w.y = pk2(h.z, h.w); *(LAS v2u*)(tile + r * 2056 + 8 * F.lane + 512 * j) = w; } }
        __syncthreads();
        const int tg = F.lane & 3;
        for (int ic = 0; ic < 8; ++ic) { const int c = 128 * F.wave + 16 * ic + (F.lane >> 2); unsigned e[8];
#pragma unroll
            for (int i = 0; i < 8; ++i) e[i] = *(const LAS unsigned short*)(tile + (8 * tg + i) * 2056 + 2 * c);
            v4u o; o.x = e[0] | (e[1] << 16); o.y = e[2] | (e[3] << 16); o.z = e[4] | (e[5] << 16); o.w = e[6] | (e[7] << 16);
            *(GAS v4u*)(hT + ((size_t)(b * 1024 + c) * 4096 + rr * 64 + 32 * qh + 8 * tg)) = o; }
        __syncthreads();
    }
}

__device__ __forceinline__ void final_phase(const Args& A, Frame& F) {
    const int gw = F.vcu * NWAVES + F.wave, NGW = F.G * NWAVES; const bf16* Y = (const bf16*)(F.ws + WS_Y);
    const RowVec fn = ld_row(A.in[I_FN], F.lane);
    for (int it = gw; it < NT_TOK / 16; it += NGW) { const int t0 = it * 16, b = t0 / SEQ; const RowVec g2 = ld_row(modp(F, 1, b, 5), F.lane);
        for (int r = 0; r < 16; ++r) { const size_t t = (size_t)t0 + r; RowVec x = ld_row_bf16(xres(F, 3) + t * DM, F.lane); const RowVec y0 = ld_row_bf16(Y + (2 * t) * DM, F.lane), y1 = ld_row_bf16(Y + (2 * t + 1) * DM, F.lane);
#pragma unroll
            for (int j = 0; j < 4; ++j) x.v[j] = x.v[j] + g2.v[j] * (y0.v[j] + y1.v[j]);
            const float rstd = rsqrtf(row_ss(x) * (1.0f / DM) + EPS);
#pragma unroll
            for (int j = 0; j < 4; ++j) x.v[j] = x.v[j] * rstd * fn.v[j];
            st_row(F.out + t * DM, F.lane, x); } }
}

typedef float f32x16 __attribute__((ext_vector_type(16)));
__device__ __forceinline__ void fft_cos_table(Frame& F, LAS float* tab) {
    for (int i = F.tid; i < 4096; i += NWAVES * 64) tab[i] = cospif((float)i * (1.0f / 2048.0f));
    __syncthreads();
}
__device__ __forceinline__ void fft_pass_a(Frame& F) {
    constexpr int TP = 272, TILE = 32 * TP, T0 = 8 * TILE;
    LAS float* tab = (LAS float*)F.lds; LAS float* twc = (LAS float*)(F.lds + T0); LAS float* tws = twc + 4096; LAS v4u* bfl = (LAS v4u*)(F.lds + T0 + 32768);
    fft_cos_table(F, tab);
    for (int i = F.tid; i < 4096; i += NWAVES * 64) { const int r = i >> 6, k1 = i & 63; twc[i] = tab[r * k1]; tws[i] = tab[(r * k1 - 1024) & 4095]; }
    for (int i = F.tid; i < 16 * 64; i += NWAVES * 64) { const int ln = i & 63, cb = (i >> 6) & 3, s = i >> 8, r32 = ln & 31, h = ln >> 5; float v[8];
        const int col = 32 * cb + r32, k1 = col & 63, cs = col >> 6;
#pragma unroll
        for (int jj = 0; jj < 8; ++jj) { const int k = 16 * s + 8 * h + jj; const int idx = (k * k1 * 64) & 4095; v[jj] = (cs ? -tab[(idx - 1024) & 4095] : tab[idx]) * 0.125f; }
        v4u o; o.x = pk2(v[0], v[1]); o.y = pk2(v[2], v[3]); o.z = pk2(v[4], v[5]); o.w = pk2(v[6], v[7]); bfl[i] = o; }
    __syncthreads();
    const int gw = F.vcu * NWAVES + F.wave, NGW = F.G * NWAVES, r32 = F.lane & 31, h = F.lane >> 5;
    const bf16* hP = (const bf16*)(F.ws + WS_XN); bf16* YP = (bf16*)(F.ws + WS_YP);
    LAS unsigned char* tile = F.lds + F.wave * TILE;
    for (int bc = gw; bc < NB * 1024; bc += NGW) { const int b = bc >> 10, c = bc & 1023;
        const bf16* arow = hP + (size_t)bc * 4096 + r32 * 64 + 8 * h;
        bf16x8 a[2][4];
#pragma unroll
        for (int rb = 0; rb < 2; ++rb)
#pragma unroll
            for (int s = 0; s < 4; ++s) a[rb][s] = *(const GAS bf16x8*)(arow + rb * 2048 + 16 * s);
#pragma unroll 1
        for (int kb = 0; kb < 2; ++kb) { const int k1 = r32 + 32 * kb;
#pragma unroll
            for (int rb = 0; rb < 2; ++rb) { f32x16 ar = (f32x16){}, ai = (f32x16){};
#pragma unroll
                for (int s = 0; s < 4; ++s) { ar = __builtin_amdgcn_mfma_f32_32x32x16_bf16(a[rb][s], __builtin_bit_cast(bf16x8, bfl[(s * 4 + kb) * 64 + F.lane]), ar, 0, 0, 0);
                                              ai = __builtin_amdgcn_mfma_f32_32x32x16_bf16(a[rb][s], __builtin_bit_cast(bf16x8, bfl[(s * 4 + 2 + kb) * 64 + F.lane]), ai, 0, 0, 0); }
#pragma unroll
                for (int g = 0; g < 4; ++g) { float yr[4], yi[4];
#pragma unroll
                    for (int i = 0; i < 4; ++i) { const int r = 32 * rb + i + 8 * g + 4 * h; const float cc = twc[r * 64 + k1], ss = tws[r * 64 + k1]; const float xr = ar[4 * g + i], xi = ai[4 * g + i];
                        yr[i] = xr * cc + xi * ss; yi[i] = xi * cc - xr * ss; }
                    v2u w; w.x = pk2(yr[0], yr[1]); w.y = pk2(yr[2], yr[3]); *(LAS v2u*)(tile + r32 * TP + (32 * rb + 8 * g + 4 * h) * 2) = w;
                    w.x = pk2(yi[0], yi[1]); w.y = pk2(yi[2], yi[3]); *(LAS v2u*)(tile + r32 * TP + 128 + (32 * rb + 8 * g + 4 * h) * 2) = w; } }
            LDS_WAIT(); asm volatile("" ::: "memory");
#pragma unroll
            for (int p = 0; p < 8; ++p) { const int row = 4 * p + (F.lane >> 4), ch = F.lane & 15; const v4u v = *(const LAS v4u*)(tile + row * TP + ch * 16);
                *(GAS v4u*)(YP + (((size_t)(b * 64 + 32 * kb + row) * 1024 + c) * 128) + ch * 8) = v; }
            LDS_WAIT(); asm volatile("" ::: "memory");
        }
    }
}
__device__ __forceinline__ void fft_pass_c(Frame& F) {
    constexpr int TP = 144, TILE = 64 * TP, T0 = 8 * TILE;
    LAS float* tab = (LAS float*)F.lds; LAS v4u* bfl = (LAS v4u*)(F.lds + T0);
    fft_cos_table(F, tab);
    for (int i = F.tid; i < 32 * 64; i += NWAVES * 64) { const int ln = i & 63, cb = (i >> 6) & 3, s = i >> 8, r32 = ln & 31, h = ln >> 5; float v[8];
        const int col = 32 * cb + r32, k2 = col & 63, cso = col >> 6;
#pragma unroll
        for (int jj = 0; jj < 8; ++jj) { const int k = 16 * s + 8 * h + jj, csi = k >> 6, r = k & 63; const int idx = (r * k2 * 64) & 4095; const float cv = tab[idx], sv = tab[(idx - 1024) & 4095];
            v[jj] = ((csi == cso) ? (csi ? -cv : cv) : sv) * 0.125f; }
        v4u o; o.x = pk2(v[0], v[1]); o.y = pk2(v[2], v[3]); o.z = pk2(v[4], v[5]); o.w = pk2(v[6], v[7]); bfl[i] = o; }
    __syncthreads();
    const int gw = F.vcu * NWAVES + F.wave, NGW = F.G * NWAVES, r32 = F.lane & 31, h = F.lane >> 5;
    const bf16* YP = (const bf16*)(F.ws + WS_YP); bf16* ZT = (bf16*)(F.ws + WS_ZT);
    LAS unsigned char* tile = F.lds + F.wave * TILE;
    for (int it = gw; it < NB * 64 * 16; it += NGW) { const int b = it >> 10, k1 = (it >> 4) & 63, g64 = it & 15;
        const bf16* arow = YP + (((size_t)(b * 64 + k1) * 1024 + 64 * g64 + r32) * 128) + 8 * h;
        bf16x8 a[2][8];
#pragma unroll
        for (int rb = 0; rb < 2; ++rb)
#pragma unroll
            for (int s = 0; s < 8; ++s) a[rb][s] = *(const GAS bf16x8*)(arow + rb * 4096 + 16 * s);
#pragma unroll 1
        for (int cso = 0; cso < 2; ++cso) {
#pragma unroll
            for (int cbl = 0; cbl < 2; ++cbl)
#pragma unroll
                for (int rb = 0; rb < 2; ++rb) { f32x16 acc = (f32x16){};
#pragma unroll
                    for (int s = 0; s < 8; ++s) acc = __builtin_amdgcn_mfma_f32_32x32x16_bf16(a[rb][s], __builtin_bit_cast(bf16x8, bfl[(s * 4 + 2 * cso + cbl) * 64 + F.lane]), acc, 0, 0, 0);
#pragma unroll
                    for (int g = 0; g < 4; ++g) { v2u w; w.x = pk2(acc[4 * g], acc[4 * g + 1]); w.y = pk2(acc[4 * g + 2], acc[4 * g + 3]); *(LAS v2u*)(tile + (32 * cbl + r32) * TP + (32 * rb + 8 * g + 4 * h) * 2) = w; } }
            LDS_WAIT(); asm volatile("" ::: "memory");
#pragma unroll
            for (int p = 0; p < 8; ++p) { const int row = 8 * p + (F.lane >> 3), ch = F.lane & 7; const v4u v = *(const LAS v4u*)(tile + row * TP + ch * 16);
                *(GAS v4u*)(ZT + ((size_t)b * 8192 + k1 + 64 * row + 4096 * cso) * 1024 + 64 * g64 + 8 * ch) = v; }
            LDS_WAIT(); asm volatile("" ::: "memory");
        }
    }
}

#ifndef PROBE_REP
#define PROBE_REP -1
#endif
template <int K> __device__ __forceinline__ void run_phase(const Args& A, Frame& F, unsigned char* lds, unsigned char* obuf) {
    unsigned char* ws = F.ws;
    constexpr int l = (K >= 12) ? 1 : 0;
    { int ln = threadIdx.x & 63; asm volatile("" : "+v"(ln)); F.lane = ln; }
    if constexpr (K == 0) p0_prologue(A, F);
    else if constexpr (K == 1) { p1_phase(A, F);
        if (F.vcu >= F.G - 16) { const int j = F.vcu - (F.G - 16);
            if (F.tid < 64) { unsigned* cw = (unsigned*)(F.ctl + CW_CTX) + 64 * (j >> 1); unsigned sp = 0;
                while ((unsigned)__builtin_amdgcn_readfirstlane(__hip_atomic_load(cw, RLX_AGENT)) < 32u) { __builtin_amdgcn_s_sleep(2); if (++sp > (1u << 22)) break; }
                __builtin_amdgcn_fence(__ATOMIC_ACQUIRE, "agent"); VM_WAIT(); }
            __syncthreads();
            ProbQKV P{16, (const char*)(ws + WS_XN), (const char*)(ws + WS_XNC), (const char*)(ws + WS_WQKV)};
            SchedOne S; S.u0.pm = j >> 1; S.u0.pn = 4 + (j & 1); S.u0.e = 1; S.u0.r0 = 0; S.u0.cnt = 0; S.u0.rb = 0; S.u0.ui = 0;
            EpiQKV E{(bf16*)(ws + WS_QO), (bf16*)(ws + WS_K), (bf16*)(ws + WS_V), A.in[I_QN], A.in[I_KN], (const LAS float*)(F.lds + GTAB_OFF)};
            pg8::gemm_phase<ProbQKV, EpiQKV, SchedOne, true>(F.lds + RING_OFF, P, S, E); } }
    else if constexpr (K == 2) { ProbQKV P{16, (const char*)(ws + WS_XN), (const char*)(ws + WS_XNC), (const char*)(ws + WS_WQKV)};
        pg8::StaticOrder S; S.init(NT_TOK / 256, QKVN / 256, F.G, (int)blockIdx.x);
        { LAS float* lr = (LAS float*)(F.lds + GTAB_OFF); const float* gr = (const float*)(ws + WS_ROPE); for (int i = F.tid; i < 2048; i += NWAVES * 64) lr[i] = gr[i]; __syncthreads(); }
        EpiQKV E{(bf16*)(ws + WS_QO), (bf16*)(ws + WS_K), (bf16*)(ws + WS_V), A.in[I_QN], A.in[I_KN], (const LAS float*)(F.lds + GTAB_OFF)};
        pg8::gemm_phase<ProbQKV, EpiQKV, pg8::StaticOrder, true>(F.lds + RING_OFF, P, S, E); }
    else if constexpr (K == 3) { const int x = F.vcu >> 5, j = F.vcu & 31;
        float mref; { float gq = fabsf(A.in[I_QN][F.lane]), gk = fabsf(A.in[I_KN][F.lane]);
#pragma unroll
            for (int o = 1; o < 64; o <<= 1) { gq = fmaxf(gq, __shfl_xor(gq, o)); gk = fmaxf(gk, __shfl_xor(gk, o)); }
            mref = 64.0f * attn_body::C2 * gq * gk * 1.0001f + 0.01f; }
        for (int i = 0; i < 8; ++i) { const int pair = 4 * x + (i >> 1), b = pair >> 2, kvh = pair & 3, un = (i & 1) * 32 + j, h = kvh * 4 + (un >> 4), qb = un & 15;
            const attn_body::bf16* Qu = (const attn_body::bf16*)(ws + WS_QO) + ((size_t)b * SEQ + qb * 256) * 1024 + h * 64;
            attn_body::attn_unit<LK / 64>(Qu, (const attn_body::bf16*)(ws + WS_K) + (size_t)b * LK * KVP + kvh * 64, (const attn_body::bf16*)(ws + WS_V) + (size_t)b * LK * KVP + kvh * 64,
                                              (attn_body::bf16*)(obuf) + ((size_t)b * SEQ + qb * 256) * 1024 + h * 64, (char*)lds + RING_OFF, mref); } }
    else if constexpr (K == 4) { ProbStd<true> P{16, (const char*)(ws + WS_QO), (const char*)(ws + WS_WO), 2048, 2048};
        pg8::StaticOrder S; S.init(NT_TOK / 256, 4, F.G, (int)blockIdx.x);
        EpiResid<true> E{A.in[I_X], xres(F, 1), modp(F, 0, 0, 2)};
        pg8::gemm_phase<ProbStd<true>, EpiResid<true>, pg8::StaticOrder, true>(F.lds + RING_OFF, P, S, E); }
    else if constexpr (K == 5 || K == 12) moe_in_phase(A, F, l);
    else if constexpr (K == 6 || K == 13) {
        grouped_setup(F, l, true);
        unsigned* upc = (unsigned*)(F.ctl + CW_UPC) + l * UPC_WORDS;
        { ProbUp P{16, (const char*)(ws + WS_XN), (const char*)(ws + WS_W13)};
          GroupedOrder S{(const LAS int*)(F.lds + TS_OFF), F.G, (int)blockIdx.x, l, 0, 0, nullptr};
          EpiUp E{(bf16*)(ws + WS_H1), upc};
          pg8::gemm_phase<ProbUp, EpiUp, GroupedOrder, true>(F.lds + RING_OFF, P, S, E); }
        { const int nup = __builtin_amdgcn_readfirstlane(((const LAS int*)(F.lds + TS_OFF))[32]) * 4; const int c = (int)blockIdx.x; const int iu = (c < nup) ? (nup - c + F.G - 1) / F.G : 0;
          ProbDown P{8, (const char*)(ws + WS_H1), (const char*)(ws + WS_W2)};
          GroupedOrder S{(const LAS int*)(F.lds + TS_OFF), F.G, c, l, iu, nup, upc};
          if (F.tid < 64) { Unit u; unsigned sp = 0;
              for (int i = 0; S.next(i, u); ++i) { unsigned* p = upc + 64 * u.pm;
                  while ((unsigned)__builtin_amdgcn_readfirstlane(__hip_atomic_load(p, RLX_AGENT)) < 32u) { __builtin_amdgcn_s_sleep(4); if (++sp > (1u << 22)) break; } }
              __builtin_amdgcn_fence(__ATOMIC_ACQUIRE, "agent"); VM_WAIT(); }
          __syncthreads();
          EpiDown E{(bf16*)(ws + WS_Y), (const int*)(ws + WS_LIST), (const float*)(ws + WS_GATE)};
          pg8::gemm_phase<ProbDown, EpiDown, GroupedOrder, true>(F.lds + RING_OFF, P, S, E); } }
    else if constexpr (K == 7) p8_phase(A, F);
    else if constexpr (K == 8) fft_pass_a(F);
    else if constexpr (K == 9) fft_pass_c(F);
    else if constexpr (K == 10) { ProbC P{8, (const char*)(ws + WS_ZT), (const char*)(ws + WS_DFTC)};
        pg8::StaticOrder S; S.init(NT_TOK / 256, 4, F.G, (int)blockIdx.x);
        EpiC E{(bf16*)(ws + WS_QO)};
        pg8::gemm_phase<ProbC, EpiC, pg8::StaticOrder, true>(F.lds + RING_OFF, P, S, E); }
    else if constexpr (K == 11) { ProbStd<true> P{16, (const char*)(ws + WS_QO), (const char*)(ws + WS_WF), 2048, 2048};
        pg8::StaticOrder S; S.init(NT_TOK / 256, 4, F.G, (int)blockIdx.x);
        EpiResid<false> E{xres(F, 2), xres(F, 3), modp(F, 1, 0, 2)};
        pg8::gemm_phase<ProbStd<true>, EpiResid<false>, pg8::StaticOrder, true>(F.lds + RING_OFF, P, S, E); }
    else if constexpr (K == 14) final_phase(A, F);
}

__global__ void __launch_bounds__(NWAVES * 64, 2) fwd_megakernel(Args args) {
    extern __shared__ __attribute__((aligned(16))) unsigned char lds[];
    Frame F;
    F.lds = (LAS unsigned char*)lds;
    F.MISC = (volatile LAS unsigned*)(F.lds + MISC_OFF);
    F.tid = threadIdx.x; F.lane = F.tid & 63; F.wave = __builtin_amdgcn_readfirstlane(F.tid >> 6);
    F.G = gridDim.x; { const int bx = blockIdx.x; F.vcu = (F.G % 8 == 0) ? (bx % 8) * (F.G / 8) + bx / 8 : bx; }
    F.ws = args.ws; F.out = args.out; F.ctl = (gu32*)(args.ws + WS_CTL);
    for (int u = F.tid; u < (LDS_BYTES - LDSCTL_OFF) / 4; u += NWAVES * 64) ((LAS unsigned*)(F.lds + LDSCTL_OFF))[u] = 0u;
    __syncthreads();
    XcdBarrier bar; bar.bar = (unsigned*)(F.ctl + CW_BAR); bar.x = 0; bar.st = nullptr;
    if (N_LAUNCHES == 1) bar = xcd_barrier_post((unsigned*)(F.ctl + CW_BAR), F.MISC + 8);
    const Args& A = args;
    const int lo = args.ph_lo, hi = args.ph_hi;
#define PH(k) do { if (PH_EN(k) && lo <= (k) && (k) < hi) { \
        if constexpr (PROBE_REP == (k)) { run_phase<k>(A, F, lds, args.ws + WS_XN); xcd_barrier(bar); } \
        run_phase<k>(A, F, lds, args.ws + WS_QO); } \
        if (lo <= (k) && (k) + 1 < hi) xcd_barrier(bar); } while (0)
    PH(0); PH(1); PH(2); PH(3); PH(4); PH(5); PH(6); PH(7); PH(8); PH(9); PH(10); PH(11); PH(12); PH(13); PH(14);
#undef PH
}

extern "C" void kernel_launch(void* const* d_in, const int* in_sizes, int n_in, void* d_out, int out_size, void* d_ws, size_t ws_size, hipStream_t stream) {
    static int grid = 0;
    if (grid == 0) {
        if (n_in != 21 || out_size != NT_TOK * DM || ws_size < WS_END) { fprintf(stderr, "kernel_launch: unexpected problem (n_in %d, out %d, ws %zu < %zu)\n", n_in, out_size, ws_size, (size_t)WS_END); grid = -1; return; }
        int dev = 0, cus = 0;
        if (hipGetDevice(&dev) != hipSuccess || hipDeviceGetAttribute(&cus, hipDeviceAttributeMultiprocessorCount, dev) != hipSuccess) { grid = -1; return; }
        if (hipFuncSetAttribute((const void*)fwd_megakernel, hipFuncAttributeMaxDynamicSharedMemorySize, LDS_BYTES) != hipSuccess) { fprintf(stderr, "kernel_launch: hipFuncSetAttribute failed\n"); grid = -1; return; }
        int per_cu = 0;
        if (hipOccupancyMaxActiveBlocksPerMultiprocessor(&per_cu, (const void*)fwd_megakernel, NWAVES * 64, LDS_BYTES) != hipSuccess || per_cu < 1) fprintf(stderr, "kernel_launch: occupancy query says %d\n", per_cu);
        (void)hipGetLastError();
        grid = 256;
        if (cus != 256) fprintf(stderr, "kernel_launch: device has %d CUs, kernel built for 256\n", cus);
    }
    if (grid < 0) return;
    (void)hipMemsetAsync((char*)d_ws + WS_CTL, 0, CTL_ZERO_BYTES, stream);
    Args a{};
    for (int i = 0; i < 21; ++i) a.in[i] = (const float*)d_in[i];
    a.out = (float*)d_out; a.ws = (unsigned char*)d_ws;
    if (N_LAUNCHES == 1) { a.ph_lo = 0; a.ph_hi = N_PHASES; hipLaunchKernelGGL(fwd_megakernel, dim3(grid), dim3(NWAVES * 64), LDS_BYTES, stream, a); }
    else for (int p = 0; p < N_PHASES; ++p) { a.ph_lo = p; a.ph_hi = p + 1; hipLaunchKernelGGL(fwd_megakernel, dim3(grid), dim3(NWAVES * 64), LDS_BYTES, stream, a); }
}
```
